# Optimizing an MI355X kernel written in HIP

```python
import jax, jax.numpy as jnp
from jax import lax
import numpy as np

D_MODEL = 2048
BATCH = 8
SEQ = 2048
DEPTH = 2

GRID_W = 64
HEAD_DIM = 128
A_HEADS = 8
A_KV_HEADS = 2
B_HEADS = 4
B_Q_LORA = 512
B_KV_LORA = 256
B_NOPE = 128
B_ROPE = 64
B_V = 128
C_HEADS = 4
WIN_ROWS = 8
WIN_COLS = 16
D_MIX = A_HEADS * HEAD_DIM + B_HEADS * B_V + C_HEADS * HEAD_DIM
Q_BLOCK = 128
ROPE_THETA = 10000.0
NORM_EPS = 1e-6
IN_SPLITS = (
    A_HEADS * HEAD_DIM,
    A_KV_HEADS * HEAD_DIM,
    A_KV_HEADS * HEAD_DIM,
    A_HEADS * HEAD_DIM,
    B_Q_LORA,
    B_KV_LORA,
    B_ROPE,
    B_HEADS * B_V,
    C_HEADS * HEAD_DIM,
    C_HEADS * HEAD_DIM,
    C_HEADS * HEAD_DIM,
    C_HEADS * HEAD_DIM,
)
D_IN = sum(IN_SPLITS)

kernel_name = "hybrid_gqa_mla_natten_encoder"


def _rms_norm(x, g):
    xf = x.astype(jnp.float32)
    y = xf * lax.rsqrt(jnp.mean(xf * xf, axis=-1, keepdims=True) + NORM_EPS)
    return (y * g.astype(jnp.float32)).astype(x.dtype)


def _rope_half(x, pos):
    n = x.shape[-1]
    inv_freq = 1.0 / (ROPE_THETA ** (jnp.arange(0, n, 2, dtype=jnp.float32) / n))
    ang = pos.astype(jnp.float32)[:, None] * inv_freq[None, :]
    cos = jnp.cos(ang)[:, None, :]
    sin = jnp.sin(ang)[:, None, :]
    xf = x.astype(jnp.float32)
    x1, x2 = xf[..., : n // 2], xf[..., n // 2:]
    out = jnp.concatenate([x1 * cos - x2 * sin, x2 * cos + x1 * sin], axis=-1)
    return out.astype(x.dtype)


def _rope_axial(x, row, col):
    h = x.shape[-1] // 2
    return jnp.concatenate([_rope_half(x[..., :h], row), _rope_half(x[..., h:], col)], axis=-1)


def _dense_block_attention(q, k, v):
    B, S, H, dq = q.shape
    Hk = k.shape[2]
    G = H // Hk
    dv = v.shape[-1]
    nb = S // Q_BLOCK
    scale = dq ** -0.5
    qb = q.reshape(B, nb, Q_BLOCK, Hk, G, dq).transpose(1, 0, 2, 3, 4, 5)

    def one(qblk):
        s = jnp.einsum('bqkgd,bskd->bkgqs', qblk, k).astype(jnp.float32) * scale
        p = jax.nn.softmax(s, axis=-1).astype(v.dtype)
        return jnp.einsum('bkgqs,bskd->bqkgd', p, v)

    o = lax.map(one, qb)
    return o.transpose(1, 0, 2, 3, 4, 5).reshape(B, S, H, dv)


def _neighbourhood_attention(q, k, v, rpb):
    B, S, H, d = q.shape
    rows = S // GRID_W
    kr = min(WIN_ROWS, rows)
    nk = kr * WIN_COLS
    t = jnp.arange(S)
    r = t // GRID_W
    c = t % GRID_W
    r0 = jnp.clip(r - kr // 2, 0, rows - kr)
    c0 = jnp.clip(c - WIN_COLS // 2, 0, GRID_W - WIN_COLS)
    key_r = r0[:, None, None] + jnp.arange(kr)[None, :, None]
    key_c = c0[:, None, None] + jnp.arange(WIN_COLS)[None, None, :]
    idx = (key_r * GRID_W + key_c).reshape(S, nk)
    dr = key_r - r[:, None, None] + (WIN_ROWS - 1)
    dc = key_c - c[:, None, None] + (WIN_COLS - 1)
    bias = rpb[:, dr, dc].reshape(H, S, nk)
    nb = S // Q_BLOCK
    scale = d ** -0.5
    qb = q.reshape(B, nb, Q_BLOCK, H, d).transpose(1, 0, 2, 3, 4)
    idxb = idx.reshape(nb, Q_BLOCK, nk)
    biasb = bias.reshape(H, nb, Q_BLOCK, nk).transpose(1, 0, 2, 3)

    def one(args):
        qblk, iblk, bblk = args
        kg = jnp.take(k, iblk, axis=1)
        vg = jnp.take(v, iblk, axis=1)
        s = jnp.einsum('bqhd,bqnhd->bhqn', qblk, kg).astype(jnp.float32) * scale
        s = s + bblk[None].astype(jnp.float32)
        p = jax.nn.softmax(s, axis=-1).astype(v.dtype)
        return jnp.einsum('bhqn,bqnhd->bqhd', p, vg)

    o = lax.map(one, (qb, idxb, biasb))
    return o.transpose(1, 0, 2, 3, 4).reshape(B, S, H, d)


def _layer(x, g_pre, g_post, w_in, a_qn, a_kn, b_qn, b_kvn, w_uq, w_ukv, rpb, w_out, row, col):
    B, S, _ = x.shape
    h = _rms_norm(x, g_pre)
    proj = jnp.einsum('bsd,de->bse', h, w_in)
    split_points = [int(p) for p in np.cumsum(IN_SPLITS)[:-1]]
    (a_q, a_k, a_v, a_g, b_cq, b_ckv, b_kr, b_g,
     c_q, c_k, c_v, c_g) = jnp.split(proj, split_points, axis=-1)

    qa = _rms_norm(a_q.reshape(B, S, A_HEADS, HEAD_DIM), a_qn)
    ka = _rms_norm(a_k.reshape(B, S, A_KV_HEADS, HEAD_DIM), a_kn)
    va = a_v.reshape(B, S, A_KV_HEADS, HEAD_DIM)
    qa = _rope_axial(qa, row, col)
    ka = _rope_axial(ka, row, col)
    o_a = _dense_block_attention(qa, ka, va).reshape(B, S, A_HEADS * HEAD_DIM) * jax.nn.silu(a_g)

    cq = _rms_norm(b_cq, b_qn)
    qb = jnp.einsum('bsr,re->bse', cq, w_uq).reshape(B, S, B_HEADS, B_NOPE + B_ROPE)
    q_nope, q_pe = qb[..., :B_NOPE], qb[..., B_NOPE:]
    q_pe = _rope_axial(q_pe, row, col)
    ckv = _rms_norm(b_ckv, b_kvn)
    kv = jnp.einsum('bsr,re->bse', ckv, w_ukv).reshape(B, S, B_HEADS, B_NOPE + B_V)
    k_nope, vb = kv[..., :B_NOPE], kv[..., B_NOPE:]
    k_pe = _rope_axial(b_kr.reshape(B, S, 1, B_ROPE), row, col)
    k_pe = jnp.broadcast_to(k_pe, (B, S, B_HEADS, B_ROPE))
    q_full = jnp.concatenate([q_nope, q_pe], axis=-1)
    k_full = jnp.concatenate([k_nope, k_pe], axis=-1)
    o_b = _dense_block_attention(q_full, k_full, vb).reshape(B, S, B_HEADS * B_V) * jax.nn.silu(b_g)

    qc = c_q.reshape(B, S, C_HEADS, HEAD_DIM)
    kc = c_k.reshape(B, S, C_HEADS, HEAD_DIM)
    vc = c_v.reshape(B, S, C_HEADS, HEAD_DIM)
    o_c = _neighbourhood_attention(qc, kc, vc, rpb).reshape(B, S, C_HEADS * HEAD_DIM) * jax.nn.silu(c_g)

    y = jnp.einsum('bse,ed->bsd', jnp.concatenate([o_a, o_b, o_c], axis=-1), w_out)
    return x + _rms_norm(y, g_post)


def setup_inputs(seed: int = 0) -> dict:
    key = jax.random.key(seed)
    ks = jax.random.split(key, 13)
    f32 = jnp.float32

    def gain(k, n):
        return 1.0 + 0.05 * jax.random.normal(k, (DEPTH, n), f32)

    x = jax.random.normal(ks[0], (BATCH, SEQ, D_MODEL), f32)
    norm_pre = gain(ks[1], D_MODEL)
    norm_post = gain(ks[2], D_MODEL)
    w_in = jax.random.normal(ks[3], (DEPTH, D_MODEL, D_IN), f32) * D_MODEL ** -0.5
    a_q_norm = gain(ks[4], HEAD_DIM)
    a_k_norm = gain(ks[5], HEAD_DIM)
    b_q_norm = gain(ks[6], B_Q_LORA)
    b_kv_norm = gain(ks[7], B_KV_LORA)
    b_w_uq = jax.random.normal(ks[8], (DEPTH, B_Q_LORA, B_HEADS * (B_NOPE + B_ROPE)), f32) * B_Q_LORA ** -0.5
    b_w_ukv = jax.random.normal(ks[9], (DEPTH, B_KV_LORA, B_HEADS * (B_NOPE + B_V)), f32) * B_KV_LORA ** -0.5
    c_rpb = 0.1 * jax.random.normal(ks[10], (DEPTH, C_HEADS, 2 * WIN_ROWS - 1, 2 * WIN_COLS - 1), f32)
    w_out = jax.random.normal(ks[11], (DEPTH, D_MIX, D_MODEL), f32) * D_MIX ** -0.5
    return {"x": x, "norm_pre": norm_pre, "norm_post": norm_post, "w_in": w_in,
            "a_q_norm": a_q_norm, "a_k_norm": a_k_norm, "b_q_norm": b_q_norm,
            "b_kv_norm": b_kv_norm, "b_w_uq": b_w_uq, "b_w_ukv": b_w_ukv,
            "c_rpb": c_rpb, "w_out": w_out}


def reference(x, norm_pre, norm_post, w_in, a_q_norm, a_k_norm, b_q_norm, b_kv_norm,
              b_w_uq, b_w_ukv, c_rpb, w_out):
    S = x.shape[1]
    t = jnp.arange(S)
    row = t // GRID_W
    col = t % GRID_W
    h = x
    for l in range(DEPTH):
        h = _layer(h, norm_pre[l], norm_post[l], w_in[l], a_q_norm[l], a_k_norm[l],
                   b_q_norm[l], b_kv_norm[l], b_w_uq[l], b_w_ukv[l], c_rpb[l], w_out[l],
                   row, col)
    return h
```

```cpp
#include <hip/hip_runtime.h>
#include <cstdint>
#include <cstdio>

typedef unsigned short bf16_t;
typedef short bf16x8 __attribute__((ext_vector_type(8)));
typedef float f32x4 __attribute__((ext_vector_type(4)));
#define DEVI __device__ __forceinline__

constexpr int BATCH = 8, SEQ = 2048, DM = 2048, DEPTH = 2;
constexpr int M = BATCH * SEQ;
constexpr int DIN = 5952, NP = 6144;
constexpr int DMIX = 2048;
constexpr float EPS = 1e-6f;
constexpr int C_AQ = 0, C_AK = 1024, C_AV = 1280, C_AG = 1536, C_BCQ = 2560, C_BCKV = 3072, C_BKR = 3328, C_BG = 3584,
              C_CQ = 4096, C_CK = 4608, C_CV = 5120, C_CG = 5632;
constexpr size_t MiB = 1u << 20;
constexpr size_t WS_TAB = 1 * MiB;
constexpr size_t WS_WIN = 2 * MiB, WIN_L = 24 * MiB;
constexpr size_t WS_WOUT = 50 * MiB, WOUT_L = 8 * MiB;
constexpr size_t WS_WUQ = 66 * MiB, WUQ_L = 1 * MiB;
constexpr size_t WS_WUKV = 68 * MiB, WUKV_L = 1 * MiB;
constexpr size_t WS_XN = 70 * MiB;
constexpr size_t WS_PROJ = 134 * MiB;
constexpr size_t WS_Y = WS_PROJ;
constexpr size_t WS_QB = 326 * MiB;
constexpr size_t WS_KVB = 350 * MiB;
constexpr size_t WS_MIX = 382 * MiB;
constexpr size_t WS_END = 446 * MiB;
constexpr int T_AR = 0, T_AC = 1024, T_BR = 3072, T_BC = 3584, T_N = 4608;

DEVI float bf2f(unsigned v) { return __uint_as_float(v << 16); }
DEVI unsigned f2bf(float f) { unsigned u = __float_as_uint(f); return (u + 0x7fffu + ((u >> 16) & 1u)) >> 16; }
DEVI unsigned pk2(float lo, float hi) { return f2bf(lo) | (f2bf(hi) << 16); }
DEVI float wave_sum(float v) {
#pragma unroll
  for (int o = 1; o < 64; o <<= 1) v += __shfl_xor(v, o);
  return v;
}
DEVI float wave_max(float v) {
#pragma unroll
  for (int o = 1; o < 64; o <<= 1) v = fmaxf(v, __shfl_xor(v, o));
  return v;
}

DEVI int perm128(int p) { const int a = p >> 6, j = (p & 63) >> 1, t = p & 1; return 64 * a + 32 * t + j; }
DEVI int perm64(int p) { const int a = p >> 5, j = (p & 31) >> 1, t = p & 1; return 32 * a + 16 * t + j; }
DEVI int map_col(int mode, int s) {
  if (mode == 0) return s;
  if (mode == 1) {
    if (s < 1280) return (s & ~127) + perm128(s & 127);
    if (s < 3328) return s;
    if (s < 3392) return 3328 + perm64(s - 3328);
    if (s < 3584) return -1;
    return s - 192;
  }
  if (s < 512) return (s >> 7) * 192 + (s & 127);
  const int h = (s - 512) >> 6, p = (s - 512) & 63;
  return h * 192 + 128 + perm64(p);
}

__global__ __launch_bounds__(256) void k_transpose_cvt(const float* __restrict__ src, bf16_t* __restrict__ dst, int K, int Ns, int mode) {
  __shared__ float tile[32][33];
  const int n0 = blockIdx.x * 32, k0 = blockIdx.y * 32, tx = threadIdx.x & 31, ty = threadIdx.x >> 5;
  const int so = map_col(mode, n0 + tx);
#pragma unroll
  for (int i = 0; i < 4; ++i) { const int kk = ty + 8 * i; tile[kk][tx] = so >= 0 ? src[(size_t)(k0 + kk) * Ns + so] : 0.f; }
  __syncthreads();
#pragma unroll
  for (int i = 0; i < 4; ++i) { const int nn = ty + 8 * i; dst[(size_t)(n0 + nn) * K + k0 + tx] = (bf16_t)f2bf(tile[tx][nn]); }
}

__global__ __launch_bounds__(256) void k_rope_tab(float2* tab) {
  const int i = blockIdx.x * 256 + threadIdx.x; if (i >= T_N) return;
  int pos, j; float n;
  if (i < T_AC) { pos = i >> 5; j = i & 31; n = 64.f; }
  else if (i < T_BR) { pos = (i - T_AC) >> 5; j = i & 31; n = 64.f; }
  else if (i < T_BC) { pos = (i - T_BR) >> 4; j = i & 15; n = 32.f; }
  else { pos = (i - T_BC) >> 4; j = i & 15; n = 32.f; }
  const float inv = 1.0f / powf(10000.f, (float)(2 * j) / n);
  const float ang = (float)pos * inv;
  const float k = rintf(ang * 0.15915494309189535f);
  float r = fmaf(-k, 6.28318548202514648f, ang); r = fmaf(-k, -1.74845553e-7f, r);
  tab[i] = make_float2(cosf(r), sinf(r));
}

__global__ __launch_bounds__(256) void k_rmsnorm_xn(const float* __restrict__ x, const float* __restrict__ g, bf16_t* __restrict__ xn) {
  const int row = blockIdx.x * 4 + (threadIdx.x >> 6), lane = threadIdx.x & 63;
  const float4* xr = (const float4*)(x + (size_t)row * DM) + lane;
  float4 v[8]; float ss = 0.f;
#pragma unroll
  for (int j = 0; j < 8; ++j) { v[j] = xr[64 * j]; ss += v[j].x * v[j].x + v[j].y * v[j].y + v[j].z * v[j].z + v[j].w * v[j].w; }
  const float rs = rsqrtf(wave_sum(ss) * (1.f / DM) + EPS);
  uint2* o = (uint2*)(xn + (size_t)row * DM) + lane;
#pragma unroll
  for (int j = 0; j < 8; ++j) { const float4 gg = ((const float4*)g)[lane + 64 * j];
    o[64 * j] = make_uint2(pk2(v[j].x * rs * gg.x, v[j].y * rs * gg.y), pk2(v[j].z * rs * gg.z, v[j].w * rs * gg.w)); }
}

template <bool OUT_F32>
__global__ __launch_bounds__(256) void k_gemm_naive(const bf16_t* __restrict__ A, int lda, const bf16_t* __restrict__ Bt, int ldb, void* __restrict__ C, int ldc, int K) {
  __shared__ __attribute__((aligned(16))) bf16_t sA[64 * 40];
  __shared__ __attribute__((aligned(16))) bf16_t sB[64 * 40];
  const int tid = threadIdx.x, lane = tid & 63, w = tid >> 6;
  const int m0 = blockIdx.y * 64, n0 = blockIdx.x * 64, lr = tid >> 2, lc = (tid & 3) * 8;
  f32x4 acc0 = {0, 0, 0, 0}, acc1 = acc0, acc2 = acc0, acc3 = acc0;
  for (int k0 = 0; k0 < K; k0 += 32) {
    const uint4 va = *(const uint4*)(A + (size_t)(m0 + lr) * lda + k0 + lc);
    const uint4 vb = *(const uint4*)(Bt + (size_t)(n0 + lr) * ldb + k0 + lc);
    __syncthreads();
    *(uint4*)(sA + lr * 40 + lc) = va; *(uint4*)(sB + lr * 40 + lc) = vb;
    __syncthreads();
    const bf16x8 a = *(const bf16x8*)(sA + (16 * w + (lane & 15)) * 40 + (lane >> 4) * 8);
    const bf16x8 b0 = *(const bf16x8*)(sB + (0 + (lane & 15)) * 40 + (lane >> 4) * 8);
    const bf16x8 b1 = *(const bf16x8*)(sB + (16 + (lane & 15)) * 40 + (lane >> 4) * 8);
    const bf16x8 b2 = *(const bf16x8*)(sB + (32 + (lane & 15)) * 40 + (lane >> 4) * 8);
    const bf16x8 b3 = *(const bf16x8*)(sB + (48 + (lane & 15)) * 40 + (lane >> 4) * 8);
    acc0 = __builtin_amdgcn_mfma_f32_16x16x32_bf16(a, b0, acc0, 0, 0, 0);
    acc1 = __builtin_amdgcn_mfma_f32_16x16x32_bf16(a, b1, acc1, 0, 0, 0);
    acc2 = __builtin_amdgcn_mfma_f32_16x16x32_bf16(a, b2, acc2, 0, 0, 0);
    acc3 = __builtin_amdgcn_mfma_f32_16x16x32_bf16(a, b3, acc3, 0, 0, 0);
  }
#pragma unroll
  for (int j = 0; j < 4; ++j) {
    const size_t row = m0 + 16 * w + (lane >> 4) * 4 + j; const int col = n0 + (lane & 15);
    if (OUT_F32) { float* c = (float*)C + row * ldc + col; c[0] = acc0[j]; c[16] = acc1[j]; c[32] = acc2[j]; c[48] = acc3[j]; }
    else { bf16_t* c = (bf16_t*)C + row * ldc + col; c[0] = (bf16_t)f2bf(acc0[j]); c[16] = (bf16_t)f2bf(acc1[j]); c[32] = (bf16_t)f2bf(acc2[j]); c[48] = (bf16_t)f2bf(acc3[j]); }
  }
}

__global__ __launch_bounds__(256) void k_postproj(bf16_t* __restrict__ PROJ, const float* __restrict__ a_qn, const float* __restrict__ a_kn,
                                                  const float* __restrict__ b_qn, const float* __restrict__ b_kvn, const float2* __restrict__ tab) {
  const int row = blockIdx.x * 4 + (threadIdx.x >> 6), lane = threadIdx.x & 63;
  const int t = row & (SEQ - 1), pr = t >> 6, pc = t & 63;
  bf16_t* p = PROJ + (size_t)row * NP;
  {
    const int a = lane >> 5, j = lane & 31;
    const float2 cs = a == 0 ? tab[T_AR + pr * 32 + j] : tab[T_AC + pc * 32 + j];
    const int d1 = 64 * a + j, d2 = d1 + 32;
    for (int hb = 0; hb < 10; ++hb) {
      unsigned* pp = (unsigned*)(p + hb * 128) + lane;
      const unsigned v = *pp; const float x1 = bf2f(v & 0xffffu), x2 = bf2f(v >> 16);
      const float rs = rsqrtf(wave_sum(x1 * x1 + x2 * x2) * (1.f / 128.f) + EPS);
      const float* g = hb < 8 ? a_qn : a_kn;
      const float y1 = x1 * rs * g[d1], y2 = x2 * rs * g[d2];
      *pp = pk2(y1 * cs.x - y2 * cs.y, y2 * cs.x + y1 * cs.y);
    }
  }
  {
    uint4* pp = (uint4*)(p + C_BCQ) + lane; const uint4 v = *pp; float x[8];
    x[0] = bf2f(v.x & 0xffffu); x[1] = bf2f(v.x >> 16); x[2] = bf2f(v.y & 0xffffu); x[3] = bf2f(v.y >> 16);
    x[4] = bf2f(v.z & 0xffffu); x[5] = bf2f(v.z >> 16); x[6] = bf2f(v.w & 0xffffu); x[7] = bf2f(v.w >> 16);
    float ss = 0.f;
#pragma unroll
    for (int i = 0; i < 8; ++i) ss += x[i] * x[i];
    const float rs = rsqrtf(wave_sum(ss) * (1.f / 512.f) + EPS);
    const float4 g0 = ((const float4*)b_qn)[2 * lane], g1 = ((const float4*)b_qn)[2 * lane + 1];
    *pp = make_uint4(pk2(x[0] * rs * g0.x, x[1] * rs * g0.y), pk2(x[2] * rs * g0.z, x[3] * rs * g0.w),
                     pk2(x[4] * rs * g1.x, x[5] * rs * g1.y), pk2(x[6] * rs * g1.z, x[7] * rs * g1.w));
  }
  {
    uint2* pp = (uint2*)(p + C_BCKV) + lane; const uint2 v = *pp;
    const float x0 = bf2f(v.x & 0xffffu), x1 = bf2f(v.x >> 16), x2 = bf2f(v.y & 0xffffu), x3 = bf2f(v.y >> 16);
    const float rs = rsqrtf(wave_sum(x0 * x0 + x1 * x1 + x2 * x2 + x3 * x3) * (1.f / 256.f) + EPS);
    const float4 g = ((const float4*)b_kvn)[lane];
    *pp = make_uint2(pk2(x0 * rs * g.x, x1 * rs * g.y), pk2(x2 * rs * g.z, x3 * rs * g.w));
  }
  if (lane < 32) {
    const int a = lane >> 4, j = lane & 15;
    const float2 cs = a == 0 ? tab[T_BR + pr * 16 + j] : tab[T_BC + pc * 16 + j];
    unsigned* pp = (unsigned*)(p + C_BKR) + lane; const unsigned v = *pp; const float x1 = bf2f(v & 0xffffu), x2 = bf2f(v >> 16);
    *pp = pk2(x1 * cs.x - x2 * cs.y, x2 * cs.x + x1 * cs.y);
  }
}

__global__ __launch_bounds__(256) void k_rope_qpe(bf16_t* __restrict__ QB, const float2* __restrict__ tab) {
  const int row = blockIdx.x * 4 + (threadIdx.x >> 6), lane = threadIdx.x & 63;
  const int t = row & (SEQ - 1), pr = t >> 6, pc = t & 63;
  unsigned* p = (unsigned*)(QB + (size_t)row * 768 + 512);
#pragma unroll
  for (int i = 0; i < 2; ++i) {
    const int pi = lane + 64 * i, a = (pi >> 4) & 1, j = pi & 15;
    const float2 cs = a == 0 ? tab[T_BR + pr * 16 + j] : tab[T_BC + pc * 16 + j];
    const unsigned v = p[pi]; const float x1 = bf2f(v & 0xffffu), x2 = bf2f(v >> 16);
    p[pi] = pk2(x1 * cs.x - x2 * cs.y, x2 * cs.x + x1 * cs.y);
  }
}

DEVI float dot8(const uint4 kv, const float* q) {
  return bf2f(kv.x & 0xffffu) * q[0] + bf2f(kv.x >> 16) * q[1] + bf2f(kv.y & 0xffffu) * q[2] + bf2f(kv.y >> 16) * q[3] +
         bf2f(kv.z & 0xffffu) * q[4] + bf2f(kv.z >> 16) * q[5] + bf2f(kv.w & 0xffffu) * q[6] + bf2f(kv.w >> 16) * q[7];
}
template <int TYPE>
__global__ __launch_bounds__(256) void k_attn_naive(const bf16_t* __restrict__ PROJ, const bf16_t* __restrict__ QB, const bf16_t* __restrict__ KVB,
                                                    const float* __restrict__ rpb, bf16_t* __restrict__ MIX) {
  __shared__ float qs[4][192];
  __shared__ float ps[4][2048];
  constexpr int NH = TYPE == 0 ? 8 : 4;
  const int w = threadIdx.x >> 6, lane = threadIdx.x & 63;
  const int item = blockIdx.x * 4 + w, h = item % NH, row = item / NH, b = row >> 11, t = row & 2047;
  const float scale = TYPE == 1 ? 0.07216878364870322f : 0.08838834764831845f;
  if (TYPE == 0) { for (int d = lane; d < 128; d += 64) qs[w][d] = bf2f(PROJ[(size_t)row * NP + C_AQ + h * 128 + d]); }
  else if (TYPE == 2) { for (int d = lane; d < 128; d += 64) qs[w][d] = bf2f(PROJ[(size_t)row * NP + C_CQ + h * 128 + d]); }
  else { for (int d = lane; d < 128; d += 64) qs[w][d] = bf2f(QB[(size_t)row * 768 + h * 128 + d]); qs[w][128 + lane] = bf2f(QB[(size_t)row * 768 + 512 + h * 64 + lane]); }
  __syncthreads();
  const int r = t >> 6, c = t & 63;
  const int r0 = min(max(r - 4, 0), 24), c0 = min(max(c - 8, 0), 48);
  constexpr int NK = TYPE == 2 ? 128 : 2048;
  float lmax = -3.0e38f;
  for (int i = 0; i < NK / 64; ++i) {
    const int n = lane + 64 * i; int j; float bias = 0.f;
    if (TYPE == 2) { const int kr = r0 + (n >> 4), kc = c0 + (n & 15); j = kr * 64 + kc; bias = rpb[(h * 15 + (kr - r + 7)) * 31 + (kc - c + 15)]; } else j = n;
    const size_t krow = (size_t)b * 2048 + j;
    const bf16_t* kp = TYPE == 0 ? PROJ + krow * NP + C_AK + (h >> 2) * 128 : TYPE == 2 ? PROJ + krow * NP + C_CK + h * 128 : KVB + krow * 1024 + h * 256;
    float acc = 0.f;
#pragma unroll
    for (int d = 0; d < 128; d += 8) acc += dot8(*(const uint4*)(kp + d), &qs[w][d]);
    if (TYPE == 1) { const bf16_t* kp2 = PROJ + krow * NP + C_BKR;
#pragma unroll
      for (int d = 0; d < 64; d += 8) acc += dot8(*(const uint4*)(kp2 + d), &qs[w][128 + d]); }
    const float s = acc * scale + bias;
    ps[w][n] = s; lmax = fmaxf(lmax, s);
  }
  const float mx = wave_max(lmax);
  float lsum = 0.f;
  for (int i = 0; i < NK / 64; ++i) { const int n = lane + 64 * i; const float p = __expf(ps[w][n] - mx); ps[w][n] = p; lsum += p; }
  const float l = wave_sum(lsum);
  __syncthreads();
  float o0 = 0.f, o1 = 0.f;
  for (int n = 0; n < NK; ++n) {
    int j; if (TYPE == 2) j = (r0 + (n >> 4)) * 64 + c0 + (n & 15); else j = n;
    const size_t krow = (size_t)b * 2048 + j;
    const bf16_t* vp = TYPE == 0 ? PROJ + krow * NP + C_AV + (h >> 2) * 128 : TYPE == 2 ? PROJ + krow * NP + C_CV + h * 128 : KVB + krow * 1024 + h * 256 + 128;
    const unsigned v = ((const unsigned*)vp)[lane]; const float p = ps[w][n];
    o0 += p * bf2f(v & 0xffffu); o1 += p * bf2f(v >> 16);
  }
  const int gcol = (TYPE == 0 ? C_AG : TYPE == 1 ? C_BG : C_CG) + h * 128, mcol = (TYPE == 0 ? 0 : TYPE == 1 ? 1024 : 1536) + h * 128;
  const unsigned gv = ((const unsigned*)(PROJ + (size_t)row * NP + gcol))[lane];
  const float g0 = bf2f(gv & 0xffffu), g1 = bf2f(gv >> 16), il = 1.f / l;
  ((unsigned*)(MIX + (size_t)row * DMIX + mcol))[lane] = pk2(o0 * il * (g0 / (1.f + __expf(-g0))), o1 * il * (g1 / (1.f + __expf(-g1))));
}

__global__ __launch_bounds__(256) void k_rowpass(const float* __restrict__ Y, const float* resid, const float* __restrict__ g_post, float* out,
                                                 const float* __restrict__ g_next, bf16_t* __restrict__ xn) {
  const int row = blockIdx.x * 4 + (threadIdx.x >> 6), lane = threadIdx.x & 63;
  const float4* yr = (const float4*)(Y + (size_t)row * DM) + lane; const float4* xr = (const float4*)(resid + (size_t)row * DM) + lane;
  float4 v[8]; float ss = 0.f;
#pragma unroll
  for (int j = 0; j < 8; ++j) { v[j] = yr[64 * j]; ss += v[j].x * v[j].x + v[j].y * v[j].y + v[j].z * v[j].z + v[j].w * v[j].w; }
  const float rs = rsqrtf(wave_sum(ss) * (1.f / DM) + EPS);
  float4* orow = (float4*)(out + (size_t)row * DM) + lane; float s2 = 0.f;
#pragma unroll
  for (int j = 0; j < 8; ++j) { const float4 gg = ((const float4*)g_post)[lane + 64 * j]; const float4 xx = xr[64 * j];
    v[j].x = xx.x + v[j].x * rs * gg.x; v[j].y = xx.y + v[j].y * rs * gg.y; v[j].z = xx.z + v[j].z * rs * gg.z; v[j].w = xx.w + v[j].w * rs * gg.w;
    orow[64 * j] = v[j]; s2 += v[j].x * v[j].x + v[j].y * v[j].y + v[j].z * v[j].z + v[j].w * v[j].w; }
  if (g_next) {
    const float r2 = rsqrtf(wave_sum(s2) * (1.f / DM) + EPS);
    uint2* o = (uint2*)(xn + (size_t)row * DM) + lane;
#pragma unroll
    for (int j = 0; j < 8; ++j) { const float4 gg = ((const float4*)g_next)[lane + 64 * j];
      o[64 * j] = make_uint2(pk2(v[j].x * r2 * gg.x, v[j].y * r2 * gg.y), pk2(v[j].z * r2 * gg.z, v[j].w * r2 * gg.w)); }
  }
}

namespace pg8 {
#define PG8_LAS __attribute__((address_space(3)))
typedef unsigned u32x4 __attribute__((ext_vector_type(4)));
constexpr int BM = 256, BK = 64, HALF = 128, HTB = HALF * BK * 2, STAGE_BYTES = 8 * HTB, NXCD = 8, WGM = 8;
__host__ __device__ __forceinline__ int lds_byte(int r, int c) { const int st = (r >> 4) * 2 + (c >> 5), rr = r & 15, cc = c & 31, ob = rr * 64 + cc * 2; return st * 1024 + (ob ^ (((ob >> 9) & 1) << 5)); }
__host__ __device__ __forceinline__ void stage_rc(int b, int& R, int& C) { const int st = b / 1024, sb = b % 1024, swz = sb ^ (((sb >> 9) & 1) << 5); R = (st >> 1) * 16 + swz / 64; C = (st & 1) * 32 + (swz % 64) / 2; }
__host__ __device__ __forceinline__ int perm32(int rho) { const int n = rho >> 4, i = rho & 15; return 8 * (i >> 2) + 4 * n + (i & 3); }
struct Unit { int pm, pn; };
struct Gemm { const bf16_t* A; const bf16_t* Bt; };
struct StaticOrder {
    int nM, nN, nwg, G, c;
    __host__ __device__ void init(int M, int N, int G_, int c_) { nM = M / BM; nN = N / BM; nwg = nM * nN; G = G_; c = c_; }
    __host__ __device__ bool next(int i, Unit& u) const {
        const long L = (long)i * G + c; if (L >= nwg) return false;
        int wgid = (int)L; { const int q = nwg / NXCD, r = nwg % NXCD, xcd = wgid % NXCD, off = wgid / NXCD; wgid = (xcd < r ? xcd * (q + 1) : r * (q + 1) + (xcd - r) * q) + off; }
        const int nig = WGM * nN, gid = wgid / nig, fm = gid * WGM, gsz = (nM - fm) < WGM ? (nM - fm) : WGM;
        u.pm = fm + ((wgid % nig) % gsz); u.pn = (wgid % nig) / gsz; return true;
    }
    __device__ __forceinline__ void a_ready(const Unit&) const {}
    __device__ __forceinline__ void done(const Unit&) const {}
};
__device__ __forceinline__ unsigned cvt_pk_bf16(float lo, float hi) { unsigned r; asm volatile("v_cvt_pk_bf16_f32 %0, %1, %2" : "=v"(r) : "v"(lo), "v"(hi)); return r; }
struct EpiF32 {
    static constexpr bool PERM = false, AFTER_DRAIN = false;
    float* C; int ldc;
    __device__ __forceinline__ void operator()(const f32x4 (&acc)[2][2][4][2], const Unit& u, int wr, int wc, int fr, int fq) const {
        const int row0 = u.pm * BM + wr * 64 + fr, col0 = u.pn * BM + wc * 32 + 4 * fq;
#pragma unroll
        for (int ai = 0; ai < 2; ++ai)
#pragma unroll
            for (int m = 0; m < 4; ++m) { float* rowp = C + (size_t)(row0 + ai * HALF + m * 16) * ldc + col0;
#pragma unroll
                for (int bj = 0; bj < 2; ++bj)
#pragma unroll
                    for (int n = 0; n < 2; ++n) *(f32x4*)(rowp + bj * HALF + n * 16) = acc[ai][bj][m][n]; }
    }
};
struct EpiBf16 {
    static constexpr bool PERM = true, AFTER_DRAIN = false;
    bf16_t* O; int ldc;
    __device__ __forceinline__ void operator()(const f32x4 (&acc)[2][2][4][2], const Unit& u, int wr, int wc, int fr, int fq) const {
        const int row0 = u.pm * BM + wr * 64 + fr, col0 = u.pn * BM + wc * 32 + 8 * fq;
#pragma unroll
        for (int ai = 0; ai < 2; ++ai)
#pragma unroll
            for (int m = 0; m < 4; ++m) { bf16_t* rowp = O + (size_t)(row0 + ai * HALF + m * 16) * ldc + col0;
#pragma unroll
                for (int bj = 0; bj < 2; ++bj) { const f32x4 v0 = acc[ai][bj][m][0], v1 = acc[ai][bj][m][1];
                    u32x4 w; w.x = cvt_pk_bf16(v0[0], v0[1]); w.y = cvt_pk_bf16(v0[2], v0[3]); w.z = cvt_pk_bf16(v1[0], v1[1]); w.w = cvt_pk_bf16(v1[2], v1[3]);
                    *(u32x4*)(rowp + bj * HALF) = w; } }
    }
};

template <int K, int LDA, int LDB, class Epi, class Sched, bool ALIGN_EPI = false, bool SP2 = false>
__device__ __forceinline__ void gemm_phase(PG8_LAS unsigned char* lds, const Gemm g, const Sched& S, const Epi& E) {
    int tid_ = threadIdx.x; asm volatile("" : "+v"(tid_));
    const int tid = tid_, wid = __builtin_amdgcn_readfirstlane(tid >> 6), lane = tid & 63, wr = wid >> 2, wc = wid & 3, fr = lane & 15, fq = lane >> 4;
    constexpr int nt = K / BK;
    unsigned voffA[2], voffB[2];
#pragma unroll
    for (int i = 0; i < 2; ++i) { int R, C; stage_rc(tid * 16 + i * 8192, R, C); const int Rb = Epi::PERM ? ((R & ~31) + perm32(R & 31)) : R;
        voffA[i] = (unsigned)(R * LDA + C) * 2u; voffB[i] = (unsigned)(Rb * LDB + C) * 2u; }
    constexpr size_t kstep = (size_t)(BK * 2);
    constexpr size_t hsA = (size_t)HALF * LDA * 2, hsB = (size_t)HALF * LDB * 2;
    constexpr size_t tsA = 2 * hsA, tsB = 2 * hsB;
    const unsigned ldsw = (unsigned)wid * 1024u;
    const int aoff = lds_byte(wr * 64 + fr, fq * 8), boff = lds_byte(wc * 32 + fr, fq * 8);
#define PG8_SA(b, h) (((b) * 2 + (h)) * HTB)
#define PG8_SB(b, h) ((4 + (b) * 2 + (h)) * HTB)
#define PG8_STAGE(bufoff, gbase, voff) do { _Pragma("unroll") for (int _i = 0; _i < 2; ++_i) \
        __builtin_amdgcn_global_load_lds((const unsigned*)((const char*)(gbase) + (voff)[_i]), (PG8_LAS unsigned*)(lds + (bufoff) + ldsw + _i * 8192), 16, 0, 0); } while (0)
#define PG8_LDA(dst, b, h) do { _Pragma("unroll") for (int m = 0; m < 4; ++m) _Pragma("unroll") for (int k = 0; k < 2; ++k) dst[m][k] = *(const PG8_LAS bf16x8*)(lds + PG8_SA(b, h) + aoff + m * 2048 + k * 1024); } while (0)
#define PG8_LDB(dst, b, h) do { _Pragma("unroll") for (int n = 0; n < 2; ++n) _Pragma("unroll") for (int k = 0; k < 2; ++k) dst[n][k] = *(const PG8_LAS bf16x8*)(lds + PG8_SB(b, h) + boff + n * 2048 + k * 1024); } while (0)
#define PG8_MMA(ai, bj, At, Bt) do { __builtin_amdgcn_s_setprio(1); _Pragma("unroll") for (int m = 0; m < 4; ++m) _Pragma("unroll") for (int n = 0; n < 2; ++n) _Pragma("unroll") for (int k = 0; k < 2; ++k) \
        acc[ai][bj][m][n] = __builtin_amdgcn_mfma_f32_16x16x32_bf16(Bt[n][k], At[m][k], acc[ai][bj][m][n], 0, 0, 0); __builtin_amdgcn_s_setprio(0); } while (0)
#define PG8_WAIT_V(n) asm volatile("s_waitcnt vmcnt(" #n ")" ::: "memory")
#define PG8_WAIT_L(n) asm volatile("s_waitcnt lgkmcnt(" #n ")" ::: "memory")
#define PG8_BAR __builtin_amdgcn_s_barrier()
#define PG8_SCHED __builtin_amdgcn_sched_barrier(0)
    Unit cur, nxt; int ui = 0;
    if (!S.next(0, cur)) return;
    f32x4 acc[2][2][4][2];
#pragma unroll
    for (int a = 0; a < 2; ++a)
#pragma unroll
        for (int b = 0; b < 2; ++b)
#pragma unroll
            for (int m = 0; m < 4; ++m)
#pragma unroll
                for (int n = 0; n < 2; ++n) acc[a][b][m][n] = (f32x4){0.f, 0.f, 0.f, 0.f};
    bf16x8 At[4][2], B0[2][2], B1[2][2];
    const char* cA = (const char*)g.A + (size_t)cur.pm * tsA; const char* cB = (const char*)g.Bt + (size_t)cur.pn * tsB;
    S.a_ready(cur);
    if constexpr (SP2) {
        PG8_STAGE(PG8_SB(0, 0), cB, voffB); PG8_STAGE(PG8_SB(0, 1), cB + hsB, voffB); PG8_STAGE(PG8_SA(0, 0), cA, voffA); PG8_STAGE(PG8_SA(0, 1), cA + hsA, voffA);
        if (wr == 1) PG8_BAR;
        PG8_WAIT_V(2); PG8_BAR;
        PG8_STAGE(PG8_SB(1, 0), cB + kstep, voffB); PG8_STAGE(PG8_SA(1, 0), cA + kstep, voffA); PG8_STAGE(PG8_SB(1, 1), cB + hsB + kstep, voffB);
        PG8_WAIT_V(6); PG8_BAR;
    } else {
        PG8_STAGE(PG8_SB(0, 0), cB, voffB); PG8_STAGE(PG8_SA(0, 0), cA, voffA); PG8_STAGE(PG8_SB(0, 1), cB + hsB, voffB); PG8_STAGE(PG8_SA(0, 1), cA + hsA, voffA);
        if (wr == 1) PG8_BAR;
        PG8_WAIT_V(4); PG8_BAR;
        PG8_STAGE(PG8_SB(1, 0), cB + kstep, voffB); PG8_STAGE(PG8_SA(1, 0), cA + kstep, voffA); PG8_STAGE(PG8_SB(1, 1), cB + hsB + kstep, voffB);
        PG8_WAIT_V(6); PG8_BAR;
    }
    for (;;) {
        const bool has_next = S.next(ui + 1, nxt);
        const char* nA = has_next ? (const char*)g.A + (size_t)nxt.pm * tsA : cA; const char* nB = has_next ? (const char*)g.Bt + (size_t)nxt.pn * tsB : cB;
#pragma unroll 1
        for (int t = 0; t < nt; t += 2) {
            const bool last = (t == nt - 2);
            const char* a1 = cA + (size_t)(t + 1) * kstep;
            const char* a2 = last ? nA : cA + (size_t)(t + 2) * kstep; const char* b2 = last ? nB : cB + (size_t)(t + 2) * kstep;
            const char* a3 = a2 + kstep; const char* b3 = b2 + kstep;
            if (last && has_next) S.a_ready(nxt);
            if constexpr (SP2) {
            PG8_LDB(B0, 0, 0); PG8_LDB(B1, 0, 1); PG8_SCHED; PG8_LDA(At, 0, 0); PG8_STAGE(PG8_SA(1, 1), a1 + hsA, voffA);
            PG8_WAIT_V(8); PG8_WAIT_L(0); PG8_BAR; PG8_MMA(0, 0, At, B0); PG8_MMA(0, 1, At, B1); PG8_BAR; PG8_SCHED;
            PG8_LDA(At, 0, 1); PG8_STAGE(PG8_SB(0, 0), b2, voffB); PG8_STAGE(PG8_SB(0, 1), b2 + hsB, voffB); PG8_STAGE(PG8_SA(0, 0), a2, voffA);
            PG8_WAIT_V(8); PG8_WAIT_L(0); PG8_BAR; PG8_MMA(1, 0, At, B0); PG8_MMA(1, 1, At, B1); PG8_BAR; PG8_SCHED;
            PG8_LDB(B0, 1, 0); PG8_LDB(B1, 1, 1); PG8_SCHED; PG8_LDA(At, 1, 0); PG8_STAGE(PG8_SA(0, 1), a2 + hsA, voffA);
            PG8_WAIT_V(8); PG8_WAIT_L(0); PG8_BAR; PG8_MMA(0, 0, At, B0); PG8_MMA(0, 1, At, B1); PG8_BAR; PG8_SCHED;
            PG8_LDA(At, 1, 1); PG8_STAGE(PG8_SB(1, 0), b3, voffB); PG8_STAGE(PG8_SB(1, 1), b3 + hsB, voffB); PG8_STAGE(PG8_SA(1, 0), a3, voffA);
            PG8_WAIT_V(8); PG8_WAIT_L(0); PG8_BAR; PG8_MMA(1, 0, At, B0); PG8_MMA(1, 1, At, B1); PG8_BAR; PG8_SCHED;
            } else {
            PG8_LDB(B0, 0, 0); PG8_SCHED; PG8_LDA(At, 0, 0); PG8_STAGE(PG8_SA(1, 1), a1 + hsA, voffA);
            PG8_WAIT_L(8); PG8_BAR; PG8_WAIT_L(0); PG8_MMA(0, 0, At, B0); PG8_BAR; PG8_SCHED;
            PG8_LDB(B1, 0, 1); PG8_STAGE(PG8_SB(0, 0), b2, voffB);
            PG8_BAR; PG8_WAIT_L(0); PG8_MMA(0, 1, At, B1); PG8_BAR;
            PG8_LDA(At, 0, 1); PG8_STAGE(PG8_SA(0, 0), a2, voffA);
            PG8_BAR; PG8_WAIT_L(0); PG8_MMA(1, 0, At, B0); PG8_BAR; PG8_SCHED;
            PG8_STAGE(PG8_SB(0, 1), b2 + hsB, voffB);
            PG8_WAIT_V(6); PG8_BAR; PG8_MMA(1, 1, At, B1); PG8_BAR;
            PG8_LDB(B0, 1, 0); PG8_SCHED; PG8_LDA(At, 1, 0); PG8_STAGE(PG8_SA(0, 1), a2 + hsA, voffA);
            PG8_WAIT_L(8); PG8_BAR; PG8_WAIT_L(0); PG8_MMA(0, 0, At, B0); PG8_BAR; PG8_SCHED;
            PG8_LDB(B1, 1, 1); PG8_STAGE(PG8_SB(1, 0), b3, voffB);
            PG8_BAR; PG8_WAIT_L(0); PG8_MMA(0, 1, At, B1); PG8_BAR;
            PG8_LDA(At, 1, 1); PG8_STAGE(PG8_SA(1, 0), a3, voffA);
            PG8_BAR; PG8_WAIT_L(0); PG8_MMA(1, 0, At, B0); PG8_BAR; PG8_SCHED;
            PG8_STAGE(PG8_SB(1, 1), b3 + hsB, voffB);
            PG8_WAIT_V(6); PG8_BAR; PG8_MMA(1, 1, At, B1); PG8_BAR;
            }
        }
        if constexpr (ALIGN_EPI) { if (wr == 0) PG8_BAR; }
        if constexpr (!Epi::AFTER_DRAIN) { E(acc, cur, wr, wc, fr, fq); S.done(cur); }
        if (!has_next) break;
#pragma unroll
        for (int a = 0; a < 2; ++a)
#pragma unroll
            for (int b = 0; b < 2; ++b)
#pragma unroll
                for (int m = 0; m < 4; ++m)
#pragma unroll
                    for (int n = 0; n < 2; ++n) acc[a][b][m][n] = (f32x4){0.f, 0.f, 0.f, 0.f};
        cur = nxt; cA = nA; cB = nB; ++ui;
        if constexpr (ALIGN_EPI) { if (wr == 1) PG8_BAR; }
    }
    PG8_WAIT_V(0);
    if constexpr (!ALIGN_EPI) { if (wr == 0) PG8_BAR; }
    PG8_BAR;
    if constexpr (Epi::AFTER_DRAIN) { E.fused(acc, cur, wr, wc, fr, fq, lds, wid, lane); S.done(cur); }
#undef PG8_SA
#undef PG8_SB
#undef PG8_STAGE
#undef PG8_LDA
#undef PG8_LDB
#undef PG8_MMA
#undef PG8_WAIT_V
#undef PG8_WAIT_L
#undef PG8_BAR
#undef PG8_SCHED
}
}
namespace att {
using f32x16 = __attribute__((ext_vector_type(16))) float;
using s16x4  = __attribute__((ext_vector_type(4))) short;
using u32x4  = __attribute__((ext_vector_type(4))) unsigned;
constexpr int NW = 8, QBLK = 32, KVBLK = 64;
constexpr int SHM_V = 16384, SHM_K = 16384, SHM_P = 8192;
constexpr int OFF_V = 0, OFF_K = 2 * SHM_V, OFF_P = OFF_K + 2 * SHM_K, OFF_WS = OFF_P + 2 * SHM_P, OFF_BIAS = OFF_WS + NW * 64 * 4, OFF_QPE = OFF_BIAS + 2048, LDS_ATT = OFF_QPE + NW * 4096;
constexpr float THR = 8.f;
#define KSWZ(row, colB) ((row) * 256 + ((colB) ^ (((row) & 7) << 4)))
#define PSWZ(row, colB) ((row) * 128 + ((colB) ^ ((((row) >> 1) & 7) << 4)))
#define SBAR() __builtin_amdgcn_sched_barrier(0)
DEVI int crow(int r, int hi) { return (r & 3) + 8 * (r >> 2) + 4 * hi; }
DEVI unsigned cvtpk(float lo, float hi) { unsigned r; asm volatile("v_cvt_pk_bf16_f32 %0, %1, %2" : "=v"(r) : "v"(lo), "v"(hi)); return r; }

template <int TYPE> DEVI void partialSM(f32x16& p0, f32x16& p1, float& m_reg, float& mn, float& alpha) {
  constexpr float SCALE = TYPE == 1 ? 0.07216878364870322f : 0.08838834764831845f;
  constexpr float C = SCALE * 1.4426950408889634f;
  float pmax = p0[0];
#pragma unroll
  for (int r = 1; r < 16; ++r) pmax = fmaxf(pmax, p0[r]);
#pragma unroll
  for (int r = 0; r < 16; ++r) pmax = fmaxf(pmax, p1[r]);
  { auto rr = __builtin_amdgcn_permlane32_swap(__float_as_uint(pmax), __float_as_uint(pmax), false, false);
    pmax = fmaxf(__uint_as_float(rr[0]), __uint_as_float(rr[1])); }
  if (__builtin_expect(__all(pmax - m_reg <= THR / SCALE), 1)) { mn = m_reg; alpha = 1.f; }
  else { mn = fmaxf(m_reg, pmax); alpha = __builtin_amdgcn_exp2f((m_reg - mn) * C); m_reg = mn; }
  const float mnC = -mn * C;
#pragma unroll
  for (int r = 0; r < 16; ++r) p0[r] = fmaf(p0[r], C, mnC);
#pragma unroll
  for (int r = 0; r < 16; ++r) p1[r] = fmaf(p1[r], C, mnC);
#pragma unroll
  for (int r = 0; r < 16; ++r) p0[r] = __builtin_amdgcn_exp2f(p0[r]);
}
DEVI void finishSM(f32x16& p0, f32x16& p1, float alpha, float& l_reg, bf16x8& pa0, bf16x8& pa1, bf16x8& pa2, bf16x8& pa3) {
#pragma unroll
  for (int r = 0; r < 16; ++r) p1[r] = __builtin_amdgcn_exp2f(p1[r]);
  float ps = 0;
#pragma unroll
  for (int r = 0; r < 16; ++r) ps += p0[r];
#pragma unroll
  for (int r = 0; r < 16; ++r) ps += p1[r];
  { auto rr = __builtin_amdgcn_permlane32_swap(__float_as_uint(ps), __float_as_uint(ps), false, false);
    ps = __uint_as_float(rr[0]) + __uint_as_float(rr[1]); }
  l_reg = l_reg * alpha + ps;
#define PK4(P, BASE, OUT) do { unsigned a0 = cvtpk(P[BASE + 0], P[BASE + 1]), a1 = cvtpk(P[BASE + 2], P[BASE + 3]);   \
    unsigned b0 = cvtpk(P[BASE + 4], P[BASE + 5]), b1 = cvtpk(P[BASE + 6], P[BASE + 7]);                              \
    auto r0 = __builtin_amdgcn_permlane32_swap(a0, b0, false, false); auto r1 = __builtin_amdgcn_permlane32_swap(a1, b1, false, false); \
    u32x4 w = {r0[0], r1[0], r0[1], r1[1]}; OUT = *reinterpret_cast<bf16x8*>(&w); } while (0)
  PK4(p0, 0, pa0); PK4(p0, 8, pa1); PK4(p1, 0, pa2); PK4(p1, 8, pa3);
#undef PK4
}
template <int TYPE> DEVI void qkt(f32x16& p0, f32x16& p1, const char* Ks, const char* Ps, const bf16x8* qr, const char* Qe, int r32, int hi) {
  p0 = f32x16{}; p1 = f32x16{};
#pragma unroll
  for (int d0 = 0; d0 < 8; ++d0) { const int cb = (d0 * 16 + hi * 8) * 2;
    const bf16x8 b0 = *reinterpret_cast<const bf16x8*>(Ks + KSWZ(r32, cb));
    const bf16x8 b1 = *reinterpret_cast<const bf16x8*>(Ks + KSWZ(32 + r32, cb));
    p0 = __builtin_amdgcn_mfma_f32_32x32x16_bf16(b0, qr[d0], p0, 0, 0, 0);
    p1 = __builtin_amdgcn_mfma_f32_32x32x16_bf16(b1, qr[d0], p1, 0, 0, 0); }
  if constexpr (TYPE == 1) {
#pragma unroll
    for (int d0 = 0; d0 < 4; ++d0) { const int cb = (d0 * 16 + hi * 8) * 2;
      const bf16x8 b0 = *reinterpret_cast<const bf16x8*>(Ps + PSWZ(r32, cb));
      const bf16x8 b1 = *reinterpret_cast<const bf16x8*>(Ps + PSWZ(32 + r32, cb));
      const bf16x8 qe = *reinterpret_cast<const bf16x8*>(Qe + PSWZ(r32, cb));
      p0 = __builtin_amdgcn_mfma_f32_32x32x16_bf16(b0, qe, p0, 0, 0, 0);
      p1 = __builtin_amdgcn_mfma_f32_32x32x16_bf16(b1, qe, p1, 0, 0, 0); }
  }
}
DEVI int v_st(int k, int c) { const int kk = (k & ~0xC) | ((k & 4) << 1) | ((k & 8) >> 1); return ((kk >> 3) * 4 + (c >> 5)) * 512 + ((kk & 7) * 32 + (c & 31)) * 2; }
DEVI int v_rd_base(int lane) { return ((lane & 3) << 3) | (((lane >> 2) & 3) << 6) | (((lane >> 4) & 1) << 5) | (((lane >> 5) & 1) << 8); }
constexpr int v_rd_off(int d0, int ks, int half) { return d0 * 512 + ks * 4096 + half * 2048; }
template <int OFF> DEVI s16x4 tr_read(int vb) { s16x4 r; asm volatile("ds_read_b64_tr_b16 %0, %1 offset:%2" : "=&v"(r) : "v"(vb), "i"(OFF) : "memory"); return r; }
template <int D0> DEVI void pv_one(f32x16& od, int vb, bf16x8 pa0, bf16x8 pa1, bf16x8 pa2, bf16x8 pa3) {
  const s16x4 l0 = tr_read<v_rd_off(D0, 0, 0)>(vb), h0 = tr_read<v_rd_off(D0, 0, 1)>(vb), l1 = tr_read<v_rd_off(D0, 1, 0)>(vb), h1 = tr_read<v_rd_off(D0, 1, 1)>(vb);
  const s16x4 l2 = tr_read<v_rd_off(D0, 2, 0)>(vb), h2 = tr_read<v_rd_off(D0, 2, 1)>(vb), l3 = tr_read<v_rd_off(D0, 3, 0)>(vb), h3 = tr_read<v_rd_off(D0, 3, 1)>(vb);
  asm volatile("s_waitcnt lgkmcnt(0)" ::: "memory"); SBAR();
#define PK(L, H) (bf16x8){L[0], L[1], L[2], L[3], H[0], H[1], H[2], H[3]}
  od = __builtin_amdgcn_mfma_f32_32x32x16_bf16(pa0, PK(l0, h0), od, 0, 0, 0);
  od = __builtin_amdgcn_mfma_f32_32x32x16_bf16(pa1, PK(l1, h1), od, 0, 0, 0);
  od = __builtin_amdgcn_mfma_f32_32x32x16_bf16(pa2, PK(l2, h2), od, 0, 0, 0);
  od = __builtin_amdgcn_mfma_f32_32x32x16_bf16(pa3, PK(l3, h3), od, 0, 0, 0);
#undef PK
}
DEVI void pv_d0(f32x16* o, int vb, bf16x8 pa0, bf16x8 pa1, bf16x8 pa2, bf16x8 pa3) {
  pv_one<0>(o[0], vb, pa0, pa1, pa2, pa3); pv_one<1>(o[1], vb, pa0, pa1, pa2, pa3); pv_one<2>(o[2], vb, pa0, pa1, pa2, pa3); pv_one<3>(o[3], vb, pa0, pa1, pa2, pa3);
}
DEVI void nb_mask(f32x16& p0, f32x16& p1, int kr, int r, int r0, int c, int c0, int hi, const float* bt) {
  const bool active = (unsigned)(kr - r0) < 8u;
  if (!active) {
#pragma unroll
    for (int i = 0; i < 16; ++i) { p0[i] = -1e30f; p1[i] = -1e30f; }
  } else {
    const float* bp = bt + (kr - r + 7) * 31 + 15 - c + 4 * hi;
    const int dk = 4 * hi - c0;
#pragma unroll
    for (int i = 0; i < 16; ++i) { const int kc = (i & 3) + 8 * (i >> 2);
      p0[i] = ((unsigned)(kc + dk) < 16u) ? p0[i] + bp[kc] : -1e30f;
      p1[i] = ((unsigned)(kc + 32 + dk) < 16u) ? p1[i] + bp[kc + 32] : -1e30f; }
  }
}

template <int TYPE, int SDEPTH>
DEVI void attn_unit(int b, int h, int qb, const bf16_t* __restrict__ PROJ, const bf16_t* __restrict__ QB, const bf16_t* __restrict__ KVB,
                    const float* __restrict__ rpb, const float2* __restrict__ tab, bf16_t* __restrict__ MIX, char* lds) {
  constexpr float SCALE = TYPE == 1 ? 0.07216878364870322f : 0.08838834764831845f;
  constexpr int NQ = 8;
  constexpr int LDQ = TYPE == 1 ? 768 : NP, LDK = TYPE == 1 ? 1024 : NP;
  int tid_ = threadIdx.x; asm volatile("" : "+v"(tid_));
  const int tid = tid_, wid = tid >> 6, lane = tid & 63, r32 = lane & 31, hi = lane >> 5;
  const size_t row0 = (size_t)b * SEQ + qb * 256, kb0 = (size_t)b * SEQ;
  const bf16_t* Qp = TYPE == 0 ? PROJ + row0 * NP + C_AQ + h * 128 : TYPE == 2 ? PROJ + row0 * NP + C_CQ + h * 128 : QB + row0 * 768 + h * 128;
  const bf16_t* Kh = TYPE == 0 ? PROJ + kb0 * NP + C_AK + (h >> 2) * 128 : TYPE == 2 ? PROJ + kb0 * NP + C_CK + h * 128 : KVB + kb0 * 1024 + h * 256;
  const bf16_t* Vh = TYPE == 0 ? PROJ + kb0 * NP + C_AV + (h >> 2) * 128 : TYPE == 2 ? PROJ + kb0 * NP + C_CV + h * 128 : KVB + kb0 * 1024 + h * 256 + 128;
  const bf16_t* Ph = PROJ + kb0 * NP + C_BKR;
  char* V_lds = lds + OFF_V; char* K_lds = lds + OFF_K; char* P_lds = lds + OFF_P;
  float* wsf = (float*)(lds + OFF_WS) + wid * 64; float* li_l = wsf; float* al_l = wsf + 32;
  float* bt = (float*)(lds + OFF_BIAS);
  int kt0 = 0, NT = SEQ / KVBLK;
  if (TYPE == 2) { if (qb == 0) { kt0 = 0; NT = 8; } else if (qb == 7) { kt0 = 24; NT = 8; } else { kt0 = min(4 * qb - 4, 20); NT = 12; } }
  const int nr = 4 * qb + (wid >> 1), nc = 32 * (wid & 1) + r32, nr0 = min(max(nr - 4, 0), 24), nc0 = min(max(nc - 8, 0), 48);
  if (TYPE == 2) { for (int i = tid; i < 465; i += 512) bt[i] = rpb[h * 465 + i] * (1.f / SCALE); }
  float m_reg = -1e30f, l_reg = 0; f32x16 o[4] = {}; bf16x8 qr[NQ];
  const bf16_t* Qw = Qp + (size_t)(wid * QBLK + r32) * LDQ + hi * 8;
#pragma unroll
  for (int d0 = 0; d0 < 8; ++d0) qr[d0] = *reinterpret_cast<const bf16x8*>(Qw + d0 * 16);
  const char* Qe = lds + OFF_QPE + wid * 4096;
  if constexpr (TYPE == 1) {
#pragma unroll
    for (int i = 0; i < 4; ++i) { const int idx = i * 64 + lane, rw = idx >> 3, ch = idx & 7;
      const u32x4 v = *reinterpret_cast<const u32x4*>(QB + (row0 + wid * QBLK + rw) * 768 + 512 + h * 64 + ch * 8);
      const int t_ = qb * 256 + wid * QBLK + rw;
      const float4* tp = (const float4*)(tab + ((ch >> 2) == 0 ? T_BR + (t_ >> 6) * 16 : T_BC + (t_ & 63) * 16) + (ch & 3) * 4);
      const float4 cs01 = tp[0], cs23 = tp[1]; u32x4 w;
      { const float x1 = bf2f(v[0] & 0xffffu), x2 = bf2f(v[0] >> 16); w[0] = pk2(x1 * cs01.x - x2 * cs01.y, x2 * cs01.x + x1 * cs01.y); }
      { const float x1 = bf2f(v[1] & 0xffffu), x2 = bf2f(v[1] >> 16); w[1] = pk2(x1 * cs01.z - x2 * cs01.w, x2 * cs01.z + x1 * cs01.w); }
      { const float x1 = bf2f(v[2] & 0xffffu), x2 = bf2f(v[2] >> 16); w[2] = pk2(x1 * cs23.x - x2 * cs23.y, x2 * cs23.x + x1 * cs23.y); }
      { const float x1 = bf2f(v[3] & 0xffffu), x2 = bf2f(v[3] >> 16); w[3] = pk2(x1 * cs23.z - x2 * cs23.w, x2 * cs23.z + x1 * cs23.w); }
      *(u32x4*)(lds + OFF_QPE + wid * 4096 + PSWZ(rw, ch * 16)) = w; } }
  const int sr = tid >> 4, sc = (tid & 15) * 8, vst0 = v_st(sr, sc), vst1 = v_st(32 + sr, sc);
  const int pr_ = tid >> 3, pc_ = (tid & 7) * 8;
  const int vb0 = (int)(uintptr_t)V_lds + v_rd_base(lane);
  struct { bf16x8 vs0, vs1, ks0, ks1, ps; } sr_[SDEPTH];
#define SLOAD(i, k0) do { const size_t kk_ = (size_t)(kt0 * KVBLK + (k0)); \
    sr_[i].vs0 = *reinterpret_cast<const bf16x8*>(&Vh[(kk_ + sr) * LDK + sc]); sr_[i].vs1 = *reinterpret_cast<const bf16x8*>(&Vh[(kk_ + 32 + sr) * LDK + sc]); \
    sr_[i].ks0 = *reinterpret_cast<const bf16x8*>(&Kh[(kk_ + sr) * LDK + sc]); sr_[i].ks1 = *reinterpret_cast<const bf16x8*>(&Kh[(kk_ + 32 + sr) * LDK + sc]); \
    if constexpr (TYPE == 1) sr_[i].ps = *reinterpret_cast<const bf16x8*>(&Ph[(kk_ + pr_) * NP + pc_]); } while (0)
#define SWRITE(bf, i) do { *(bf16x8*)(V_lds + (bf) * SHM_V + vst0) = sr_[i].vs0; *(bf16x8*)(V_lds + (bf) * SHM_V + vst1) = sr_[i].vs1; const int kc = sc * 2; \
    *(bf16x8*)(K_lds + (bf) * SHM_K + KSWZ(sr, kc)) = sr_[i].ks0; *(bf16x8*)(K_lds + (bf) * SHM_K + KSWZ(32 + sr, kc)) = sr_[i].ks1; \
    if constexpr (TYPE == 1) *(bf16x8*)(P_lds + (bf) * SHM_P + PSWZ(pr_, pc_ * 2)) = sr_[i].ps; } while (0)
#define SWAIT() do { if constexpr (SDEPTH == 2) { if constexpr (TYPE == 1) asm volatile("s_waitcnt vmcnt(5)" ::: "memory"); else asm volatile("s_waitcnt vmcnt(4)" ::: "memory"); } \
    else asm volatile("s_waitcnt vmcnt(0)" ::: "memory"); } while (0)
#define RESC(a) do { if (__any((a) < 1.f)) { if (hi == 0) al_l[r32] = (a); asm volatile("s_waitcnt lgkmcnt(0)" ::: "memory"); \
    _Pragma("unroll") for (int d = 0; d < 4; ++d) _Pragma("unroll") for (int r = 0; r < 16; ++r) o[d][r] *= al_l[crow(r, hi)]; } } while (0)
#define MASK(P0, P1, j) do { if constexpr (TYPE == 2) nb_mask(P0, P1, kt0 + (j), nr, nr0, nc, nc0, hi, bt); } while (0)
  f32x16 pA0, pA1, pB0, pB1; float mnA, mnB, alA, alB; bf16x8 pa0, pa1, pa2, pa3;
  constexpr int SE = 0, SO = SDEPTH - 1;
  SLOAD(SE, 0); asm volatile("s_waitcnt vmcnt(0)" ::: "memory"); SWRITE(0, SE); __syncthreads();
  qkt<TYPE>(pA0, pA1, K_lds, P_lds, qr, Qe, r32, hi); MASK(pA0, pA1, 0); partialSM<TYPE>(pA0, pA1, m_reg, mnA, alA);
  SLOAD(SO, KVBLK); if constexpr (SDEPTH == 2) { if (2 < NT) SLOAD(SE, 2 * KVBLK); }
  SWAIT(); SWRITE(1, SO); __syncthreads();
  for (int j = 1; j + 1 < NT; j += 2) {
    SBAR(); qkt<TYPE>(pB0, pB1, K_lds + SHM_K, P_lds + SHM_P, qr, Qe, r32, hi); MASK(pB0, pB1, j);
    finishSM(pA0, pA1, alA, l_reg, pa0, pa1, pa2, pa3); SBAR();
    SLOAD(SO, (j + SDEPTH) * KVBLK); SBAR();
    pv_d0(o, vb0, pa0, pa1, pa2, pa3); partialSM<TYPE>(pB0, pB1, m_reg, mnB, alB);
    __syncthreads(); SWAIT(); SWRITE(0, SE);
    RESC(alB); __syncthreads();
    SBAR(); qkt<TYPE>(pA0, pA1, K_lds, P_lds, qr, Qe, r32, hi); MASK(pA0, pA1, j + 1);
    finishSM(pB0, pB1, alB, l_reg, pa0, pa1, pa2, pa3); SBAR();
    if (SDEPTH == 1 || j + 3 < NT) SLOAD(SE, (j + 1 + SDEPTH) * KVBLK); SBAR();
    pv_d0(o, vb0 + SHM_V, pa0, pa1, pa2, pa3); partialSM<TYPE>(pA0, pA1, m_reg, mnA, alA);
    __syncthreads(); SWAIT(); SWRITE(1, SO);
    RESC(alA); __syncthreads();
  }
  SBAR(); qkt<TYPE>(pB0, pB1, K_lds + SHM_K, P_lds + SHM_P, qr, Qe, r32, hi); MASK(pB0, pB1, NT - 1);
  finishSM(pA0, pA1, alA, l_reg, pa0, pa1, pa2, pa3); SBAR();
  pv_d0(o, vb0, pa0, pa1, pa2, pa3); partialSM<TYPE>(pB0, pB1, m_reg, mnB, alB);
  __syncthreads(); RESC(alB);
  finishSM(pB0, pB1, alB, l_reg, pa0, pa1, pa2, pa3); SBAR();
  pv_d0(o, vb0 + SHM_V, pa0, pa1, pa2, pa3);
  if (hi == 0) li_l[r32] = l_reg; asm volatile("s_waitcnt lgkmcnt(0)" ::: "memory");
  float rli[16];
#pragma unroll
  for (int r = 0; r < 16; ++r) rli[r] = __builtin_amdgcn_rcpf(li_l[crow(r, hi)]);
  __syncthreads();
  bf16_t* stg = (bf16_t*)(lds + wid * 8192);
#pragma unroll
  for (int r = 0; r < 16; ++r) { const int orow = crow(r, hi);
#pragma unroll
    for (int d0 = 0; d0 < 4; ++d0) stg[orow * 128 + d0 * 32 + r32] = (bf16_t)f2bf(o[d0][r] * rli[r]); }
  asm volatile("s_waitcnt lgkmcnt(0)" ::: "memory");
  constexpr int GCOL = TYPE == 0 ? C_AG : TYPE == 1 ? C_BG : C_CG, MCOL = TYPE == 0 ? 0 : TYPE == 1 ? 1024 : 1536;
  const bf16_t* Gp = PROJ + (row0 + wid * QBLK) * NP + GCOL + h * 128; bf16_t* Op = MIX + (row0 + wid * QBLK) * DMIX + MCOL + h * 128;
#pragma unroll
  for (int i = 0; i < 8; ++i) { const int pidx = i * 64 + lane, row = pidx >> 4, ch = pidx & 15;
    const u32x4 ov = *(const u32x4*)(stg + row * 128 + ch * 8); const u32x4 gv = *(const u32x4*)(Gp + (size_t)row * NP + ch * 8);
    u32x4 w;
#pragma unroll
    for (int e = 0; e < 4; ++e) { const float g0 = bf2f(gv[e] & 0xffffu), g1 = bf2f(gv[e] >> 16), o0 = bf2f(ov[e] & 0xffffu), o1 = bf2f(ov[e] >> 16);
      w[e] = pk2(o0 * g0 * __builtin_amdgcn_rcpf(1.f + __expf(-g0)), o1 * g1 * __builtin_amdgcn_rcpf(1.f + __expf(-g1))); }
    *(u32x4*)(Op + (size_t)row * DMIX + ch * 8) = w; }
  __syncthreads();
#undef SLOAD
#undef SWRITE
#undef SWAIT
#undef RESC
#undef MASK
}
#undef SBAR
}
#ifndef AMASK
#define AMASK 7
#endif
constexpr int NWAVES = 8;
constexpr int N_PHASES = 1 + 6 * DEPTH;
constexpr size_t WS_CTL = 0, CTL_ZERO_BYTES = 64 * 1024;
constexpr int CW_BAR = 1024;
constexpr int RING_OFF = 0, RING_BYTES = 131072;
constexpr int LDSCTL_OFF = RING_BYTES, MISC_OFF = LDSCTL_OFF + 320;
constexpr int LDS_BYTES = 147456;

#define GAS __attribute__((address_space(1)))
#define LAS __attribute__((address_space(3)))
typedef GAS unsigned gu32;
#define RLX_AGENT __ATOMIC_RELAXED, __HIP_MEMORY_SCOPE_AGENT

#define XB_TMO      128
#define XB_XCNT(j)  (256  + 64 * (j))
#define XB_XSUB(j)  (1280 + 64 * (j))
#define XB_XGEN(j)  (2304 + 64 * (j))
#define XB_TOP      3328
#define XB_TOPGEN   3392
#define XCD_BAR_WORDS 3456
#define XB_SPIN_CAP (1u << 18)
__device__ __forceinline__ unsigned xb_ld(unsigned* p)              { return __hip_atomic_load(p, __ATOMIC_RELAXED, __HIP_MEMORY_SCOPE_AGENT); }
__device__ __forceinline__ unsigned xb_add(unsigned* p, unsigned v) { return __hip_atomic_fetch_add(p, v, __ATOMIC_RELAXED, __HIP_MEMORY_SCOPE_AGENT); }
__device__ __forceinline__ unsigned xb_xcc_id() { return (unsigned)__builtin_amdgcn_s_getreg((3 << 11) | 20) & 0xFu; }
#define XB_SPIN(cond, bar) do { unsigned _sp = 0; while (cond) { __builtin_amdgcn_s_sleep(1); \
    if ((++_sp & 255u) == 0u) { if (xb_ld(&(bar)[XB_TMO])) break; if (_sp > XB_SPIN_CAP) { atomicAdd(&(bar)[XB_TMO], 1u); break; } } } } while (0)
struct XcdBarrier { unsigned* bar; unsigned x; volatile LAS unsigned* st; };
__device__ __forceinline__ XcdBarrier xcd_barrier_post(unsigned* bar, volatile LAS unsigned* st) {
    XcdBarrier b; b.bar = bar; b.x = xb_xcc_id(); b.st = st;
    if (threadIdx.x == 0) (void)xb_add(&bar[XB_XCNT(b.x)], 1u);
    return b;
}
__device__ __forceinline__ void xcd_barrier_complete(unsigned* bar, unsigned x, unsigned& nloc, unsigned& nx) {
    const unsigned G = gridDim.x * gridDim.y * gridDim.z;
    unsigned sum, cnt, mine, sp = 0u;
    for (;;) {
        sum = 0u; cnt = 0u; mine = 0u;
#pragma unroll
        for (unsigned j = 0; j < 16; ++j) { const unsigned c = xb_ld(&bar[XB_XCNT(j)]); sum += c; cnt += (c > 0u) ? 1u : 0u; mine = (j == x) ? c : mine; }
        if (sum == G) break;
        __builtin_amdgcn_s_sleep(1);
        if ((++sp & 255u) == 0u) { if (xb_ld(&bar[XB_TMO])) break; if (sp > XB_SPIN_CAP) { atomicAdd(&bar[XB_TMO], 1u); break; } }
    }
    nloc = mine > 0u ? mine : 1u; nx = cnt > 0u ? cnt : 1u;
}
__device__ __forceinline__ void xcd_barrier(const XcdBarrier& b) {
    asm volatile("s_waitcnt vmcnt(0)" ::: "memory");
    __syncthreads();
    if (threadIdx.x == 0) {
        unsigned* bar = b.bar;
        __builtin_amdgcn_s_waitcnt(0);
        unsigned nloc = b.st[0], nx = b.st[1];
        if (nloc == 0u) { xcd_barrier_complete(bar, b.x, nloc, nx); b.st[0] = nloc; b.st[1] = nx; }
        const unsigned old = xb_add(&bar[XB_XSUB(b.x)], 1u);
        const unsigned gen = old / nloc;
        if (old + 1u == (gen + 1u) * nloc) {
            __builtin_amdgcn_fence(__ATOMIC_RELEASE, "agent");
            asm volatile("s_waitcnt vmcnt(0)" ::: "memory");
            const unsigned og = xb_add(&bar[XB_TOP], 1u);
            const unsigned tg = og / nx;
            if (og + 1u == (tg + 1u) * nx) xb_add(&bar[XB_TOPGEN], 1u);
            else XB_SPIN(xb_ld(&bar[XB_TOPGEN]) == tg, bar);
            __builtin_amdgcn_fence(__ATOMIC_ACQUIRE, "agent");
            xb_add(&bar[XB_XGEN(b.x)], 1u);
            asm volatile("s_waitcnt vmcnt(0)" ::: "memory");
        } else {
            XB_SPIN(xb_ld(&bar[XB_XGEN(b.x)]) == gen, bar);
            __builtin_amdgcn_fence(__ATOMIC_ACQUIRE, "agent");
            asm volatile("s_waitcnt vmcnt(0)" ::: "memory");
        }
    }
    __syncthreads();
}

struct Args {
    const float* in[12]; float* out; unsigned char* ws;
    int ph_lo, ph_hi, li, amask;
};


DEVI void p0_transpose_item(const float* __restrict__ W, int K, int Ns, int Nd, int mode, bf16_t* __restrict__ WT, LAS float* scr, int item, int lane) {
    const int nblk = Nd / 32, kb = item / nblk, nb = item % nblk, k0 = 64 * kb, n0 = 32 * nb;
    const int so = map_col(mode, n0 + (lane & 31));
#pragma unroll 8
    for (int i = 0; i < 32; ++i) { const int kk = 2 * i + (lane >> 5); scr[kk * 33 + (lane & 31)] = so >= 0 ? W[(size_t)(k0 + kk) * Ns + so] : 0.f; }
    asm volatile("s_waitcnt lgkmcnt(0)" ::: "memory");
    const int c = lane & 7;
#pragma unroll
    for (int j = 0; j < 4; ++j) { const int n = (lane >> 3) + 8 * j; const LAS float* s = scr + (8 * c) * 33 + n;
        uint4 o; o.x = pk2(s[0 * 33], s[1 * 33]); o.y = pk2(s[2 * 33], s[3 * 33]); o.z = pk2(s[4 * 33], s[5 * 33]); o.w = pk2(s[6 * 33], s[7 * 33]);
        *(uint4*)(WT + (size_t)(n0 + n) * K + k0 + 8 * c) = o; }
    asm volatile("s_waitcnt lgkmcnt(0)" ::: "memory");
}
DEVI void rmsnorm_row_xn(const float* __restrict__ xrow, const float* __restrict__ g, bf16_t* __restrict__ orow, int lane) {
    const float4* xr = (const float4*)xrow + lane;
    float4 v[8]; float ss = 0.f;
#pragma unroll
    for (int j = 0; j < 8; ++j) { v[j] = xr[64 * j]; ss += v[j].x * v[j].x + v[j].y * v[j].y + v[j].z * v[j].z + v[j].w * v[j].w; }
    const float rs = rsqrtf(wave_sum(ss) * (1.f / DM) + EPS);
    uint2* o = (uint2*)orow + lane;
#pragma unroll
    for (int j = 0; j < 8; ++j) { const float4 gg = ((const float4*)g)[lane + 64 * j];
        o[64 * j] = make_uint2(pk2(v[j].x * rs * gg.x, v[j].y * rs * gg.y), pk2(v[j].z * rs * gg.z, v[j].w * rs * gg.w)); }
}
DEVI void phase_prologue(const Args& args, LAS unsigned char* L, int gw, int NGW, int wave, int lane) {
    unsigned char* ws = args.ws;
    LAS float* scr = (LAS float*)(L + RING_OFF + wave * 16384);
    constexpr int I_IN = (DM / 64) * (NP / 32), I_OUT = (DMIX / 64) * (DM / 32), I_UQ = (512 / 64) * (768 / 32), I_UKV = (256 / 64) * (1024 / 32), I_L = I_IN + I_OUT + I_UQ + I_UKV;
    for (int it = gw; it < DEPTH * I_L; it += NGW) {
        const int l = it / I_L; int r = it % I_L;
        if (r < I_IN) { p0_transpose_item(args.in[3] + (size_t)l * DM * DIN, DM, DIN, NP, 1, (bf16_t*)(ws + WS_WIN + l * WIN_L), scr, r, lane); continue; } r -= I_IN;
        if (r < I_OUT) { p0_transpose_item(args.in[11] + (size_t)l * DMIX * DM, DMIX, DM, DM, 0, (bf16_t*)(ws + WS_WOUT + l * WOUT_L), scr, r, lane); continue; } r -= I_OUT;
        if (r < I_UQ) { p0_transpose_item(args.in[8] + (size_t)l * 512 * 768, 512, 768, 768, 2, (bf16_t*)(ws + WS_WUQ + l * WUQ_L), scr, r, lane); continue; } r -= I_UQ;
        p0_transpose_item(args.in[9] + (size_t)l * 256 * 1024, 256, 1024, 1024, 0, (bf16_t*)(ws + WS_WUKV + l * WUKV_L), scr, r, lane);
    }
    bf16_t* XN = (bf16_t*)(ws + WS_XN);
    for (int m = gw; m < M; m += NGW) rmsnorm_row_xn(args.in[0] + (size_t)m * DM, args.in[1], XN + (size_t)m * DM, lane);
    float2* tab = (float2*)(ws + WS_TAB);
    for (int i = gw * 64 + lane; i < T_N; i += NGW * 64) {
        int pos, j; float n;
        if (i < T_AC) { pos = i >> 5; j = i & 31; n = 64.f; }
        else if (i < T_BR) { pos = (i - T_AC) >> 5; j = i & 31; n = 64.f; }
        else if (i < T_BC) { pos = (i - T_BR) >> 4; j = i & 15; n = 32.f; }
        else { pos = (i - T_BC) >> 4; j = i & 15; n = 32.f; }
        const float inv = 1.0f / powf(10000.f, (float)(2 * j) / n);
        const float ang = (float)pos * inv;
        const float k = rintf(ang * 0.15915494309189535f);
        float r = fmaf(-k, 6.28318548202514648f, ang); r = fmaf(-k, -1.74845553e-7f, r);
        tab[i] = make_float2(cosf(r), sinf(r));
    }
}
DEVI void postproj_row(bf16_t* __restrict__ p, int row, int lane, const float* __restrict__ a_qn, const float* __restrict__ a_kn,
                       const float* __restrict__ b_qn, const float* __restrict__ b_kvn, const float2* __restrict__ tab) {
    const int t = row & (SEQ - 1), pr = t >> 6, pc = t & 63;
    {
        const int a = lane >> 5, j = lane & 31;
        const float2 cs = a == 0 ? tab[T_AR + pr * 32 + j] : tab[T_AC + pc * 32 + j];
        const int d1 = 64 * a + j, d2 = d1 + 32;
        const float gq1 = a_qn[d1], gq2 = a_qn[d2], gk1 = a_kn[d1], gk2 = a_kn[d2];
        unsigned v[10];
#pragma unroll
        for (int hb = 0; hb < 10; ++hb) v[hb] = ((const unsigned*)(p + hb * 128))[lane];
#pragma unroll
        for (int hb = 0; hb < 10; ++hb) {
            const float x1 = bf2f(v[hb] & 0xffffu), x2 = bf2f(v[hb] >> 16);
            const float rs = rsqrtf(wave_sum(x1 * x1 + x2 * x2) * (1.f / 128.f) + EPS);
            const float y1 = x1 * rs * (hb < 8 ? gq1 : gk1), y2 = x2 * rs * (hb < 8 ? gq2 : gk2);
            ((unsigned*)(p + hb * 128))[lane] = pk2(y1 * cs.x - y2 * cs.y, y2 * cs.x + y1 * cs.y);
        }
    }
    {
        uint4* pp = (uint4*)(p + C_BCQ) + lane; const uint4 v = *pp; float x[8];
        x[0] = bf2f(v.x & 0xffffu); x[1] = bf2f(v.x >> 16); x[2] = bf2f(v.y & 0xffffu); x[3] = bf2f(v.y >> 16);
        x[4] = bf2f(v.z & 0xffffu); x[5] = bf2f(v.z >> 16); x[6] = bf2f(v.w & 0xffffu); x[7] = bf2f(v.w >> 16);
        float ss = 0.f;
#pragma unroll
        for (int i = 0; i < 8; ++i) ss += x[i] * x[i];
        const float rs = rsqrtf(wave_sum(ss) * (1.f / 512.f) + EPS);
        const float4 g0 = ((const float4*)b_qn)[2 * lane], g1 = ((const float4*)b_qn)[2 * lane + 1];
        *pp = make_uint4(pk2(x[0] * rs * g0.x, x[1] * rs * g0.y), pk2(x[2] * rs * g0.z, x[3] * rs * g0.w),
                         pk2(x[4] * rs * g1.x, x[5] * rs * g1.y), pk2(x[6] * rs * g1.z, x[7] * rs * g1.w));
    }
    {
        uint2* pp = (uint2*)(p + C_BCKV) + lane; const uint2 v = *pp;
        const float x0 = bf2f(v.x & 0xffffu), x1 = bf2f(v.x >> 16), x2 = bf2f(v.y & 0xffffu), x3 = bf2f(v.y >> 16);
        const float rs = rsqrtf(wave_sum(x0 * x0 + x1 * x1 + x2 * x2 + x3 * x3) * (1.f / 256.f) + EPS);
        const float4 g = ((const float4*)b_kvn)[lane];
        *pp = make_uint2(pk2(x0 * rs * g.x, x1 * rs * g.y), pk2(x2 * rs * g.z, x3 * rs * g.w));
    }
    if (lane < 32) {
        const int a = lane >> 4, j = lane & 15;
        const float2 cs = a == 0 ? tab[T_BR + pr * 16 + j] : tab[T_BC + pc * 16 + j];
        unsigned* pp = (unsigned*)(p + C_BKR) + lane; const unsigned v = *pp; const float x1 = bf2f(v & 0xffffu), x2 = bf2f(v >> 16);
        *pp = pk2(x1 * cs.x - x2 * cs.y, x2 * cs.x + x1 * cs.y);
    }
}
DEVI void rowpass_row(const float* __restrict__ yrow, const float* xrow, const float* __restrict__ g_post, float* orow_, const float* __restrict__ g_next, bf16_t* __restrict__ xnrow, int lane) {
    const float4* yr = (const float4*)yrow + lane; const float4* xr = (const float4*)xrow + lane;
    float4 v[8]; float ss = 0.f;
#pragma unroll
    for (int j = 0; j < 8; ++j) { v[j] = yr[64 * j]; ss += v[j].x * v[j].x + v[j].y * v[j].y + v[j].z * v[j].z + v[j].w * v[j].w; }
    const float rs = rsqrtf(wave_sum(ss) * (1.f / DM) + EPS);
    float4* orow = (float4*)orow_ + lane; float s2 = 0.f;
#pragma unroll
    for (int j = 0; j < 8; ++j) { const float4 gg = ((const float4*)g_post)[lane + 64 * j]; const float4 xx = xr[64 * j];
        v[j].x = xx.x + v[j].x * rs * gg.x; v[j].y = xx.y + v[j].y * rs * gg.y; v[j].z = xx.z + v[j].z * rs * gg.z; v[j].w = xx.w + v[j].w * rs * gg.w;
        orow[64 * j] = v[j]; s2 += v[j].x * v[j].x + v[j].y * v[j].y + v[j].z * v[j].z + v[j].w * v[j].w; }
    if (g_next) {
        const float r2 = rsqrtf(wave_sum(s2) * (1.f / DM) + EPS);
        uint2* o = (uint2*)xnrow + lane;
#pragma unroll
        for (int j = 0; j < 8; ++j) { const float4 gg = ((const float4*)g_next)[lane + 64 * j];
            o[64 * j] = make_uint2(pk2(v[j].x * r2 * gg.x, v[j].y * r2 * gg.y), pk2(v[j].z * r2 * gg.z, v[j].w * r2 * gg.w)); }
    }
}

__global__ void __launch_bounds__(NWAVES * 64, 2) mk_fwd(Args args) {
    extern __shared__ __attribute__((aligned(16))) unsigned char lds[];
    LAS unsigned char* L = (LAS unsigned char*)lds;
    volatile LAS unsigned* MISC = (volatile LAS unsigned*)(L + MISC_OFF);
    const int G = gridDim.x; const int bx = blockIdx.x;
    const int vcu = (G % 8 == 0) ? (bx % 8) * (G / 8) + bx / 8 : bx;
    unsigned char* ws = args.ws;
    gu32* ctl = (gu32*)(ws + WS_CTL);
    for (int u = threadIdx.x; u < (LDS_BYTES - LDSCTL_OFF) / 4; u += NWAVES * 64) ((LAS unsigned*)(L + LDSCTL_OFF))[u] = 0u;
    __syncthreads();
    XcdBarrier bar; bar.bar = (unsigned*)(ctl + CW_BAR) + args.li * XCD_BAR_WORDS; bar.x = 0; bar.st = nullptr;
    const bool multi = (args.ph_hi - args.ph_lo) > 1;
    if (multi) bar = xcd_barrier_post((unsigned*)(ctl + CW_BAR) + args.li * XCD_BAR_WORDS, MISC + 8);
    bf16_t* XN = (bf16_t*)(ws + WS_XN); bf16_t* PROJ = (bf16_t*)(ws + WS_PROJ); float* Y = (float*)(ws + WS_Y);
    bf16_t* QB = (bf16_t*)(ws + WS_QB); bf16_t* KVB = (bf16_t*)(ws + WS_KVB); bf16_t* MIX = (bf16_t*)(ws + WS_MIX);
    const int lo = args.ph_lo, hi = args.ph_hi;
#define IN(k) (lo <= (k) && (k) < hi)
#define SEAM(k) do { if (IN(k) && IN((k) + 1)) xcd_barrier(bar); } while (0)
    const int NGW = G * NWAVES;
#define FRESH_IDS() int tid__ = threadIdx.x; asm volatile("" : "+v"(tid__)); const int lane_ = tid__ & 63, wave_ = __builtin_amdgcn_readfirstlane(tid__ >> 6), gw_ = vcu * NWAVES + wave_
    const float2* tab = (const float2*)(ws + WS_TAB);
    if (IN(0)) { FRESH_IDS(); phase_prologue(args, L, gw_, NGW, wave_, lane_); }
    SEAM(0);
#define LAYER(l) do { \
        constexpr int pb = 1 + 6 * (l); \
        if (IN(pb + 0)) { \
            pg8::Gemm g{XN, (const bf16_t*)(ws + WS_WIN + (l) * WIN_L)}; pg8::StaticOrder S; S.init(M, NP, G, bx); \
            pg8::EpiBf16 E{PROJ, NP}; \
            pg8::gemm_phase<DM, DM, DM, pg8::EpiBf16, pg8::StaticOrder, true, true>(L + RING_OFF, g, S, E); \
        } \
        SEAM(pb + 0); \
        if (IN(pb + 1)) { FRESH_IDS(); for (int m = gw_; m < M; m += NGW) postproj_row(PROJ + (size_t)m * NP, m, lane_, args.in[4] + (l) * 128, args.in[5] + (l) * 128, args.in[6] + (l) * 512, args.in[7] + (l) * 256, tab); } \
        SEAM(pb + 1); \
        if (IN(pb + 2)) { \
            { pg8::Gemm g{PROJ + C_BCQ, (const bf16_t*)(ws + WS_WUQ + (l) * WUQ_L)}; pg8::StaticOrder S; S.init(M, 768, G, bx); \
              pg8::EpiBf16 E{QB, 768}; \
              pg8::gemm_phase<512, NP, 512, pg8::EpiBf16, pg8::StaticOrder, true, true>(L + RING_OFF, g, S, E); } \
            { pg8::Gemm g{PROJ + C_BCKV, (const bf16_t*)(ws + WS_WUKV + (l) * WUKV_L)}; pg8::StaticOrder S; S.init(M, 1024, G, bx); \
              pg8::EpiBf16 E{KVB, 1024}; \
              pg8::gemm_phase<256, NP, 256, pg8::EpiBf16, pg8::StaticOrder, true, true>(L + RING_OFF, g, S, E); } \
        } \
        SEAM(pb + 2); \
        if (IN(pb + 3)) { \
            const float* rpb_l = args.in[10] + (size_t)(l) * 4 * 465; \
            for (int u = vcu; u < 1024; u += G) { \
                if (u < 512) { if constexpr ((AMASK & 1) != 0) { const int kvh = u >> 8, b_ = (u & 255) >> 5, i_ = u & 31; att::attn_unit<0, 2>(b_, kvh * 4 + (i_ >> 3), i_ & 7, PROJ, QB, KVB, rpb_l, tab, MIX, (char*)lds + RING_OFF); } } \
                else if (u < 768) { if constexpr ((AMASK & 2) != 0) { const int ub = u - 512, b_ = ub >> 5, i_ = ub & 31; att::attn_unit<1, 1>(b_, i_ >> 3, i_ & 7, PROJ, QB, KVB, rpb_l, tab, MIX, (char*)lds + RING_OFF); } } \
                else { if constexpr ((AMASK & 4) != 0) { const int ub = u - 768, b_ = ub >> 5, i_ = ub & 31; att::attn_unit<2, 1>(b_, i_ >> 3, i_ & 7, PROJ, QB, KVB, rpb_l, tab, MIX, (char*)lds + RING_OFF); } } \
            } \
        } \
        SEAM(pb + 3); \
        if (IN(pb + 4)) { \
            pg8::Gemm g{MIX, (const bf16_t*)(ws + WS_WOUT + (l) * WOUT_L)}; pg8::StaticOrder S; S.init(M, DM, G, bx); \
            pg8::EpiF32 E{Y, DM}; \
            pg8::gemm_phase<DMIX, DMIX, DMIX, pg8::EpiF32, pg8::StaticOrder, true, true>(L + RING_OFF, g, S, E); \
        } \
        SEAM(pb + 4); \
        if (IN(pb + 5)) { FRESH_IDS(); for (int m = gw_; m < M; m += NGW) rowpass_row(Y + (size_t)m * DM, ((l) == 0 ? args.in[0] : args.out) + (size_t)m * DM, args.in[2] + (l) * DM, args.out + (size_t)m * DM, \
                (l) + 1 < DEPTH ? args.in[1] + ((l) + 1) * DM : nullptr, XN + (size_t)m * DM, lane_); } \
        SEAM(pb + 5); \
    } while (0)
    LAYER(0);
    LAYER(1);
#undef LAYER
#undef IN
#undef SEAM
}

static int g_grid = 0;
static void launch_mk(Args a, int lo, int hi, int li, hipStream_t stream) {
    a.ph_lo = lo; a.ph_hi = hi; a.li = li;
    hipLaunchKernelGGL(mk_fwd, dim3(g_grid), dim3(NWAVES * 64), LDS_BYTES, stream, a);
}

extern "C" void kernel_launch(void* const* d_in, const int* in_sizes, int n_in, void* d_out, int out_size, void* d_ws, size_t ws_size, hipStream_t stream) {
  if (n_in != 12 || in_sizes[0] != M * DM || out_size != M * DM || ws_size < WS_END) {
    fprintf(stderr, "kernel_launch: unexpected shapes n_in %d in0 %d out %d ws %zu (need %zu)\n", n_in, n_in > 0 ? in_sizes[0] : -1, out_size, ws_size, (size_t)WS_END); return; }
  if (g_grid == 0) {
    int dev = 0, cus = 0, per_cu = 0;
    if (hipGetDevice(&dev) != hipSuccess || hipDeviceGetAttribute(&cus, hipDeviceAttributeMultiprocessorCount, dev) != hipSuccess) { fprintf(stderr, "kernel_launch: device query failed\n"); g_grid = -1; return; }
    if (hipFuncSetAttribute((const void*)mk_fwd, hipFuncAttributeMaxDynamicSharedMemorySize, LDS_BYTES) != hipSuccess) { fprintf(stderr, "kernel_launch: hipFuncSetAttribute failed\n"); g_grid = -1; return; }
    if (hipOccupancyMaxActiveBlocksPerMultiprocessor(&per_cu, (const void*)mk_fwd, NWAVES * 64, LDS_BYTES) != hipSuccess || per_cu < 1) { fprintf(stderr, "kernel_launch: occupancy query says %d blocks/CU\n", per_cu); g_grid = -1; (void)hipGetLastError(); return; }
    g_grid = cus;
  }
  if (g_grid < 0) return;
  const float* x = (const float*)d_in[0]; const float* norm_pre = (const float*)d_in[1]; const float* norm_post = (const float*)d_in[2];
  const float* w_in = (const float*)d_in[3]; const float* a_qn = (const float*)d_in[4]; const float* a_kn = (const float*)d_in[5];
  const float* b_qn = (const float*)d_in[6]; const float* b_kvn = (const float*)d_in[7]; const float* w_uq = (const float*)d_in[8];
  const float* w_ukv = (const float*)d_in[9]; const float* rpb = (const float*)d_in[10]; const float* w_out = (const float*)d_in[11];
  char* ws = (char*)d_ws; float* out = (float*)d_out;
  (void)hipMemsetAsync(ws + WS_CTL, 0, CTL_ZERO_BYTES, stream);
  Args a{}; for (int i = 0; i < 12; ++i) a.in[i] = (const float*)d_in[i]; a.out = out; a.ws = (unsigned char*)d_ws; a.amask = AMASK;
  launch_mk(a, 0, N_PHASES, 0, stream);
  (void)x; (void)norm_pre; (void)norm_post; (void)w_in; (void)a_qn; (void)a_kn; (void)b_qn; (void)b_kvn; (void)w_uq; (void)w_ukv; (void)rpb; (void)w_out;
}
```

```cpp
#include <hip/hip_runtime.h>
#include <cstdint>
#include <cstdio>

typedef unsigned short bf16_t;
typedef short bf16x8 __attribute__((ext_vector_type(8)));
typedef float f32x4 __attribute__((ext_vector_type(4)));
#define DEVI __device__ __forceinline__

constexpr int BATCH = 8, SEQ = 2048, DM = 2048, DEPTH = 2;
constexpr int M = BATCH * SEQ;
constexpr int DIN = 5952, NP = 6144;
constexpr int DMIX = 2048;
constexpr float EPS = 1e-6f;
constexpr int C_AQ = 0, C_AK = 1024, C_AV = 1280, C_AG = 1536, C_BCQ = 2560, C_BCKV = 3072, C_BKR = 3328, C_BG = 3584,
              C_CQ = 4096, C_CK = 4608, C_CV = 5120, C_CG = 5632;
constexpr size_t MiB = 1u << 20;
constexpr size_t WS_TAB = 1 * MiB;
constexpr size_t WS_WIN = 2 * MiB, WIN_L = 24 * MiB;
constexpr size_t WS_WOUT = 50 * MiB, WOUT_L = 8 * MiB;
constexpr size_t WS_WUQ = 66 * MiB, WUQ_L = 1 * MiB;
constexpr size_t WS_WUKV = 68 * MiB, WUKV_L = 1 * MiB;
constexpr size_t WS_XN = 70 * MiB;
constexpr size_t WS_PROJ = 134 * MiB;
constexpr size_t WS_Y = WS_PROJ;
constexpr size_t WS_QB = 326 * MiB;
constexpr size_t WS_KVB = 350 * MiB;
constexpr size_t WS_MIX = 382 * MiB;
constexpr size_t WS_X1B = 446 * MiB;
constexpr size_t WS_END = 510 * MiB;
constexpr int T_AR = 0, T_AC = 1024, T_BR = 3072, T_BC = 3584, T_N = 4608;

DEVI float bf2f(unsigned v) { return __uint_as_float(v << 16); }
DEVI unsigned f2bf(float f) { unsigned u = __float_as_uint(f); return (u + 0x7fffu + ((u >> 16) & 1u)) >> 16; }
DEVI unsigned pk2(float lo, float hi) { return f2bf(lo) | (f2bf(hi) << 16); }
DEVI float wave_sum(float v) {
#pragma unroll
  for (int o = 1; o < 64; o <<= 1) v += __shfl_xor(v, o);
  return v;
}
DEVI float wave_max(float v) {
#pragma unroll
  for (int o = 1; o < 64; o <<= 1) v = fmaxf(v, __shfl_xor(v, o));
  return v;
}

DEVI int perm128(int p) { const int a = p >> 6, j = (p & 63) >> 1, t = p & 1; return 64 * a + 32 * t + j; }
DEVI int perm64(int p) { const int a = p >> 5, j = (p & 31) >> 1, t = p & 1; return 32 * a + 16 * t + j; }
DEVI int map_col(int mode, int s) {
  if (mode == 0) return s;
  if (mode == 1) {
    if (s < 1280) return (s & ~127) + perm128(s & 127);
    if (s < 3328) return s;
    if (s < 3392) return 3328 + perm64(s - 3328);
    if (s < 3584) return -1;
    return s - 192;
  }
  if (s < 512) return (s >> 7) * 192 + (s & 127);
  const int h = (s - 512) >> 6, p = (s - 512) & 63;
  return h * 192 + 128 + perm64(p);
}

__global__ __launch_bounds__(256) void k_transpose_cvt(const float* __restrict__ src, bf16_t* __restrict__ dst, int K, int Ns, int mode) {
  __shared__ float tile[32][33];
  const int n0 = blockIdx.x * 32, k0 = blockIdx.y * 32, tx = threadIdx.x & 31, ty = threadIdx.x >> 5;
  const int so = map_col(mode, n0 + tx);
#pragma unroll
  for (int i = 0; i < 4; ++i) { const int kk = ty + 8 * i; tile[kk][tx] = so >= 0 ? src[(size_t)(k0 + kk) * Ns + so] : 0.f; }
  __syncthreads();
#pragma unroll
  for (int i = 0; i < 4; ++i) { const int nn = ty + 8 * i; dst[(size_t)(n0 + nn) * K + k0 + tx] = (bf16_t)f2bf(tile[tx][nn]); }
}

__global__ __launch_bounds__(256) void k_rope_tab(float2* tab) {
  const int i = blockIdx.x * 256 + threadIdx.x; if (i >= T_N) return;
  int pos, j; float n;
  if (i < T_AC) { pos = i >> 5; j = i & 31; n = 64.f; }
  else if (i < T_BR) { pos = (i - T_AC) >> 5; j = i & 31; n = 64.f; }
  else if (i < T_BC) { pos = (i - T_BR) >> 4; j = i & 15; n = 32.f; }
  else { pos = (i - T_BC) >> 4; j = i & 15; n = 32.f; }
  const float inv = 1.0f / powf(10000.f, (float)(2 * j) / n);
  const float ang = (float)pos * inv;
  const float k = rintf(ang * 0.15915494309189535f);
  float r = fmaf(-k, 6.28318548202514648f, ang); r = fmaf(-k, -1.74845553e-7f, r);
  tab[i] = make_float2(cosf(r), sinf(r));
}

__global__ __launch_bounds__(256) void k_rmsnorm_xn(const float* __restrict__ x, const float* __restrict__ g, bf16_t* __restrict__ xn) {
  const int row = blockIdx.x * 4 + (threadIdx.x >> 6), lane = threadIdx.x & 63;
  const float4* xr = (const float4*)(x + (size_t)row * DM) + lane;
  float4 v[8]; float ss = 0.f;
#pragma unroll
  for (int j = 0; j < 8; ++j) { v[j] = xr[64 * j]; ss += v[j].x * v[j].x + v[j].y * v[j].y + v[j].z * v[j].z + v[j].w * v[j].w; }
  const float rs = rsqrtf(wave_sum(ss) * (1.f / DM) + EPS);
  uint2* o = (uint2*)(xn + (size_t)row * DM) + lane;
#pragma unroll
  for (int j = 0; j < 8; ++j) { const float4 gg = ((const float4*)g)[lane + 64 * j];
    o[64 * j] = make_uint2(pk2(v[j].x * rs * gg.x, v[j].y * rs * gg.y), pk2(v[j].z * rs * gg.z, v[j].w * rs * gg.w)); }
}

template <bool OUT_F32>
__global__ __launch_bounds__(256) void k_gemm_naive(const bf16_t* __restrict__ A, int lda, const bf16_t* __restrict__ Bt, int ldb, void* __restrict__ C, int ldc, int K) {
  __shared__ __attribute__((aligned(16))) bf16_t sA[64 * 40];
  __shared__ __attribute__((aligned(16))) bf16_t sB[64 * 40];
  const int tid = threadIdx.x, lane = tid & 63, w = tid >> 6;
  const int m0 = blockIdx.y * 64, n0 = blockIdx.x * 64, lr = tid >> 2, lc = (tid & 3) * 8;
  f32x4 acc0 = {0, 0, 0, 0}, acc1 = acc0, acc2 = acc0, acc3 = acc0;
  for (int k0 = 0; k0 < K; k0 += 32) {
    const uint4 va = *(const uint4*)(A + (size_t)(m0 + lr) * lda + k0 + lc);
    const uint4 vb = *(const uint4*)(Bt + (size_t)(n0 + lr) * ldb + k0 + lc);
    __syncthreads();
    *(uint4*)(sA + lr * 40 + lc) = va; *(uint4*)(sB + lr * 40 + lc) = vb;
    __syncthreads();
    const bf16x8 a = *(const bf16x8*)(sA + (16 * w + (lane & 15)) * 40 + (lane >> 4) * 8);
    const bf16x8 b0 = *(const bf16x8*)(sB + (0 + (lane & 15)) * 40 + (lane >> 4) * 8);
    const bf16x8 b1 = *(const bf16x8*)(sB + (16 + (lane & 15)) * 40 + (lane >> 4) * 8);
    const bf16x8 b2 = *(const bf16x8*)(sB + (32 + (lane & 15)) * 40 + (lane >> 4) * 8);
    const bf16x8 b3 = *(const bf16x8*)(sB + (48 + (lane & 15)) * 40 + (lane >> 4) * 8);
    acc0 = __builtin_amdgcn_mfma_f32_16x16x32_bf16(a, b0, acc0, 0, 0, 0);
    acc1 = __builtin_amdgcn_mfma_f32_16x16x32_bf16(a, b1, acc1, 0, 0, 0);
    acc2 = __builtin_amdgcn_mfma_f32_16x16x32_bf16(a, b2, acc2, 0, 0, 0);
    acc3 = __builtin_amdgcn_mfma_f32_16x16x32_bf16(a, b3, acc3, 0, 0, 0);
  }
#pragma unroll
  for (int j = 0; j < 4; ++j) {
    const size_t row = m0 + 16 * w + (lane >> 4) * 4 + j; const int col = n0 + (lane & 15);
    if (OUT_F32) { float* c = (float*)C + row * ldc + col; c[0] = acc0[j]; c[16] = acc1[j]; c[32] = acc2[j]; c[48] = acc3[j]; }
    else { bf16_t* c = (bf16_t*)C + row * ldc + col; c[0] = (bf16_t)f2bf(acc0[j]); c[16] = (bf16_t)f2bf(acc1[j]); c[32] = (bf16_t)f2bf(acc2[j]); c[48] = (bf16_t)f2bf(acc3[j]); }
  }
}

__global__ __launch_bounds__(256) void k_postproj(bf16_t* __restrict__ PROJ, const float* __restrict__ a_qn, const float* __restrict__ a_kn,
                                                  const float* __restrict__ b_qn, const float* __restrict__ b_kvn, const float2* __restrict__ tab) {
  const int row = blockIdx.x * 4 + (threadIdx.x >> 6), lane = threadIdx.x & 63;
  const int t = row & (SEQ - 1), pr = t >> 6, pc = t & 63;
  bf16_t* p = PROJ + (size_t)row * NP;
  {
    const int a = lane >> 5, j = lane & 31;
    const float2 cs = a == 0 ? tab[T_AR + pr * 32 + j] : tab[T_AC + pc * 32 + j];
    const int d1 = 64 * a + j, d2 = d1 + 32;
    for (int hb = 0; hb < 10; ++hb) {
      unsigned* pp = (unsigned*)(p + hb * 128) + lane;
      const unsigned v = *pp; const float x1 = bf2f(v & 0xffffu), x2 = bf2f(v >> 16);
      const float rs = rsqrtf(wave_sum(x1 * x1 + x2 * x2) * (1.f / 128.f) + EPS);
      const float* g = hb < 8 ? a_qn : a_kn;
      const float y1 = x1 * rs * g[d1], y2 = x2 * rs * g[d2];
      *pp = pk2(y1 * cs.x - y2 * cs.y, y2 * cs.x + y1 * cs.y);
    }
  }
  {
    uint4* pp = (uint4*)(p + C_BCQ) + lane; const uint4 v = *pp; float x[8];
    x[0] = bf2f(v.x & 0xffffu); x[1] = bf2f(v.x >> 16); x[2] = bf2f(v.y & 0xffffu); x[3] = bf2f(v.y >> 16);
    x[4] = bf2f(v.z & 0xffffu); x[5] = bf2f(v.z >> 16); x[6] = bf2f(v.w & 0xffffu); x[7] = bf2f(v.w >> 16);
    float ss = 0.f;
#pragma unroll
    for (int i = 0; i < 8; ++i) ss += x[i] * x[i];
    const float rs = rsqrtf(wave_sum(ss) * (1.f / 512.f) + EPS);
    const float4 g0 = ((const float4*)b_qn)[2 * lane], g1 = ((const float4*)b_qn)[2 * lane + 1];
    *pp = make_uint4(pk2(x[0] * rs * g0.x, x[1] * rs * g0.y), pk2(x[2] * rs * g0.z, x[3] * rs * g0.w),
                     pk2(x[4] * rs * g1.x, x[5] * rs * g1.y), pk2(x[6] * rs * g1.z, x[7] * rs * g1.w));
  }
  {
    uint2* pp = (uint2*)(p + C_BCKV) + lane; const uint2 v = *pp;
    const float x0 = bf2f(v.x & 0xffffu), x1 = bf2f(v.x >> 16), x2 = bf2f(v.y & 0xffffu), x3 = bf2f(v.y >> 16);
    const float rs = rsqrtf(wave_sum(x0 * x0 + x1 * x1 + x2 * x2 + x3 * x3) * (1.f / 256.f) + EPS);
    const float4 g = ((const float4*)b_kvn)[lane];
    *pp = make_uint2(pk2(x0 * rs * g.x, x1 * rs * g.y), pk2(x2 * rs * g.z, x3 * rs * g.w));
  }
  if (lane < 32) {
    const int a = lane >> 4, j = lane & 15;
    const float2 cs = a == 0 ? tab[T_BR + pr * 16 + j] : tab[T_BC + pc * 16 + j];
    unsigned* pp = (unsigned*)(p + C_BKR) + lane; const unsigned v = *pp; const float x1 = bf2f(v & 0xffffu), x2 = bf2f(v >> 16);
    *pp = pk2(x1 * cs.x - x2 * cs.y, x2 * cs.x + x1 * cs.y);
  }
}

__global__ __launch_bounds__(256) void k_rope_qpe(bf16_t* __restrict__ QB, const float2* __restrict__ tab) {
  const int row = blockIdx.x * 4 + (threadIdx.x >> 6), lane = threadIdx.x & 63;
  const int t = row & (SEQ - 1), pr = t >> 6, pc = t & 63;
  unsigned* p = (unsigned*)(QB + (size_t)row * 768 + 512);
#pragma unroll
  for (int i = 0; i < 2; ++i) {
    const int pi = lane + 64 * i, a = (pi >> 4) & 1, j = pi & 15;
    const float2 cs = a == 0 ? tab[T_BR + pr * 16 + j] : tab[T_BC + pc * 16 + j];
    const unsigned v = p[pi]; const float x1 = bf2f(v & 0xffffu), x2 = bf2f(v >> 16);
    p[pi] = pk2(x1 * cs.x - x2 * cs.y, x2 * cs.x + x1 * cs.y);
  }
}

DEVI float dot8(const uint4 kv, const float* q) {
  return bf2f(kv.x & 0xffffu) * q[0] + bf2f(kv.x >> 16) * q[1] + bf2f(kv.y & 0xffffu) * q[2] + bf2f(kv.y >> 16) * q[3] +
         bf2f(kv.z & 0xffffu) * q[4] + bf2f(kv.z >> 16) * q[5] + bf2f(kv.w & 0xffffu) * q[6] + bf2f(kv.w >> 16) * q[7];
}
template <int TYPE>
__global__ __launch_bounds__(256) void k_attn_naive(const bf16_t* __restrict__ PROJ, const bf16_t* __restrict__ QB, const bf16_t* __restrict__ KVB,
                                                    const float* __restrict__ rpb, bf16_t* __restrict__ MIX) {
  __shared__ float qs[4][192];
  __shared__ float ps[4][2048];
  constexpr int NH = TYPE == 0 ? 8 : 4;
  const int w = threadIdx.x >> 6, lane = threadIdx.x & 63;
  const int item = blockIdx.x * 4 + w, h = item % NH, row = item / NH, b = row >> 11, t = row & 2047;
  const float scale = TYPE == 1 ? 0.07216878364870322f : 0.08838834764831845f;
  if (TYPE == 0) { for (int d = lane; d < 128; d += 64) qs[w][d] = bf2f(PROJ[(size_t)row * NP + C_AQ + h * 128 + d]); }
  else if (TYPE == 2) { for (int d = lane; d < 128; d += 64) qs[w][d] = bf2f(PROJ[(size_t)row * NP + C_CQ + h * 128 + d]); }
  else { for (int d = lane; d < 128; d += 64) qs[w][d] = bf2f(QB[(size_t)row * 768 + h * 128 + d]); qs[w][128 + lane] = bf2f(QB[(size_t)row * 768 + 512 + h * 64 + lane]); }
  __syncthreads();
  const int r = t >> 6, c = t & 63;
  const int r0 = min(max(r - 4, 0), 24), c0 = min(max(c - 8, 0), 48);
  constexpr int NK = TYPE == 2 ? 128 : 2048;
  float lmax = -3.0e38f;
  for (int i = 0; i < NK / 64; ++i) {
    const int n = lane + 64 * i; int j; float bias = 0.f;
    if (TYPE == 2) { const int kr = r0 + (n >> 4), kc = c0 + (n & 15); j = kr * 64 + kc; bias = rpb[(h * 15 + (kr - r + 7)) * 31 + (kc - c + 15)]; } else j = n;
    const size_t krow = (size_t)b * 2048 + j;
    const bf16_t* kp = TYPE == 0 ? PROJ + krow * NP + C_AK + (h >> 2) * 128 : TYPE == 2 ? PROJ + krow * NP + C_CK + h * 128 : KVB + krow * 1024 + h * 256;
    float acc = 0.f;
#pragma unroll
    for (int d = 0; d < 128; d += 8) acc += dot8(*(const uint4*)(kp + d), &qs[w][d]);
    if (TYPE == 1) { const bf16_t* kp2 = PROJ + krow * NP + C_BKR;
#pragma unroll
      for (int d = 0; d < 64; d += 8) acc += dot8(*(const uint4*)(kp2 + d), &qs[w][128 + d]); }
    const float s = acc * scale + bias;
    ps[w][n] = s; lmax = fmaxf(lmax, s);
  }
  const float mx = wave_max(lmax);
  float lsum = 0.f;
  for (int i = 0; i < NK / 64; ++i) { const int n = lane + 64 * i; const float p = __expf(ps[w][n] - mx); ps[w][n] = p; lsum += p; }
  const float l = wave_sum(lsum);
  __syncthreads();
  float o0 = 0.f, o1 = 0.f;
  for (int n = 0; n < NK; ++n) {
    int j; if (TYPE == 2) j = (r0 + (n >> 4)) * 64 + c0 + (n & 15); else j = n;
    const size_t krow = (size_t)b * 2048 + j;
    const bf16_t* vp = TYPE == 0 ? PROJ + krow * NP + C_AV + (h >> 2) * 128 : TYPE == 2 ? PROJ + krow * NP + C_CV + h * 128 : KVB + krow * 1024 + h * 256 + 128;
    const unsigned v = ((const unsigned*)vp)[lane]; const float p = ps[w][n];
    o0 += p * bf2f(v & 0xffffu); o1 += p * bf2f(v >> 16);
  }
  const int gcol = (TYPE == 0 ? C_AG : TYPE == 1 ? C_BG : C_CG) + h * 128, mcol = (TYPE == 0 ? 0 : TYPE == 1 ? 1024 : 1536) + h * 128;
  const unsigned gv = ((const unsigned*)(PROJ + (size_t)row * NP + gcol))[lane];
  const float g0 = bf2f(gv & 0xffffu), g1 = bf2f(gv >> 16), il = 1.f / l;
  ((unsigned*)(MIX + (size_t)row * DMIX + mcol))[lane] = pk2(o0 * il * (g0 / (1.f + __expf(-g0))), o1 * il * (g1 / (1.f + __expf(-g1))));
}

__global__ __launch_bounds__(256) void k_rowpass(const float* __restrict__ Y, const float* resid, const float* __restrict__ g_post, float* out,
                                                 const float* __restrict__ g_next, bf16_t* __restrict__ xn) {
  const int row = blockIdx.x * 4 + (threadIdx.x >> 6), lane = threadIdx.x & 63;
  const float4* yr = (const float4*)(Y + (size_t)row * DM) + lane; const float4* xr = (const float4*)(resid + (size_t)row * DM) + lane;
  float4 v[8]; float ss = 0.f;
#pragma unroll
  for (int j = 0; j < 8; ++j) { v[j] = yr[64 * j]; ss += v[j].x * v[j].x + v[j].y * v[j].y + v[j].z * v[j].z + v[j].w * v[j].w; }
  const float rs = rsqrtf(wave_sum(ss) * (1.f / DM) + EPS);
  float4* orow = (float4*)(out + (size_t)row * DM) + lane; float s2 = 0.f;
#pragma unroll
  for (int j = 0; j < 8; ++j) { const float4 gg = ((const float4*)g_post)[lane + 64 * j]; const float4 xx = xr[64 * j];
    v[j].x = xx.x + v[j].x * rs * gg.x; v[j].y = xx.y + v[j].y * rs * gg.y; v[j].z = xx.z + v[j].z * rs * gg.z; v[j].w = xx.w + v[j].w * rs * gg.w;
    orow[64 * j] = v[j]; s2 += v[j].x * v[j].x + v[j].y * v[j].y + v[j].z * v[j].z + v[j].w * v[j].w; }
  if (g_next) {
    const float r2 = rsqrtf(wave_sum(s2) * (1.f / DM) + EPS);
    uint2* o = (uint2*)(xn + (size_t)row * DM) + lane;
#pragma unroll
    for (int j = 0; j < 8; ++j) { const float4 gg = ((const float4*)g_next)[lane + 64 * j];
      o[64 * j] = make_uint2(pk2(v[j].x * r2 * gg.x, v[j].y * r2 * gg.y), pk2(v[j].z * r2 * gg.z, v[j].w * r2 * gg.w)); }
  }
}

namespace pg8 {
#define PG8_LAS __attribute__((address_space(3)))
typedef unsigned u32x4 __attribute__((ext_vector_type(4)));
constexpr int BM = 256, BK = 64, HALF = 128, HTB = HALF * BK * 2, STAGE_BYTES = 8 * HTB, NXCD = 8, WGM = 8;
__host__ __device__ __forceinline__ int lds_byte(int r, int c) { const int st = (r >> 4) * 2 + (c >> 5), rr = r & 15, cc = c & 31, ob = rr * 64 + cc * 2; return st * 1024 + (ob ^ (((ob >> 9) & 1) << 5)); }
__host__ __device__ __forceinline__ void stage_rc(int b, int& R, int& C) { const int st = b / 1024, sb = b % 1024, swz = sb ^ (((sb >> 9) & 1) << 5); R = (st >> 1) * 16 + swz / 64; C = (st & 1) * 32 + (swz % 64) / 2; }
__host__ __device__ __forceinline__ int perm32(int rho) { const int n = rho >> 4, i = rho & 15; return 8 * (i >> 2) + 4 * n + (i & 3); }
struct Unit { int pm, pn, slot; };
struct Gemm { const bf16_t* A; const bf16_t* Bt; };
struct StaticOrder {
    int nM, nN, nwg, G, c;
    __host__ __device__ void init(int M, int N, int G_, int c_) { nM = M / BM; nN = N / BM; nwg = nM * nN; G = G_; c = c_; }
    __host__ __device__ bool next(int i, Unit& u) const {
        const long L = (long)i * G + c; if (L >= nwg) return false;
        int wgid = (int)L; { const int q = nwg / NXCD, r = nwg % NXCD, xcd = wgid % NXCD, off = wgid / NXCD; wgid = (xcd < r ? xcd * (q + 1) : r * (q + 1) + (xcd - r) * q) + off; }
        const int nig = WGM * nN, gid = wgid / nig, fm = gid * WGM, gsz = (nM - fm) < WGM ? (nM - fm) : WGM;
        u.pm = fm + ((wgid % nig) % gsz); u.pn = (wgid % nig) / gsz; u.slot = i & 1; return true;
    }
    __device__ __forceinline__ void a_ready(const Unit&) const {}
    __device__ __forceinline__ void done(const Unit&) const {}
};
__device__ __forceinline__ unsigned cvt_pk_bf16(float lo, float hi) { unsigned r; asm volatile("v_cvt_pk_bf16_f32 %0, %1, %2" : "=v"(r) : "v"(lo), "v"(hi)); return r; }
struct EpiF32 {
    static constexpr bool PERM = false, AFTER_DRAIN = false;
    float* C; int ldc;
    __device__ __forceinline__ void operator()(const f32x4 (&acc)[2][2][4][2], const Unit& u, int wr, int wc, int fr, int fq) const {
        const int row0 = u.pm * BM + wr * 64 + fr, col0 = u.pn * BM + wc * 32 + 4 * fq;
#pragma unroll
        for (int ai = 0; ai < 2; ++ai)
#pragma unroll
            for (int m = 0; m < 4; ++m) { float* rowp = C + (size_t)(row0 + ai * HALF + m * 16) * ldc + col0;
#pragma unroll
                for (int bj = 0; bj < 2; ++bj)
#pragma unroll
                    for (int n = 0; n < 2; ++n) *(f32x4*)(rowp + bj * HALF + n * 16) = acc[ai][bj][m][n]; }
    }
};
struct EpiNone {
    static constexpr bool PERM = true, AFTER_DRAIN = false;
    __device__ __forceinline__ void operator()(const f32x4 (&acc)[2][2][4][2], const Unit&, int, int, int, int) const {
#pragma unroll
        for (int ai = 0; ai < 2; ++ai)
#pragma unroll
            for (int bj = 0; bj < 2; ++bj)
#pragma unroll
                for (int m = 0; m < 4; ++m)
#pragma unroll
                    for (int n = 0; n < 2; ++n) asm volatile("" :: "v"(acc[ai][bj][m][n]));
    }
};
struct EpiBf16 {
    static constexpr bool PERM = true, AFTER_DRAIN = false;
    bf16_t* O; int ldc;
    __device__ __forceinline__ void operator()(const f32x4 (&acc)[2][2][4][2], const Unit& u, int wr, int wc, int fr, int fq) const {
        const int row0 = u.pm * BM + wr * 64 + fr, col0 = u.pn * BM + wc * 32 + 8 * fq;
#pragma unroll
        for (int ai = 0; ai < 2; ++ai)
#pragma unroll
            for (int m = 0; m < 4; ++m) { bf16_t* rowp = O + (size_t)(row0 + ai * HALF + m * 16) * ldc + col0;
#pragma unroll
                for (int bj = 0; bj < 2; ++bj) { const f32x4 v0 = acc[ai][bj][m][0], v1 = acc[ai][bj][m][1];
                    u32x4 w; w.x = cvt_pk_bf16(v0[0], v0[1]); w.y = cvt_pk_bf16(v0[2], v0[3]); w.z = cvt_pk_bf16(v1[0], v1[1]); w.w = cvt_pk_bf16(v1[2], v1[3]);
                    *(u32x4*)(rowp + bj * HALF) = w; } }
    }
};

template <int KW, int LDA> struct RsOrder : StaticOrder {
    const bf16_t* A; PG8_LAS float* tab;
    __device__ __forceinline__ void a_ready(const Unit& u) const {
        int l_ = threadIdx.x; asm volatile("" : "+v"(l_));
        const int lane = l_ & 63, wid = l_ >> 6, rr = lane >> 4, c = lane & 15;
        constexpr int NV = KW / 16 / 8;
        const bf16_t* base = A + (size_t)(u.pm * BM + wid * 32 + rr) * LDA + c * (KW / 16);
#pragma unroll 2
        for (int i = 0; i < 8; ++i) {
            float ss = 0.f;
#pragma unroll
            for (int v = 0; v < NV; ++v) { const u32x4 x = *(const u32x4*)(base + (size_t)(4 * i) * LDA + v * 8);
#pragma unroll
                for (int e = 0; e < 4; ++e) { const float a = __uint_as_float(x[e] << 16), b = __uint_as_float(x[e] & 0xffff0000u); ss += a * a + b * b; } }
            ss += __shfl_xor(ss, 1); ss += __shfl_xor(ss, 2); ss += __shfl_xor(ss, 4); ss += __shfl_xor(ss, 8);
            if (c == 0) tab[u.slot * 256 + wid * 32 + 4 * i + rr] = rsqrtf(ss * (1.f / KW) + 1e-6f);
        }
    }
};
template <int ROPE_PN> struct EpiBf16Rs {
    static constexpr bool PERM = true, AFTER_DRAIN = false;
    bf16_t* O; int ldc; const PG8_LAS float* rst; const float2* tab_r; const float2* tab_c;
    __device__ __forceinline__ void operator()(const f32x4 (&acc)[2][2][4][2], const Unit& u, int wr, int wc, int fr, int fq) const {
        const int row0 = u.pm * BM + wr * 64 + fr, col0 = u.pn * BM + wc * 32 + 8 * fq;
        const bool rope = (ROPE_PN >= 0) && (u.pn == ROPE_PN);
#pragma unroll
        for (int ai = 0; ai < 2; ++ai)
#pragma unroll
            for (int m = 0; m < 4; ++m) { const int row = row0 + ai * HALF + m * 16; bf16_t* rowp = O + (size_t)row * ldc + col0;
                const float rs = rst[u.slot * 256 + ai * HALF + wr * 64 + m * 16 + fr];
                f32x4 c01 = {1.f, 0.f, 1.f, 0.f}, c23 = c01;
                if (rope) { const int t = row & 2047; const float2* tp = (wc & 1) ? tab_c + (t & 63) * 16 + 4 * fq : tab_r + (t >> 6) * 16 + 4 * fq;
                    c01 = *(const f32x4*)tp; c23 = *(const f32x4*)(tp + 2); }
#pragma unroll
                for (int bj = 0; bj < 2; ++bj) { f32x4 v0 = acc[ai][bj][m][0] * rs, v1 = acc[ai][bj][m][1] * rs;
                    if (rope) { const f32x4 a0 = v0, a1 = v1;
                        v0[0] = a0[0] * c01[0] - a0[1] * c01[1]; v0[1] = a0[1] * c01[0] + a0[0] * c01[1]; v0[2] = a0[2] * c01[2] - a0[3] * c01[3]; v0[3] = a0[3] * c01[2] + a0[2] * c01[3];
                        v1[0] = a1[0] * c23[0] - a1[1] * c23[1]; v1[1] = a1[1] * c23[0] + a1[0] * c23[1]; v1[2] = a1[2] * c23[2] - a1[3] * c23[3]; v1[3] = a1[3] * c23[2] + a1[2] * c23[3]; }
                    u32x4 w; w.x = cvt_pk_bf16(v0[0], v0[1]); w.y = cvt_pk_bf16(v0[2], v0[3]); w.z = cvt_pk_bf16(v1[0], v1[1]); w.w = cvt_pk_bf16(v1[2], v1[3]);
                    *(u32x4*)(rowp + bj * HALF) = w; } }
    }
};

template <int K, int LDA, int LDB, class Epi, class Sched, bool ALIGN_EPI = false, bool SP2 = false>
__device__ __forceinline__ void gemm_phase(PG8_LAS unsigned char* lds, const Gemm g, const Sched& S, const Epi& E) {
    int tid_ = threadIdx.x; asm volatile("" : "+v"(tid_));
    const int tid = tid_, wid = __builtin_amdgcn_readfirstlane(tid >> 6), lane = tid & 63, wr = wid >> 2, wc = wid & 3, fr = lane & 15, fq = lane >> 4;
    constexpr int nt = K / BK;
    unsigned voffA[2], voffB[2];
#pragma unroll
    for (int i = 0; i < 2; ++i) { int R, C; stage_rc(tid * 16 + i * 8192, R, C); const int Rb = Epi::PERM ? ((R & ~31) + perm32(R & 31)) : R;
        voffA[i] = (unsigned)(R * LDA + C) * 2u; voffB[i] = (unsigned)(Rb * LDB + C) * 2u; }
    constexpr size_t kstep = (size_t)(BK * 2);
    constexpr size_t hsA = (size_t)HALF * LDA * 2, hsB = (size_t)HALF * LDB * 2;
    constexpr size_t tsA = 2 * hsA, tsB = 2 * hsB;
    const unsigned ldsw = (unsigned)wid * 1024u;
    const int aoff = lds_byte(wr * 64 + fr, fq * 8), boff = lds_byte(wc * 32 + fr, fq * 8);
#define PG8_SA(b, h) (((b) * 2 + (h)) * HTB)
#define PG8_SB(b, h) ((4 + (b) * 2 + (h)) * HTB)
#define PG8_STAGE(bufoff, gbase, voff) do { _Pragma("unroll") for (int _i = 0; _i < 2; ++_i) \
        __builtin_amdgcn_global_load_lds((const unsigned*)((const char*)(gbase) + (voff)[_i]), (PG8_LAS unsigned*)(lds + (bufoff) + ldsw + _i * 8192), 16, 0, 0); } while (0)
#define PG8_LDA(dst, b, h) do { _Pragma("unroll") for (int m = 0; m < 4; ++m) _Pragma("unroll") for (int k = 0; k < 2; ++k) dst[m][k] = *(const PG8_LAS bf16x8*)(lds + PG8_SA(b, h) + aoff + m * 2048 + k * 1024); } while (0)
#define PG8_LDB(dst, b, h) do { _Pragma("unroll") for (int n = 0; n < 2; ++n) _Pragma("unroll") for (int k = 0; k < 2; ++k) dst[n][k] = *(const PG8_LAS bf16x8*)(lds + PG8_SB(b, h) + boff + n * 2048 + k * 1024); } while (0)
#define PG8_MMA(ai, bj, At, Bt) do { __builtin_amdgcn_s_setprio(1); _Pragma("unroll") for (int m = 0; m < 4; ++m) _Pragma("unroll") for (int n = 0; n < 2; ++n) _Pragma("unroll") for (int k = 0; k < 2; ++k) \
        acc[ai][bj][m][n] = __builtin_amdgcn_mfma_f32_16x16x32_bf16(Bt[n][k], At[m][k], acc[ai][bj][m][n], 0, 0, 0); __builtin_amdgcn_s_setprio(0); } while (0)
#define PG8_WAIT_V(n) asm volatile("s_waitcnt vmcnt(" #n ")" ::: "memory")
#define PG8_WAIT_L(n) asm volatile("s_waitcnt lgkmcnt(" #n ")" ::: "memory")
#define PG8_BAR __builtin_amdgcn_s_barrier()
#define PG8_SCHED __builtin_amdgcn_sched_barrier(0)
    Unit cur, nxt; int ui = 0;
    if (!S.next(0, cur)) return;
    f32x4 acc[2][2][4][2];
#pragma unroll
    for (int a = 0; a < 2; ++a)
#pragma unroll
        for (int b = 0; b < 2; ++b)
#pragma unroll
            for (int m = 0; m < 4; ++m)
#pragma unroll
                for (int n = 0; n < 2; ++n) acc[a][b][m][n] = (f32x4){0.f, 0.f, 0.f, 0.f};
    bf16x8 At[4][2], B0[2][2], B1[2][2];
    const char* cA = (const char*)g.A + (size_t)cur.pm * tsA; const char* cB = (const char*)g.Bt + (size_t)cur.pn * tsB;
    S.a_ready(cur);
    if constexpr (SP2) {
        PG8_STAGE(PG8_SB(0, 0), cB, voffB); PG8_STAGE(PG8_SB(0, 1), cB + hsB, voffB); PG8_STAGE(PG8_SA(0, 0), cA, voffA); PG8_STAGE(PG8_SA(0, 1), cA + hsA, voffA);
        if (wr == 1) PG8_BAR;
        PG8_WAIT_V(2); PG8_BAR;
        PG8_STAGE(PG8_SB(1, 0), cB + kstep, voffB); PG8_STAGE(PG8_SA(1, 0), cA + kstep, voffA); PG8_STAGE(PG8_SB(1, 1), cB + hsB + kstep, voffB);
        PG8_WAIT_V(6); PG8_BAR;
    } else {
        PG8_STAGE(PG8_SB(0, 0), cB, voffB); PG8_STAGE(PG8_SA(0, 0), cA, voffA); PG8_STAGE(PG8_SB(0, 1), cB + hsB, voffB); PG8_STAGE(PG8_SA(0, 1), cA + hsA, voffA);
        if (wr == 1) PG8_BAR;
        PG8_WAIT_V(4); PG8_BAR;
        PG8_STAGE(PG8_SB(1, 0), cB + kstep, voffB); PG8_STAGE(PG8_SA(1, 0), cA + kstep, voffA); PG8_STAGE(PG8_SB(1, 1), cB + hsB + kstep, voffB);
        PG8_WAIT_V(6); PG8_BAR;
    }
    for (;;) {
        const bool has_next = S.next(ui + 1, nxt);
        const char* nA = has_next ? (const char*)g.A + (size_t)nxt.pm * tsA : cA; const char* nB = has_next ? (const char*)g.Bt + (size_t)nxt.pn * tsB : cB;
#pragma unroll 1
        for (int t = 0; t < nt; t += 2) {
            const bool last = (t == nt - 2);
            const char* a1 = cA + (size_t)(t + 1) * kstep;
            const char* a2 = last ? nA : cA + (size_t)(t + 2) * kstep; const char* b2 = last ? nB : cB + (size_t)(t + 2) * kstep;
            const char* a3 = a2 + kstep; const char* b3 = b2 + kstep;
            if (last && has_next) S.a_ready(nxt);
            if constexpr (SP2) {
            PG8_LDB(B0, 0, 0); PG8_LDB(B1, 0, 1); PG8_SCHED; PG8_LDA(At, 0, 0); PG8_STAGE(PG8_SA(1, 1), a1 + hsA, voffA);
            PG8_WAIT_V(8); PG8_WAIT_L(0); PG8_BAR; PG8_MMA(0, 0, At, B0); PG8_MMA(0, 1, At, B1); PG8_BAR; PG8_SCHED;
            PG8_LDA(At, 0, 1); PG8_STAGE(PG8_SB(0, 0), b2, voffB); PG8_STAGE(PG8_SB(0, 1), b2 + hsB, voffB); PG8_STAGE(PG8_SA(0, 0), a2, voffA);
            PG8_WAIT_V(8); PG8_WAIT_L(0); PG8_BAR; PG8_MMA(1, 0, At, B0); PG8_MMA(1, 1, At, B1); PG8_BAR; PG8_SCHED;
            PG8_LDB(B0, 1, 0); PG8_LDB(B1, 1, 1); PG8_SCHED; PG8_LDA(At, 1, 0); PG8_STAGE(PG8_SA(0, 1), a2 + hsA, voffA);
            PG8_WAIT_V(8); PG8_WAIT_L(0); PG8_BAR; PG8_MMA(0, 0, At, B0); PG8_MMA(0, 1, At, B1); PG8_BAR; PG8_SCHED;
            PG8_LDA(At, 1, 1); PG8_STAGE(PG8_SB(1, 0), b3, voffB); PG8_STAGE(PG8_SB(1, 1), b3 + hsB, voffB); PG8_STAGE(PG8_SA(1, 0), a3, voffA);
            PG8_WAIT_V(8); PG8_WAIT_L(0); PG8_BAR; PG8_MMA(1, 0, At, B0); PG8_MMA(1, 1, At, B1); PG8_BAR; PG8_SCHED;
            } else {
            PG8_LDB(B0, 0, 0); PG8_SCHED; PG8_LDA(At, 0, 0); PG8_STAGE(PG8_SA(1, 1), a1 + hsA, voffA);
            PG8_WAIT_L(8); PG8_BAR; PG8_WAIT_L(0); PG8_MMA(0, 0, At, B0); PG8_BAR; PG8_SCHED;
            PG8_LDB(B1, 0, 1); PG8_STAGE(PG8_SB(0, 0), b2, voffB);
            PG8_BAR; PG8_WAIT_L(0); PG8_MMA(0, 1, At, B1); PG8_BAR;
            PG8_LDA(At, 0, 1); PG8_STAGE(PG8_SA(0, 0), a2, voffA);
            PG8_BAR; PG8_WAIT_L(0); PG8_MMA(1, 0, At, B0); PG8_BAR; PG8_SCHED;
            PG8_STAGE(PG8_SB(0, 1), b2 + hsB, voffB);
            PG8_WAIT_V(6); PG8_BAR; PG8_MMA(1, 1, At, B1); PG8_BAR;
            PG8_LDB(B0, 1, 0); PG8_SCHED; PG8_LDA(At, 1, 0); PG8_STAGE(PG8_SA(0, 1), a2 + hsA, voffA);
            PG8_WAIT_L(8); PG8_BAR; PG8_WAIT_L(0); PG8_MMA(0, 0, At, B0); PG8_BAR; PG8_SCHED;
            PG8_LDB(B1, 1, 1); PG8_STAGE(PG8_SB(1, 0), b3, voffB);
            PG8_BAR; PG8_WAIT_L(0); PG8_MMA(0, 1, At, B1); PG8_BAR;
            PG8_LDA(At, 1, 1); PG8_STAGE(PG8_SA(1, 0), a3, voffA);
            PG8_BAR; PG8_WAIT_L(0); PG8_MMA(1, 0, At, B0); PG8_BAR; PG8_SCHED;
            PG8_STAGE(PG8_SB(1, 1), b3 + hsB, voffB);
            PG8_WAIT_V(6); PG8_BAR; PG8_MMA(1, 1, At, B1); PG8_BAR;
            }
        }
        if constexpr (ALIGN_EPI) { if (wr == 0) PG8_BAR; }
        if constexpr (!Epi::AFTER_DRAIN) { E(acc, cur, wr, wc, fr, fq); S.done(cur); }
        if (!has_next) break;
#pragma unroll
        for (int a = 0; a < 2; ++a)
#pragma unroll
            for (int b = 0; b < 2; ++b)
#pragma unroll
                for (int m = 0; m < 4; ++m)
#pragma unroll
                    for (int n = 0; n < 2; ++n) acc[a][b][m][n] = (f32x4){0.f, 0.f, 0.f, 0.f};
        cur = nxt; cA = nA; cB = nB; ++ui;
        if constexpr (ALIGN_EPI) { if (wr == 1) PG8_BAR; }
    }
    PG8_WAIT_V(0);
    if constexpr (!ALIGN_EPI) { if (wr == 0) PG8_BAR; }
    PG8_BAR;
    if constexpr (Epi::AFTER_DRAIN) { E.fused(acc, cur, wr, wc, fr, fq, lds, wid, lane); S.done(cur); }
#undef PG8_SA
#undef PG8_SB
#undef PG8_STAGE
#undef PG8_LDA
#undef PG8_LDB
#undef PG8_MMA
#undef PG8_WAIT_V
#undef PG8_WAIT_L
#undef PG8_BAR
#undef PG8_SCHED
}
}
namespace att {
using f32x16 = __attribute__((ext_vector_type(16))) float;
using s16x4  = __attribute__((ext_vector_type(4))) short;
using u32x4  = __attribute__((ext_vector_type(4))) unsigned;
constexpr int NW = 8, QBLK = 32, KVBLK = 64;
constexpr int SHM_V = 16384, SHM_K = 16384, SHM_P = 8192;
constexpr int OFF_V = 0, OFF_K = 2 * SHM_V, OFF_P = OFF_K + 2 * SHM_K, OFF_WS = OFF_P + 2 * SHM_P, OFF_BIAS = OFF_WS + NW * 64 * 4, OFF_QPE = OFF_BIAS + 2048, LDS_ATT = OFF_QPE + NW * 4096;
constexpr float THR = 8.f;
#define KSWZ(row, colB) ((row) * 256 + ((colB) ^ (((row) & 7) << 4)))
#define PSWZ(row, colB) ((row) * 128 + ((colB) ^ ((((row) >> 1) & 7) << 4)))
#define SBAR() __builtin_amdgcn_sched_barrier(0)
DEVI int crow(int r, int hi) { return (r & 3) + 8 * (r >> 2) + 4 * hi; }
DEVI unsigned cvtpk(float lo, float hi) { unsigned r; asm volatile("v_cvt_pk_bf16_f32 %0, %1, %2" : "=v"(r) : "v"(lo), "v"(hi)); return r; }

template <int TYPE> DEVI void partialSM(f32x16& p0, f32x16& p1, float& m_reg, float& mn, float& alpha) {
  constexpr float SCALE = TYPE == 1 ? 0.07216878364870322f : 0.08838834764831845f;
  constexpr float C = SCALE * 1.4426950408889634f;
  float pmax = p0[0];
#pragma unroll
  for (int r = 1; r < 16; ++r) pmax = fmaxf(pmax, p0[r]);
#pragma unroll
  for (int r = 0; r < 16; ++r) pmax = fmaxf(pmax, p1[r]);
  { auto rr = __builtin_amdgcn_permlane32_swap(__float_as_uint(pmax), __float_as_uint(pmax), false, false);
    pmax = fmaxf(__uint_as_float(rr[0]), __uint_as_float(rr[1])); }
  if (__builtin_expect(__all(pmax - m_reg <= THR / SCALE), 1)) { mn = m_reg; alpha = 1.f; }
  else { mn = fmaxf(m_reg, pmax); alpha = __builtin_amdgcn_exp2f((m_reg - mn) * C); m_reg = mn; }
  const float mnC = -mn * C;
#pragma unroll
  for (int r = 0; r < 16; ++r) p0[r] = fmaf(p0[r], C, mnC);
#pragma unroll
  for (int r = 0; r < 16; ++r) p1[r] = fmaf(p1[r], C, mnC);
#pragma unroll
  for (int r = 0; r < 16; ++r) p0[r] = __builtin_amdgcn_exp2f(p0[r]);
}
DEVI void finishSM(f32x16& p0, f32x16& p1, float alpha, float& l_reg, bf16x8& pa0, bf16x8& pa1, bf16x8& pa2, bf16x8& pa3) {
#pragma unroll
  for (int r = 0; r < 16; ++r) p1[r] = __builtin_amdgcn_exp2f(p1[r]);
  float ps = 0;
#pragma unroll
  for (int r = 0; r < 16; ++r) ps += p0[r];
#pragma unroll
  for (int r = 0; r < 16; ++r) ps += p1[r];
  { auto rr = __builtin_amdgcn_permlane32_swap(__float_as_uint(ps), __float_as_uint(ps), false, false);
    ps = __uint_as_float(rr[0]) + __uint_as_float(rr[1]); }
  l_reg = l_reg * alpha + ps;
#define PK4(P, BASE, OUT) do { unsigned a0 = cvtpk(P[BASE + 0], P[BASE + 1]), a1 = cvtpk(P[BASE + 2], P[BASE + 3]);   \
    unsigned b0 = cvtpk(P[BASE + 4], P[BASE + 5]), b1 = cvtpk(P[BASE + 6], P[BASE + 7]);                              \
    auto r0 = __builtin_amdgcn_permlane32_swap(a0, b0, false, false); auto r1 = __builtin_amdgcn_permlane32_swap(a1, b1, false, false); \
    u32x4 w = {r0[0], r1[0], r0[1], r1[1]}; OUT = *reinterpret_cast<bf16x8*>(&w); } while (0)
  PK4(p0, 0, pa0); PK4(p0, 8, pa1); PK4(p1, 0, pa2); PK4(p1, 8, pa3);
#undef PK4
}
template <int TYPE> DEVI void qkt(f32x16& p0, f32x16& p1, const char* Ks, const char* Ps, const bf16x8* qr, const char* Qe, int r32, int hi) {
  p0 = f32x16{}; p1 = f32x16{};
#pragma unroll
  for (int d0 = 0; d0 < 8; ++d0) { const int cb = (d0 * 16 + hi * 8) * 2;
    const bf16x8 b0 = *reinterpret_cast<const bf16x8*>(Ks + KSWZ(r32, cb));
    const bf16x8 b1 = *reinterpret_cast<const bf16x8*>(Ks + KSWZ(32 + r32, cb));
    p0 = __builtin_amdgcn_mfma_f32_32x32x16_bf16(b0, qr[d0], p0, 0, 0, 0);
    p1 = __builtin_amdgcn_mfma_f32_32x32x16_bf16(b1, qr[d0], p1, 0, 0, 0); }
  if constexpr (TYPE == 1) {
#pragma unroll
    for (int d0 = 0; d0 < 4; ++d0) { const int cb = (d0 * 16 + hi * 8) * 2;
      const bf16x8 b0 = *reinterpret_cast<const bf16x8*>(Ps + PSWZ(r32, cb));
      const bf16x8 b1 = *reinterpret_cast<const bf16x8*>(Ps + PSWZ(32 + r32, cb));
      const bf16x8 qe = *reinterpret_cast<const bf16x8*>(Qe + PSWZ(r32, cb));
      p0 = __builtin_amdgcn_mfma_f32_32x32x16_bf16(b0, qe, p0, 0, 0, 0);
      p1 = __builtin_amdgcn_mfma_f32_32x32x16_bf16(b1, qe, p1, 0, 0, 0); }
  }
}
DEVI int v_st(int k, int c) { const int kk = (k & ~0xC) | ((k & 4) << 1) | ((k & 8) >> 1); return ((kk >> 3) * 4 + (c >> 5)) * 512 + ((kk & 7) * 32 + (c & 31)) * 2; }
DEVI int v_rd_base(int lane) { return ((lane & 3) << 3) | (((lane >> 2) & 3) << 6) | (((lane >> 4) & 1) << 5) | (((lane >> 5) & 1) << 8); }
constexpr int v_rd_off(int d0, int ks, int half) { return d0 * 512 + ks * 4096 + half * 2048; }
template <int OFF> DEVI s16x4 tr_read(int vb) { s16x4 r; asm volatile("ds_read_b64_tr_b16 %0, %1 offset:%2" : "=&v"(r) : "v"(vb), "i"(OFF) : "memory"); return r; }
template <int D0> DEVI void pv_one(f32x16& od, int vb, bf16x8 pa0, bf16x8 pa1, bf16x8 pa2, bf16x8 pa3) {
  const s16x4 l0 = tr_read<v_rd_off(D0, 0, 0)>(vb), h0 = tr_read<v_rd_off(D0, 0, 1)>(vb), l1 = tr_read<v_rd_off(D0, 1, 0)>(vb), h1 = tr_read<v_rd_off(D0, 1, 1)>(vb);
  const s16x4 l2 = tr_read<v_rd_off(D0, 2, 0)>(vb), h2 = tr_read<v_rd_off(D0, 2, 1)>(vb), l3 = tr_read<v_rd_off(D0, 3, 0)>(vb), h3 = tr_read<v_rd_off(D0, 3, 1)>(vb);
  asm volatile("s_waitcnt lgkmcnt(0)" ::: "memory"); SBAR();
#define PK(L, H) (bf16x8){L[0], L[1], L[2], L[3], H[0], H[1], H[2], H[3]}
  od = __builtin_amdgcn_mfma_f32_32x32x16_bf16(pa0, PK(l0, h0), od, 0, 0, 0);
  od = __builtin_amdgcn_mfma_f32_32x32x16_bf16(pa1, PK(l1, h1), od, 0, 0, 0);
  od = __builtin_amdgcn_mfma_f32_32x32x16_bf16(pa2, PK(l2, h2), od, 0, 0, 0);
  od = __builtin_amdgcn_mfma_f32_32x32x16_bf16(pa3, PK(l3, h3), od, 0, 0, 0);
#undef PK
}
DEVI void pv_d0(f32x16* o, int vb, bf16x8 pa0, bf16x8 pa1, bf16x8 pa2, bf16x8 pa3) {
  pv_one<0>(o[0], vb, pa0, pa1, pa2, pa3); pv_one<1>(o[1], vb, pa0, pa1, pa2, pa3); pv_one<2>(o[2], vb, pa0, pa1, pa2, pa3); pv_one<3>(o[3], vb, pa0, pa1, pa2, pa3);
}
DEVI void nb_mask(f32x16& p0, f32x16& p1, int kr, int r, int r0, int c, int c0, int hi, const float* bt) {
  const bool active = (unsigned)(kr - r0) < 8u;
  if (!active) {
#pragma unroll
    for (int i = 0; i < 16; ++i) { p0[i] = -1e30f; p1[i] = -1e30f; }
  } else {
    const float* bp = bt + (kr - r + 7) * 31 + 15 - c + 4 * hi;
    const int dk = 4 * hi - c0;
#pragma unroll
    for (int i = 0; i < 16; ++i) { const int kc = (i & 3) + 8 * (i >> 2);
      p0[i] = ((unsigned)(kc + dk) < 16u) ? p0[i] + bp[kc] : -1e30f;
      p1[i] = ((unsigned)(kc + 32 + dk) < 16u) ? p1[i] + bp[kc + 32] : -1e30f; }
  }
}

template <int TYPE, int SDEPTH>
DEVI void attn_unit(int b, int h, int qb, const bf16_t* __restrict__ PROJ, const bf16_t* __restrict__ QB, const bf16_t* __restrict__ KVB,
                    const float* __restrict__ rpb, const float* __restrict__ qgain, const float2* __restrict__ tab, bf16_t* __restrict__ MIX, char* lds) {
  constexpr float SCALE = TYPE == 1 ? 0.07216878364870322f : 0.08838834764831845f;
  constexpr int NQ = 8;
  constexpr int LDQ = TYPE == 1 ? 768 : NP, LDK = TYPE == 1 ? 1024 : NP;
  int tid_ = threadIdx.x; asm volatile("" : "+v"(tid_));
  const int tid = tid_, wid = tid >> 6, lane = tid & 63, r32 = lane & 31, hi = lane >> 5;
  const size_t row0 = (size_t)b * SEQ + qb * 256, kb0 = (size_t)b * SEQ;
  const bf16_t* Qp = TYPE == 0 ? PROJ + row0 * NP + C_AQ + h * 128 : TYPE == 2 ? PROJ + row0 * NP + C_CQ + h * 128 : QB + row0 * 768 + h * 128;
  const bf16_t* Kh = TYPE == 0 ? PROJ + kb0 * NP + C_AK + (h >> 2) * 128 : TYPE == 2 ? PROJ + kb0 * NP + C_CK + h * 128 : KVB + kb0 * 1024 + h * 256;
  const bf16_t* Vh = TYPE == 0 ? PROJ + kb0 * NP + C_AV + (h >> 2) * 128 : TYPE == 2 ? PROJ + kb0 * NP + C_CV + h * 128 : KVB + kb0 * 1024 + h * 256 + 128;
  const bf16_t* Ph = PROJ + kb0 * NP + C_BKR;
  char* V_lds = lds + OFF_V; char* K_lds = lds + OFF_K; char* P_lds = lds + OFF_P;
  float* wsf = (float*)(lds + OFF_WS) + wid * 64; float* li_l = wsf; float* al_l = wsf + 32;
  float* bt = (float*)(lds + OFF_BIAS);
  int kt0 = 0, NT = SEQ / KVBLK;
  if (TYPE == 2) { if (qb == 0) { kt0 = 0; NT = 8; } else if (qb == 7) { kt0 = 24; NT = 8; } else { kt0 = min(4 * qb - 4, 20); NT = 12; } }
  const int nr = 4 * qb + (wid >> 1), nc = 32 * (wid & 1) + r32, nr0 = min(max(nr - 4, 0), 24), nc0 = min(max(nc - 8, 0), 48);
  if (TYPE == 2) { for (int i = tid; i < 465; i += 512) bt[i] = rpb[h * 465 + i] * (1.f / SCALE); }
  float m_reg = -1e30f, l_reg = 0; f32x16 o[4] = {}; bf16x8 qr[NQ];
  const bf16_t* Qw = Qp + (size_t)(wid * QBLK + r32) * LDQ + hi * 8;
#pragma unroll
  for (int d0 = 0; d0 < 8; ++d0) qr[d0] = *reinterpret_cast<const bf16x8*>(Qw + d0 * 16);
  if constexpr (TYPE == 0) {
    float ss = 0.f;
#pragma unroll
    for (int d0 = 0; d0 < 8; ++d0) { const u32x4 w = __builtin_bit_cast(u32x4, qr[d0]);
#pragma unroll
      for (int e = 0; e < 4; ++e) { const float x1 = __uint_as_float(w[e] << 16), x2 = __uint_as_float(w[e] & 0xffff0000u); ss += x1 * x1 + x2 * x2; } }
    { auto rr = __builtin_amdgcn_permlane32_swap(__float_as_uint(ss), __float_as_uint(ss), false, false); ss = __uint_as_float(rr[0]) + __uint_as_float(rr[1]); }
    const float rs = rsqrtf(ss * (1.f / 128.f) + EPS);
    const int t_ = qb * 256 + wid * QBLK + r32, pr = t_ >> 6, pc = t_ & 63;
#pragma unroll
    for (int d0 = 0; d0 < 8; ++d0) { const int ax = d0 >> 2, j0 = (d0 & 3) * 8 + hi * 4;
      const float4 g0 = *(const float4*)(qgain + 64 * ax + j0), g1 = *(const float4*)(qgain + 64 * ax + 32 + j0);
      const float4* tp = (const float4*)(tab + (ax == 0 ? T_AR + pr * 32 : T_AC + pc * 32) + j0); const float4 c01 = tp[0], c23 = tp[1];
      const u32x4 w = __builtin_bit_cast(u32x4, qr[d0]); u32x4 o_;
      { const float x1 = __uint_as_float(w[0] << 16) * rs * g0.x, x2 = __uint_as_float(w[0] & 0xffff0000u) * rs * g1.x; o_[0] = pk2(x1 * c01.x - x2 * c01.y, x2 * c01.x + x1 * c01.y); }
      { const float x1 = __uint_as_float(w[1] << 16) * rs * g0.y, x2 = __uint_as_float(w[1] & 0xffff0000u) * rs * g1.y; o_[1] = pk2(x1 * c01.z - x2 * c01.w, x2 * c01.z + x1 * c01.w); }
      { const float x1 = __uint_as_float(w[2] << 16) * rs * g0.z, x2 = __uint_as_float(w[2] & 0xffff0000u) * rs * g1.z; o_[2] = pk2(x1 * c23.x - x2 * c23.y, x2 * c23.x + x1 * c23.y); }
      { const float x1 = __uint_as_float(w[3] << 16) * rs * g0.w, x2 = __uint_as_float(w[3] & 0xffff0000u) * rs * g1.w; o_[3] = pk2(x1 * c23.z - x2 * c23.w, x2 * c23.z + x1 * c23.w); }
      qr[d0] = __builtin_bit_cast(bf16x8, o_); }
  }
  const char* Qe = lds + OFF_QPE + wid * 4096;
  if constexpr (TYPE == 1) {
#pragma unroll
    for (int i = 0; i < 4; ++i) { const int idx = i * 64 + lane, rw = idx >> 3, ch = idx & 7;
      *(u32x4*)(lds + OFF_QPE + wid * 4096 + PSWZ(rw, ch * 16)) = *reinterpret_cast<const u32x4*>(QB + (row0 + wid * QBLK + rw) * 768 + 512 + h * 64 + ch * 8); } }
  const int sr = tid >> 4, sc = (tid & 15) * 8, vst0 = v_st(sr, sc), vst1 = v_st(32 + sr, sc);
  const int pr_ = tid >> 3, pc_ = (tid & 7) * 8;
  const int vb0 = (int)(uintptr_t)V_lds + v_rd_base(lane);
  struct { bf16x8 vs0, vs1, ks0, ks1, ps; } sr_[2];
#define SLOAD(i, k0) do { const size_t kk_ = (size_t)(kt0 * KVBLK + (k0)); \
    sr_[i].vs0 = *reinterpret_cast<const bf16x8*>(&Vh[(kk_ + sr) * LDK + sc]); sr_[i].vs1 = *reinterpret_cast<const bf16x8*>(&Vh[(kk_ + 32 + sr) * LDK + sc]); \
    sr_[i].ks0 = *reinterpret_cast<const bf16x8*>(&Kh[(kk_ + sr) * LDK + sc]); sr_[i].ks1 = *reinterpret_cast<const bf16x8*>(&Kh[(kk_ + 32 + sr) * LDK + sc]); \
    if constexpr (TYPE == 1) sr_[i].ps = *reinterpret_cast<const bf16x8*>(&Ph[(kk_ + pr_) * NP + pc_]); } while (0)
#define SWRITE(bf, i) do { *(bf16x8*)(V_lds + (bf) * SHM_V + vst0) = sr_[i].vs0; *(bf16x8*)(V_lds + (bf) * SHM_V + vst1) = sr_[i].vs1; const int kc = sc * 2; \
    *(bf16x8*)(K_lds + (bf) * SHM_K + KSWZ(sr, kc)) = sr_[i].ks0; *(bf16x8*)(K_lds + (bf) * SHM_K + KSWZ(32 + sr, kc)) = sr_[i].ks1; \
    if constexpr (TYPE == 1) *(bf16x8*)(P_lds + (bf) * SHM_P + PSWZ(pr_, pc_ * 2)) = sr_[i].ps; } while (0)
#define SWAIT() do { if constexpr (SDEPTH == 2) { if constexpr (TYPE == 1) asm volatile("s_waitcnt vmcnt(5)" ::: "memory"); else asm volatile("s_waitcnt vmcnt(4)" ::: "memory"); } \
    else asm volatile("s_waitcnt vmcnt(0)" ::: "memory"); } while (0)
#define RESC(a) do { if (__any((a) < 1.f)) { if (hi == 0) al_l[r32] = (a); asm volatile("s_waitcnt lgkmcnt(0)" ::: "memory"); \
    _Pragma("unroll") for (int d = 0; d < 4; ++d) _Pragma("unroll") for (int r = 0; r < 16; ++r) o[d][r] *= al_l[crow(r, hi)]; } } while (0)
#define MASK(P0, P1, j) do { if constexpr (TYPE == 2) nb_mask(P0, P1, kt0 + (j), nr, nr0, nc, nc0, hi, bt); } while (0)
  f32x16 pA0, pA1, pB0, pB1; float mnA, mnB, alA, alB; bf16x8 pa0, pa1, pa2, pa3;
  constexpr int SE = 0, SO = SDEPTH - 1;
  if constexpr (TYPE == 2) {
    const int wnr0 = __builtin_amdgcn_readfirstlane(nr0);
#define ACT(j) ((unsigned)(kt0 + (j) - wnr0) < 8u)
#define TILE(j, bf) do { if (ACT(j)) { qkt<TYPE>(pA0, pA1, K_lds + (bf) * SHM_K, P_lds, qr, Qe, r32, hi); MASK(pA0, pA1, j); partialSM<TYPE>(pA0, pA1, m_reg, mnA, alA); RESC(alA); \
      finishSM(pA0, pA1, alA, l_reg, pa0, pa1, pa2, pa3); SBAR(); pv_d0(o, vb0 + (bf) * SHM_V, pa0, pa1, pa2, pa3); } } while (0)
    SLOAD(0, 0); asm volatile("s_waitcnt vmcnt(0)" ::: "memory"); SWRITE(0, 0); __syncthreads();
    SLOAD(1, KVBLK); if constexpr (SDEPTH == 2) SLOAD(0, 2 * KVBLK);
    for (int j = 0; j < NT; j += 2) {
      TILE(j, 0);
      SWAIT(); SWRITE(1, 1);
      if constexpr (SDEPTH == 2) { if (j + 3 < NT) SLOAD(1, (j + 3) * KVBLK); }
      __syncthreads();
      if constexpr (SDEPTH == 1) { if (j + 2 < NT) SLOAD(0, (j + 2) * KVBLK); }
      TILE(j + 1, 1);
      if (j + 2 < NT) { SWAIT(); SWRITE(0, 0);
        if constexpr (SDEPTH == 2) { if (j + 4 < NT) SLOAD(0, (j + 4) * KVBLK); }
        __syncthreads();
        if constexpr (SDEPTH == 1) SLOAD(1, (j + 3) * KVBLK); }
    }
#undef TILE
#undef ACT
  } else {
  SLOAD(SE, 0); asm volatile("s_waitcnt vmcnt(0)" ::: "memory"); SWRITE(0, SE); __syncthreads();
  qkt<TYPE>(pA0, pA1, K_lds, P_lds, qr, Qe, r32, hi); MASK(pA0, pA1, 0); partialSM<TYPE>(pA0, pA1, m_reg, mnA, alA);
  SLOAD(SO, KVBLK); if constexpr (SDEPTH == 2) { if (2 < NT) SLOAD(SE, 2 * KVBLK); }
  SWAIT(); SWRITE(1, SO); __syncthreads();
  for (int j = 1; j + 1 < NT; j += 2) {
    SBAR(); qkt<TYPE>(pB0, pB1, K_lds + SHM_K, P_lds + SHM_P, qr, Qe, r32, hi); MASK(pB0, pB1, j);
    finishSM(pA0, pA1, alA, l_reg, pa0, pa1, pa2, pa3); SBAR();
    SLOAD(SO, (j + SDEPTH) * KVBLK); SBAR();
    pv_d0(o, vb0, pa0, pa1, pa2, pa3); partialSM<TYPE>(pB0, pB1, m_reg, mnB, alB);
    __syncthreads(); SWAIT(); SWRITE(0, SE);
    RESC(alB); __syncthreads();
    SBAR(); qkt<TYPE>(pA0, pA1, K_lds, P_lds, qr, Qe, r32, hi); MASK(pA0, pA1, j + 1);
    finishSM(pB0, pB1, alB, l_reg, pa0, pa1, pa2, pa3); SBAR();
    if (SDEPTH == 1 || j + 3 < NT) SLOAD(SE, (j + 1 + SDEPTH) * KVBLK); SBAR();
    pv_d0(o, vb0 + SHM_V, pa0, pa1, pa2, pa3); partialSM<TYPE>(pA0, pA1, m_reg, mnA, alA);
    __syncthreads(); SWAIT(); SWRITE(1, SO);
    RESC(alA); __syncthreads();
  }
  SBAR(); qkt<TYPE>(pB0, pB1, K_lds + SHM_K, P_lds + SHM_P, qr, Qe, r32, hi); MASK(pB0, pB1, NT - 1);
  finishSM(pA0, pA1, alA, l_reg, pa0, pa1, pa2, pa3); SBAR();
  pv_d0(o, vb0, pa0, pa1, pa2, pa3); partialSM<TYPE>(pB0, pB1, m_reg, mnB, alB);
  __syncthreads(); RESC(alB);
  finishSM(pB0, pB1, alB, l_reg, pa0, pa1, pa2, pa3); SBAR();
  pv_d0(o, vb0 + SHM_V, pa0, pa1, pa2, pa3);
  }
  if (hi == 0) li_l[r32] = l_reg; asm volatile("s_waitcnt lgkmcnt(0)" ::: "memory");
  float rli[16];
#pragma unroll
  for (int r = 0; r < 16; ++r) rli[r] = __builtin_amdgcn_rcpf(li_l[crow(r, hi)]);
  __syncthreads();
  bf16_t* stg = (bf16_t*)(lds + wid * 8192);
#pragma unroll
  for (int r = 0; r < 16; ++r) { const int orow = crow(r, hi);
#pragma unroll
    for (int d0 = 0; d0 < 4; ++d0) stg[orow * 128 + d0 * 32 + r32] = (bf16_t)f2bf(o[d0][r] * rli[r]); }
  asm volatile("s_waitcnt lgkmcnt(0)" ::: "memory");
  constexpr int GCOL = TYPE == 0 ? C_AG : TYPE == 1 ? C_BG : C_CG, MCOL = TYPE == 0 ? 0 : TYPE == 1 ? 1024 : 1536;
  const bf16_t* Gp = PROJ + (row0 + wid * QBLK) * NP + GCOL + h * 128; bf16_t* Op = MIX + (row0 + wid * QBLK) * DMIX + MCOL + h * 128;
#pragma unroll
  for (int i = 0; i < 8; ++i) { const int pidx = i * 64 + lane, row = pidx >> 4, ch = pidx & 15;
    const u32x4 ov = *(const u32x4*)(stg + row * 128 + ch * 8); const u32x4 gv = *(const u32x4*)(Gp + (size_t)row * NP + ch * 8);
    u32x4 w;
#pragma unroll
    for (int e = 0; e < 4; ++e) { const float g0 = bf2f(gv[e] & 0xffffu), g1 = bf2f(gv[e] >> 16), o0 = bf2f(ov[e] & 0xffffu), o1 = bf2f(ov[e] >> 16);
      w[e] = pk2(o0 * g0 * __builtin_amdgcn_rcpf(1.f + __expf(-g0)), o1 * g1 * __builtin_amdgcn_rcpf(1.f + __expf(-g1))); }
    *(u32x4*)(Op + (size_t)row * DMIX + ch * 8) = w; }
  __syncthreads();
#undef SLOAD
#undef SWRITE
#undef SWAIT
#undef RESC
#undef MASK
}
#undef SBAR
}
#ifndef AMASK
#define AMASK 7
#endif
#ifndef REP_KIND
#define REP_KIND -1
#endif
#ifndef G1_NOEPI
#define G1_NOEPI 0
#endif
#ifndef G1_ALIGN
#define G1_ALIGN true
#endif
#ifndef G1_SP2
#define G1_SP2 true
#endif
#ifndef AREP
#define AREP 7
#endif
#define NREP(k) ((k) == REP_KIND ? 2 : 1)
constexpr int NWAVES = 8;
constexpr int N_PHASES = 1 + 5 * DEPTH;
constexpr size_t WS_CTL = 0, CTL_ZERO_BYTES = 64 * 1024;
constexpr int CW_BAR = 1024;
constexpr int RING_OFF = 0, RING_BYTES = 131072;
constexpr int LDSCTL_OFF = RING_BYTES, MISC_OFF = LDSCTL_OFF + 320, RST_OFF = LDSCTL_OFF + 1024;
constexpr int LDS_BYTES = 147456;

#define GAS __attribute__((address_space(1)))
#define LAS __attribute__((address_space(3)))
typedef GAS unsigned gu32;
#define RLX_AGENT __ATOMIC_RELAXED, __HIP_MEMORY_SCOPE_AGENT

#define XB_TMO      128
#define XB_XCNT(j)  (256  + 64 * (j))
#define XB_XSUB(j)  (1280 + 64 * (j))
#define XB_XGEN(j)  (2304 + 64 * (j))
#define XB_TOP      3328
#define XB_TOPGEN   3392
#define XCD_BAR_WORDS 3456
#define XB_SPIN_CAP (1u << 18)
__device__ __forceinline__ unsigned xb_ld(unsigned* p)              { return __hip_atomic_load(p, __ATOMIC_RELAXED, __HIP_MEMORY_SCOPE_AGENT); }
__device__ __forceinline__ unsigned xb_add(unsigned* p, unsigned v) { return __hip_atomic_fetch_add(p, v, __ATOMIC_RELAXED, __HIP_MEMORY_SCOPE_AGENT); }
__device__ __forceinline__ unsigned xb_xcc_id() { return (unsigned)__builtin_amdgcn_s_getreg((3 << 11) | 20) & 0xFu; }
#define XB_SPIN(cond, bar) do { unsigned _sp = 0; while (cond) { __builtin_amdgcn_s_sleep(1); \
    if ((++_sp & 255u) == 0u) { if (xb_ld(&(bar)[XB_TMO])) break; if (_sp > XB_SPIN_CAP) { atomicAdd(&(bar)[XB_TMO], 1u); break; } } } } while (0)
struct XcdBarrier { unsigned* bar; unsigned x; volatile LAS unsigned* st; };
__device__ __forceinline__ XcdBarrier xcd_barrier_post(unsigned* bar, volatile LAS unsigned* st) {
    XcdBarrier b; b.bar = bar; b.x = xb_xcc_id(); b.st = st;
    if (threadIdx.x == 0) (void)xb_add(&bar[XB_XCNT(b.x)], 1u);
    return b;
}
__device__ __forceinline__ void xcd_barrier_complete(unsigned* bar, unsigned x, unsigned& nloc, unsigned& nx) {
    const unsigned G = gridDim.x * gridDim.y * gridDim.z;
    unsigned sum, cnt, mine, sp = 0u;
    for (;;) {
        sum = 0u; cnt = 0u; mine = 0u;
#pragma unroll
        for (unsigned j = 0; j < 16; ++j) { const unsigned c = xb_ld(&bar[XB_XCNT(j)]); sum += c; cnt += (c > 0u) ? 1u : 0u; mine = (j == x) ? c : mine; }
        if (sum == G) break;
        __builtin_amdgcn_s_sleep(1);
        if ((++sp & 255u) == 0u) { if (xb_ld(&bar[XB_TMO])) break; if (sp > XB_SPIN_CAP) { atomicAdd(&bar[XB_TMO], 1u); break; } }
    }
    nloc = mine > 0u ? mine : 1u; nx = cnt > 0u ? cnt : 1u;
}
__device__ __forceinline__ void xcd_barrier(const XcdBarrier& b) {
    asm volatile("s_waitcnt vmcnt(0)" ::: "memory");
    __syncthreads();
    if (threadIdx.x == 0) {
        unsigned* bar = b.bar;
        __builtin_amdgcn_s_waitcnt(0);
        unsigned nloc = b.st[0], nx = b.st[1];
        if (nloc == 0u) { xcd_barrier_complete(bar, b.x, nloc, nx); b.st[0] = nloc; b.st[1] = nx; }
        const unsigned old = xb_add(&bar[XB_XSUB(b.x)], 1u);
        const unsigned gen = old / nloc;
        if (old + 1u == (gen + 1u) * nloc) {
            __builtin_amdgcn_fence(__ATOMIC_RELEASE, "agent");
            asm volatile("s_waitcnt vmcnt(0)" ::: "memory");
            const unsigned og = xb_add(&bar[XB_TOP], 1u);
            const unsigned tg = og / nx;
            if (og + 1u == (tg + 1u) * nx) xb_add(&bar[XB_TOPGEN], 1u);
            else XB_SPIN(xb_ld(&bar[XB_TOPGEN]) == tg, bar);
            __builtin_amdgcn_fence(__ATOMIC_ACQUIRE, "agent");
            xb_add(&bar[XB_XGEN(b.x)], 1u);
            asm volatile("s_waitcnt vmcnt(0)" ::: "memory");
        } else {
            XB_SPIN(xb_ld(&bar[XB_XGEN(b.x)]) == gen, bar);
            __builtin_amdgcn_fence(__ATOMIC_ACQUIRE, "agent");
            asm volatile("s_waitcnt vmcnt(0)" ::: "memory");
        }
    }
    __syncthreads();
}

struct Args {
    const float* in[12]; float* out; unsigned char* ws;
    int ph_lo, ph_hi, li, amask;
};


DEVI void p0_transpose_item(const float* __restrict__ W, int K, int Ns, int Nd, int mode, const float* __restrict__ kgain, bf16_t* __restrict__ WT, LAS float* scr, int item, int lane) {
    const int nblk = Nd / 32, kb = item / nblk, nb = item % nblk, k0 = 64 * kb, n0 = 32 * nb;
    const int so = map_col(mode, n0 + (lane & 31));
#pragma unroll 8
    for (int i = 0; i < 32; ++i) { const int kk = 2 * i + (lane >> 5); scr[kk * 33 + (lane & 31)] = so >= 0 ? W[(size_t)(k0 + kk) * Ns + so] * (kgain ? kgain[k0 + kk] : 1.f) : 0.f; }
    asm volatile("s_waitcnt lgkmcnt(0)" ::: "memory");
    const int c = lane & 7;
#pragma unroll
    for (int j = 0; j < 4; ++j) { const int n = (lane >> 3) + 8 * j; const LAS float* s = scr + (8 * c) * 33 + n;
        uint4 o; o.x = pk2(s[0 * 33], s[1 * 33]); o.y = pk2(s[2 * 33], s[3 * 33]); o.z = pk2(s[4 * 33], s[5 * 33]); o.w = pk2(s[6 * 33], s[7 * 33]);
        *(uint4*)(WT + (size_t)(n0 + n) * K + k0 + 8 * c) = o; }
    asm volatile("s_waitcnt lgkmcnt(0)" ::: "memory");
}
DEVI void rmsnorm_row_xn(const float* __restrict__ xrow, const float* __restrict__ g, bf16_t* __restrict__ orow, int lane) {
    const float4* xr = (const float4*)xrow + lane;
    float4 v[8]; float ss = 0.f;
#pragma unroll
    for (int j = 0; j < 8; ++j) { v[j] = xr[64 * j]; ss += v[j].x * v[j].x + v[j].y * v[j].y + v[j].z * v[j].z + v[j].w * v[j].w; }
    const float rs = rsqrtf(wave_sum(ss) * (1.f / DM) + EPS);
    uint2* o = (uint2*)orow + lane;
#pragma unroll
    for (int j = 0; j < 8; ++j) { const float4 gg = ((const float4*)g)[lane + 64 * j];
        o[64 * j] = make_uint2(pk2(v[j].x * rs * gg.x, v[j].y * rs * gg.y), pk2(v[j].z * rs * gg.z, v[j].w * rs * gg.w)); }
}
DEVI void phase_prologue(const Args& args, LAS unsigned char* L, int gw, int NGW, int wave, int lane) {
    unsigned char* ws = args.ws;
    LAS float* scr = (LAS float*)(L + RING_OFF + wave * 16384);
    constexpr int I_IN = (DM / 64) * (NP / 32), I_OUT = (DMIX / 64) * (DM / 32), I_UQ = (512 / 64) * (768 / 32), I_UKV = (256 / 64) * (1024 / 32), I_L = I_IN + I_OUT + I_UQ + I_UKV;
    for (int it = gw; it < DEPTH * I_L; it += NGW) {
        const int l = it / I_L; int r = it % I_L;
        if (r < I_IN) { p0_transpose_item(args.in[3] + (size_t)l * DM * DIN, DM, DIN, NP, 1, nullptr, (bf16_t*)(ws + WS_WIN + l * WIN_L), scr, r, lane); continue; } r -= I_IN;
        if (r < I_OUT) { p0_transpose_item(args.in[11] + (size_t)l * DMIX * DM, DMIX, DM, DM, 0, nullptr, (bf16_t*)(ws + WS_WOUT + l * WOUT_L), scr, r, lane); continue; } r -= I_OUT;
        if (r < I_UQ) { p0_transpose_item(args.in[8] + (size_t)l * 512 * 768, 512, 768, 768, 2, args.in[6] + l * 512, (bf16_t*)(ws + WS_WUQ + l * WUQ_L), scr, r, lane); continue; } r -= I_UQ;
        p0_transpose_item(args.in[9] + (size_t)l * 256 * 1024, 256, 1024, 1024, 0, args.in[7] + l * 256, (bf16_t*)(ws + WS_WUKV + l * WUKV_L), scr, r, lane);
    }
    bf16_t* XN = (bf16_t*)(ws + WS_XN);
    for (int m = gw; m < M; m += NGW) rmsnorm_row_xn(args.in[0] + (size_t)m * DM, args.in[1], XN + (size_t)m * DM, lane);
    float2* tab = (float2*)(ws + WS_TAB);
    for (int i = gw * 64 + lane; i < T_N; i += NGW * 64) {
        int pos, j; float n;
        if (i < T_AC) { pos = i >> 5; j = i & 31; n = 64.f; }
        else if (i < T_BR) { pos = (i - T_AC) >> 5; j = i & 31; n = 64.f; }
        else if (i < T_BC) { pos = (i - T_BR) >> 4; j = i & 15; n = 32.f; }
        else { pos = (i - T_BC) >> 4; j = i & 15; n = 32.f; }
        const float inv = 1.0f / powf(10000.f, (float)(2 * j) / n);
        const float ang = (float)pos * inv;
        const float k = rintf(ang * 0.15915494309189535f);
        float r = fmaf(-k, 6.28318548202514648f, ang); r = fmaf(-k, -1.74845553e-7f, r);
        tab[i] = make_float2(cosf(r), sinf(r));
    }
}
DEVI void postproj_row(bf16_t* __restrict__ p, int row, int lane, const float* __restrict__ a_qn, const float* __restrict__ a_kn,
                       const float* __restrict__ b_qn, const float* __restrict__ b_kvn, const float2* __restrict__ tab) {
    const int t = row & (SEQ - 1), pr = t >> 6, pc = t & 63;
    {
        const int a = lane >> 5, j = lane & 31;
        const float2 cs = a == 0 ? tab[T_AR + pr * 32 + j] : tab[T_AC + pc * 32 + j];
        const int d1 = 64 * a + j, d2 = d1 + 32;
        const float gq1 = a_qn[d1], gq2 = a_qn[d2], gk1 = a_kn[d1], gk2 = a_kn[d2];
        unsigned v[10];
#pragma unroll
        for (int hb = 0; hb < 10; ++hb) v[hb] = ((const unsigned*)(p + hb * 128))[lane];
#pragma unroll
        for (int hb = 0; hb < 10; ++hb) {
            const float x1 = bf2f(v[hb] & 0xffffu), x2 = bf2f(v[hb] >> 16);
            const float rs = rsqrtf(wave_sum(x1 * x1 + x2 * x2) * (1.f / 128.f) + EPS);
            const float y1 = x1 * rs * (hb < 8 ? gq1 : gk1), y2 = x2 * rs * (hb < 8 ? gq2 : gk2);
            ((unsigned*)(p + hb * 128))[lane] = pk2(y1 * cs.x - y2 * cs.y, y2 * cs.x + y1 * cs.y);
        }
    }
    {
        uint4* pp = (uint4*)(p + C_BCQ) + lane; const uint4 v = *pp; float x[8];
        x[0] = bf2f(v.x & 0xffffu); x[1] = bf2f(v.x >> 16); x[2] = bf2f(v.y & 0xffffu); x[3] = bf2f(v.y >> 16);
        x[4] = bf2f(v.z & 0xffffu); x[5] = bf2f(v.z >> 16); x[6] = bf2f(v.w & 0xffffu); x[7] = bf2f(v.w >> 16);
        float ss = 0.f;
#pragma unroll
        for (int i = 0; i < 8; ++i) ss += x[i] * x[i];
        const float rs = rsqrtf(wave_sum(ss) * (1.f / 512.f) + EPS);
        const float4 g0 = ((const float4*)b_qn)[2 * lane], g1 = ((const float4*)b_qn)[2 * lane + 1];
        *pp = make_uint4(pk2(x[0] * rs * g0.x, x[1] * rs * g0.y), pk2(x[2] * rs * g0.z, x[3] * rs * g0.w),
                         pk2(x[4] * rs * g1.x, x[5] * rs * g1.y), pk2(x[6] * rs * g1.z, x[7] * rs * g1.w));
    }
    {
        uint2* pp = (uint2*)(p + C_BCKV) + lane; const uint2 v = *pp;
        const float x0 = bf2f(v.x & 0xffffu), x1 = bf2f(v.x >> 16), x2 = bf2f(v.y & 0xffffu), x3 = bf2f(v.y >> 16);
        const float rs = rsqrtf(wave_sum(x0 * x0 + x1 * x1 + x2 * x2 + x3 * x3) * (1.f / 256.f) + EPS);
        const float4 g = ((const float4*)b_kvn)[lane];
        *pp = make_uint2(pk2(x0 * rs * g.x, x1 * rs * g.y), pk2(x2 * rs * g.z, x3 * rs * g.w));
    }
    if (lane < 32) {
        const int a = lane >> 4, j = lane & 15;
        const float2 cs = a == 0 ? tab[T_BR + pr * 16 + j] : tab[T_BC + pc * 16 + j];
        unsigned* pp = (unsigned*)(p + C_BKR) + lane; const unsigned v = *pp; const float x1 = bf2f(v & 0xffffu), x2 = bf2f(v >> 16);
        *pp = pk2(x1 * cs.x - x2 * cs.y, x2 * cs.x + x1 * cs.y);
    }
}
DEVI void postprojK_row(bf16_t* __restrict__ p, int row, int lane, const float* __restrict__ a_kn, const float2* __restrict__ tab) {
    const int t = row & (SEQ - 1), pr = t >> 6, pc = t & 63;
    const int a = lane >> 5, j = lane & 31;
    const float2 cs = a == 0 ? tab[T_AR + pr * 32 + j] : tab[T_AC + pc * 32 + j];
    const float gk1 = a_kn[64 * a + j], gk2 = a_kn[64 * a + j + 32];
    unsigned* pk = (unsigned*)(p + C_AK); const unsigned v0 = pk[lane], v1 = pk[64 + lane];
    unsigned vr = 0; const int a2 = lane >> 4, j2 = lane & 15; float2 cs2 = make_float2(1.f, 0.f);
    if (lane < 32) { vr = ((const unsigned*)(p + C_BKR))[lane]; cs2 = a2 == 0 ? tab[T_BR + pr * 16 + j2] : tab[T_BC + pc * 16 + j2]; }
    { const float x1 = bf2f(v0 & 0xffffu), x2 = bf2f(v0 >> 16); const float rs = rsqrtf(wave_sum(x1 * x1 + x2 * x2) * (1.f / 128.f) + EPS);
      const float y1 = x1 * rs * gk1, y2 = x2 * rs * gk2; pk[lane] = pk2(y1 * cs.x - y2 * cs.y, y2 * cs.x + y1 * cs.y); }
    { const float x1 = bf2f(v1 & 0xffffu), x2 = bf2f(v1 >> 16); const float rs = rsqrtf(wave_sum(x1 * x1 + x2 * x2) * (1.f / 128.f) + EPS);
      const float y1 = x1 * rs * gk1, y2 = x2 * rs * gk2; pk[64 + lane] = pk2(y1 * cs.x - y2 * cs.y, y2 * cs.x + y1 * cs.y); }
    if (lane < 32) { const float x1 = bf2f(vr & 0xffffu), x2 = bf2f(vr >> 16); ((unsigned*)(p + C_BKR))[lane] = pk2(x1 * cs2.x - x2 * cs2.y, x2 * cs2.x + x1 * cs2.y); }
}
template <bool FIRST>
DEVI void rowpass_row(const bf16_t* __restrict__ yrow, const float* __restrict__ xrow, const bf16_t* __restrict__ x1row_in, const float* __restrict__ g_post, float* __restrict__ orow_,
                      bf16_t* __restrict__ x1row_out, const float* __restrict__ g_next, bf16_t* __restrict__ xnrow, int lane) {
    const uint2* yr = (const uint2*)yrow + lane;
    float4 v[8]; float ss = 0.f;
#pragma unroll
    for (int j = 0; j < 8; ++j) { const uint2 yv = yr[64 * j]; v[j] = make_float4(bf2f(yv.x & 0xffffu), bf2f(yv.x >> 16), bf2f(yv.y & 0xffffu), bf2f(yv.y >> 16)); ss += v[j].x * v[j].x + v[j].y * v[j].y + v[j].z * v[j].z + v[j].w * v[j].w; }
    const float rs = rsqrtf(wave_sum(ss) * (1.f / DM) + EPS);
    float s2 = 0.f;
#pragma unroll
    for (int j = 0; j < 8; ++j) { const float4 gg = ((const float4*)g_post)[lane + 64 * j]; float4 xx;
        if (FIRST) xx = ((const float4*)xrow)[lane + 64 * j];
        else { const uint2 xv = ((const uint2*)x1row_in)[lane + 64 * j]; xx = make_float4(bf2f(xv.x & 0xffffu), bf2f(xv.x >> 16), bf2f(xv.y & 0xffffu), bf2f(xv.y >> 16)); }
        v[j].x = xx.x + v[j].x * rs * gg.x; v[j].y = xx.y + v[j].y * rs * gg.y; v[j].z = xx.z + v[j].z * rs * gg.z; v[j].w = xx.w + v[j].w * rs * gg.w;
        if (FIRST) { ((uint2*)x1row_out)[lane + 64 * j] = make_uint2(pk2(v[j].x, v[j].y), pk2(v[j].z, v[j].w)); s2 += v[j].x * v[j].x + v[j].y * v[j].y + v[j].z * v[j].z + v[j].w * v[j].w; }
        else ((float4*)orow_)[lane + 64 * j] = v[j]; }
    if (FIRST) {
        const float r2 = rsqrtf(wave_sum(s2) * (1.f / DM) + EPS);
        uint2* o = (uint2*)xnrow + lane;
#pragma unroll
        for (int j = 0; j < 8; ++j) { const float4 gg = ((const float4*)g_next)[lane + 64 * j];
            o[64 * j] = make_uint2(pk2(v[j].x * r2 * gg.x, v[j].y * r2 * gg.y), pk2(v[j].z * r2 * gg.z, v[j].w * r2 * gg.w)); }
    }
}

__global__ void __launch_bounds__(NWAVES * 64, 2) mk_fwd(Args args) {
    extern __shared__ __attribute__((aligned(16))) unsigned char lds[];
    LAS unsigned char* L = (LAS unsigned char*)lds;
    volatile LAS unsigned* MISC = (volatile LAS unsigned*)(L + MISC_OFF);
    const int G = gridDim.x; const int bx = blockIdx.x;
    const int vcu = (G % 8 == 0) ? (bx % 8) * (G / 8) + bx / 8 : bx;
    unsigned char* ws = args.ws;
    gu32* ctl = (gu32*)(ws + WS_CTL);
    for (int u = threadIdx.x; u < (LDS_BYTES - LDSCTL_OFF) / 4; u += NWAVES * 64) ((LAS unsigned*)(L + LDSCTL_OFF))[u] = 0u;
    __syncthreads();
    XcdBarrier bar; bar.bar = (unsigned*)(ctl + CW_BAR) + args.li * XCD_BAR_WORDS; bar.x = 0; bar.st = nullptr;
    const bool multi = (args.ph_hi - args.ph_lo) > 1;
    if (multi) bar = xcd_barrier_post((unsigned*)(ctl + CW_BAR) + args.li * XCD_BAR_WORDS, MISC + 8);
    bf16_t* XN = (bf16_t*)(ws + WS_XN); bf16_t* PROJ = (bf16_t*)(ws + WS_PROJ); bf16_t* Y = (bf16_t*)(ws + WS_Y);
    bf16_t* QB = (bf16_t*)(ws + WS_QB); bf16_t* KVB = (bf16_t*)(ws + WS_KVB); bf16_t* MIX = (bf16_t*)(ws + WS_MIX);
    const int lo = args.ph_lo, hi = args.ph_hi;
#define IN(k) (lo <= (k) && (k) < hi)
#define SEAM(k) do { if (IN(k) && IN((k) + 1)) xcd_barrier(bar); } while (0)
    const int NGW = G * NWAVES;
#define FRESH_IDS() int tid__ = threadIdx.x; asm volatile("" : "+v"(tid__)); const int lane_ = tid__ & 63, wave_ = __builtin_amdgcn_readfirstlane(tid__ >> 6), gw_ = vcu * NWAVES + wave_
    const float2* tab = (const float2*)(ws + WS_TAB);
    if (IN(0)) { for (int rep_ = 0; rep_ < NREP(0); ++rep_) { FRESH_IDS(); phase_prologue(args, L, gw_, NGW, wave_, lane_); } }
    SEAM(0);
#define LAYER(l) do { \
        constexpr int pb = 1 + 5 * (l); \
        if (IN(pb + 0)) { for (int rep_ = 0; rep_ < NREP(1); ++rep_) { \
            pg8::Gemm g{XN, (const bf16_t*)(ws + WS_WIN + (l) * WIN_L)}; pg8::StaticOrder S; S.init(M, NP, G, bx); \
            pg8::EpiBf16 E{PROJ, NP}; \
            pg8::gemm_phase<DM, DM, DM, pg8::EpiBf16, pg8::StaticOrder, true, true>(L + RING_OFF, g, S, E); \
        } } \
        SEAM(pb + 0); \
        if (IN(pb + 1)) { for (int rep_ = 0; rep_ < NREP(3); ++rep_) { \
            if (rep_ == 0) { FRESH_IDS(); for (int m = gw_; m < M; m += NGW) postprojK_row(PROJ + (size_t)m * NP, m, lane_, args.in[5] + (l) * 128, tab); } \
            { pg8::Gemm g{PROJ + C_BCQ, (const bf16_t*)(ws + WS_WUQ + (l) * WUQ_L)}; pg8::RsOrder<512, NP> S; S.init(M, 768, G, bx); S.A = PROJ + C_BCQ; S.tab = (LAS float*)(L + RST_OFF); \
              pg8::EpiBf16Rs<2> E{QB, 768, (const LAS float*)(L + RST_OFF), tab + T_BR, tab + T_BC}; \
              pg8::gemm_phase<512, NP, 512, pg8::EpiBf16Rs<2>, pg8::RsOrder<512, NP>, true, true>(L + RING_OFF, g, S, E); } \
            { pg8::Gemm g{PROJ + C_BCKV, (const bf16_t*)(ws + WS_WUKV + (l) * WUKV_L)}; pg8::RsOrder<256, NP> S; S.init(M, 1024, G, bx); S.A = PROJ + C_BCKV; S.tab = (LAS float*)(L + RST_OFF); \
              pg8::EpiBf16Rs<-1> E{KVB, 1024, (const LAS float*)(L + RST_OFF), tab, tab}; \
              pg8::gemm_phase<256, NP, 256, pg8::EpiBf16Rs<-1>, pg8::RsOrder<256, NP>, true, true>(L + RING_OFF, g, S, E); } \
        } } \
        SEAM(pb + 1); \
        if (IN(pb + 2)) { for (int rep_ = 0; rep_ < NREP(4); ++rep_) { \
            const float* rpb_l = args.in[10] + (size_t)(l) * 4 * 465; const float* qg_l = args.in[4] + (l) * 128; \
            for (int u = vcu; u < 1024; u += G) { \
                if (u < 512) { if (rep_ == 0 || (AREP & 1)) { const int kvh = u >> 8, b_ = (u & 255) >> 5, i_ = u & 31; att::attn_unit<0, 2>(b_, kvh * 4 + (i_ >> 3), i_ & 7, PROJ, QB, KVB, rpb_l, qg_l, tab, MIX, (char*)lds + RING_OFF); } } \
                else if (u < 768) { if (rep_ == 0 || (AREP & 2)) { const int ub = u - 512, b_ = ub >> 5, i_ = ub & 31; att::attn_unit<1, 1>(b_, i_ >> 3, i_ & 7, PROJ, QB, KVB, rpb_l, qg_l, tab, MIX, (char*)lds + RING_OFF); } } \
                else { if (rep_ == 0 || (AREP & 4)) { const int ub = u - 768, b_ = ub >> 5, i_ = ub & 31; att::attn_unit<2, 2>(b_, i_ >> 3, i_ & 7, PROJ, QB, KVB, rpb_l, qg_l, tab, MIX, (char*)lds + RING_OFF); } } \
            } \
        } } \
        SEAM(pb + 2); \
        if (IN(pb + 3)) { for (int rep_ = 0; rep_ < NREP(5); ++rep_) { \
            pg8::Gemm g{MIX, (const bf16_t*)(ws + WS_WOUT + (l) * WOUT_L)}; pg8::StaticOrder S; S.init(M, DM, G, bx); \
            pg8::EpiBf16 E{Y, DM}; \
            pg8::gemm_phase<DMIX, DMIX, DMIX, pg8::EpiBf16, pg8::StaticOrder, true, true>(L + RING_OFF, g, S, E); \
        } } \
        SEAM(pb + 3); \
        if (IN(pb + 4)) { FRESH_IDS(); bf16_t* X1B = (bf16_t*)(ws + WS_X1B); for (int m = gw_; m < M; m += NGW) rowpass_row<(l) == 0>(Y + (size_t)m * DM, args.in[0] + (size_t)m * DM, X1B + (size_t)m * DM, args.in[2] + (l) * DM, args.out + (size_t)m * DM, \
                X1B + (size_t)m * DM, args.in[1] + (((l) + 1) % DEPTH) * DM, XN + (size_t)m * DM, lane_); } \
        SEAM(pb + 4); \
    } while (0)
    LAYER(0);
    LAYER(1);
#undef LAYER
#undef IN
#undef SEAM
}

static int g_grid = 0;
static void launch_mk(Args a, int lo, int hi, int li, hipStream_t stream) {
    a.ph_lo = lo; a.ph_hi = hi; a.li = li;
    hipLaunchKernelGGL(mk_fwd, dim3(g_grid), dim3(NWAVES * 64), LDS_BYTES, stream, a);
}

extern "C" void kernel_launch(void* const* d_in, const int* in_sizes, int n_in, void* d_out, int out_size, void* d_ws, size_t ws_size, hipStream_t stream) {
  if (n_in != 12 || in_sizes[0] != M * DM || out_size != M * DM || ws_size < WS_END) {
    fprintf(stderr, "kernel_launch: unexpected shapes n_in %d in0 %d out %d ws %zu (need %zu)\n", n_in, n_in > 0 ? in_sizes[0] : -1, out_size, ws_size, (size_t)WS_END); return; }
  if (g_grid == 0) {
    int dev = 0, cus = 0, per_cu = 0;
    if (hipGetDevice(&dev) != hipSuccess || hipDeviceGetAttribute(&cus, hipDeviceAttributeMultiprocessorCount, dev) != hipSuccess) { fprintf(stderr, "kernel_launch: device query failed\n"); g_grid = -1; return; }
    if (hipFuncSetAttribute((const void*)mk_fwd, hipFuncAttributeMaxDynamicSharedMemorySize, LDS_BYTES) != hipSuccess) { fprintf(stderr, "kernel_launch: hipFuncSetAttribute failed\n"); g_grid = -1; return; }
    if (hipOccupancyMaxActiveBlocksPerMultiprocessor(&per_cu, (const void*)mk_fwd, NWAVES * 64, LDS_BYTES) != hipSuccess || per_cu < 1) { fprintf(stderr, "kernel_launch: occupancy query says %d blocks/CU\n", per_cu); g_grid = -1; (void)hipGetLastError(); return; }
    g_grid = cus;
  }
  if (g_grid < 0) return;
  const float* x = (const float*)d_in[0]; const float* norm_pre = (const float*)d_in[1]; const float* norm_post = (const float*)d_in[2];
  const float* w_in = (const float*)d_in[3]; const float* a_qn = (const float*)d_in[4]; const float* a_kn = (const float*)d_in[5];
  const float* b_qn = (const float*)d_in[6]; const float* b_kvn = (const float*)d_in[7]; const float* w_uq = (const float*)d_in[8];
  const float* w_ukv = (const float*)d_in[9]; const float* rpb = (const float*)d_in[10]; const float* w_out = (const float*)d_in[11];
  char* ws = (char*)d_ws; float* out = (float*)d_out;
  (void)hipMemsetAsync(ws + WS_CTL, 0, CTL_ZERO_BYTES, stream);
  Args a{}; for (int i = 0; i < 12; ++i) a.in[i] = (const float*)d_in[i]; a.out = out; a.ws = (unsigned char*)d_ws; a.amask = AMASK;
  launch_mk(a, 0, N_PHASES, 0, stream);
  (void)x; (void)norm_pre; (void)norm_post; (void)w_in; (void)a_qn; (void)a_kn; (void)b_qn; (void)b_kvn; (void)w_uq; (void)w_ukv; (void)rpb; (void)w_out;
}
```

```cpp
#include <hip/hip_runtime.h>
#include <cstdint>
#include <cstdio>

typedef unsigned short bf16_t;
typedef short bf16x8 __attribute__((ext_vector_type(8)));
typedef float f32x4 __attribute__((ext_vector_type(4)));
#define DEVI __device__ __forceinline__

constexpr int BATCH = 8, SEQ = 2048, DM = 2048, DEPTH = 2;
constexpr int M = BATCH * SEQ;
constexpr int DIN = 5952, NP = 6144;
constexpr int DMIX = 2048;
constexpr float EPS = 1e-6f;
constexpr int C_AQ = 0, C_AK = 1024, C_AV = 1280, C_AG = 1536, C_BCQ = 2560, C_BCKV = 3072, C_BKR = 3328, C_BG = 3584,
              C_CQ = 4096, C_CK = 4608, C_CV = 5120, C_CG = 5632;
constexpr size_t MiB = 1u << 20;
constexpr size_t WS_TAB = 1 * MiB;
constexpr size_t WS_WIN = 2 * MiB, WIN_L = 24 * MiB;
constexpr size_t WS_WOUT = 50 * MiB, WOUT_L = 8 * MiB;
constexpr size_t WS_WUQ = 66 * MiB, WUQ_L = 1 * MiB;
constexpr size_t WS_WUKV = 68 * MiB, WUKV_L = 1 * MiB;
constexpr size_t WS_XN = 70 * MiB;
constexpr size_t WS_PROJ = 134 * MiB;
constexpr size_t WS_Y = WS_PROJ;
constexpr size_t WS_QB = 326 * MiB;
constexpr size_t WS_KVB = 350 * MiB;
constexpr size_t WS_MIX = 382 * MiB;
constexpr size_t WS_X1B = 446 * MiB;
constexpr size_t WS_END = 510 * MiB;
constexpr int T_AR = 0, T_AC = 1024, T_BR = 3072, T_BC = 3584, T_N = 4608;

DEVI float bf2f(unsigned v) { return __uint_as_float(v << 16); }
DEVI unsigned f2bf(float f) { unsigned u = __float_as_uint(f); return (u + 0x7fffu + ((u >> 16) & 1u)) >> 16; }
DEVI unsigned pk2(float lo, float hi) { return f2bf(lo) | (f2bf(hi) << 16); }
DEVI float wave_sum(float v) {
#pragma unroll
  for (int o = 1; o < 64; o <<= 1) v += __shfl_xor(v, o);
  return v;
}
DEVI float wave_max(float v) {
#pragma unroll
  for (int o = 1; o < 64; o <<= 1) v = fmaxf(v, __shfl_xor(v, o));
  return v;
}

DEVI int perm128(int p) { const int a = p >> 6, j = (p & 63) >> 1, t = p & 1; return 64 * a + 32 * t + j; }
DEVI int perm64(int p) { const int a = p >> 5, j = (p & 31) >> 1, t = p & 1; return 32 * a + 16 * t + j; }
DEVI int map_col(int mode, int s) {
  if (mode == 0) return s;
  if (mode == 1) {
    if (s < 1280) return (s & ~127) + perm128(s & 127);
    if (s < 3328) return s;
    if (s < 3392) return 3328 + perm64(s - 3328);
    if (s < 3584) return -1;
    return s - 192;
  }
  if (s < 512) return (s >> 7) * 192 + (s & 127);
  const int h = (s - 512) >> 6, p = (s - 512) & 63;
  return h * 192 + 128 + perm64(p);
}

__global__ __launch_bounds__(256) void k_transpose_cvt(const float* __restrict__ src, bf16_t* __restrict__ dst, int K, int Ns, int mode) {
  __shared__ float tile[32][33];
  const int n0 = blockIdx.x * 32, k0 = blockIdx.y * 32, tx = threadIdx.x & 31, ty = threadIdx.x >> 5;
  const int so = map_col(mode, n0 + tx);
#pragma unroll
  for (int i = 0; i < 4; ++i) { const int kk = ty + 8 * i; tile[kk][tx] = so >= 0 ? src[(size_t)(k0 + kk) * Ns + so] : 0.f; }
  __syncthreads();
#pragma unroll
  for (int i = 0; i < 4; ++i) { const int nn = ty + 8 * i; dst[(size_t)(n0 + nn) * K + k0 + tx] = (bf16_t)f2bf(tile[tx][nn]); }
}

__global__ __launch_bounds__(256) void k_rope_tab(float2* tab) {
  const int i = blockIdx.x * 256 + threadIdx.x; if (i >= T_N) return;
  int pos, j; float n;
  if (i < T_AC) { pos = i >> 5; j = i & 31; n = 64.f; }
  else if (i < T_BR) { pos = (i - T_AC) >> 5; j = i & 31; n = 64.f; }
  else if (i < T_BC) { pos = (i - T_BR) >> 4; j = i & 15; n = 32.f; }
  else { pos = (i - T_BC) >> 4; j = i & 15; n = 32.f; }
  const float inv = 1.0f / powf(10000.f, (float)(2 * j) / n);
  const float ang = (float)pos * inv;
  const float k = rintf(ang * 0.15915494309189535f);
  float r = fmaf(-k, 6.28318548202514648f, ang); r = fmaf(-k, -1.74845553e-7f, r);
  tab[i] = make_float2(cosf(r), sinf(r));
}

__global__ __launch_bounds__(256) void k_rmsnorm_xn(const float* __restrict__ x, const float* __restrict__ g, bf16_t* __restrict__ xn) {
  const int row = blockIdx.x * 4 + (threadIdx.x >> 6), lane = threadIdx.x & 63;
  const float4* xr = (const float4*)(x + (size_t)row * DM) + lane;
  float4 v[8]; float ss = 0.f;
#pragma unroll
  for (int j = 0; j < 8; ++j) { v[j] = xr[64 * j]; ss += v[j].x * v[j].x + v[j].y * v[j].y + v[j].z * v[j].z + v[j].w * v[j].w; }
  const float rs = rsqrtf(wave_sum(ss) * (1.f / DM) + EPS);
  uint2* o = (uint2*)(xn + (size_t)row * DM) + lane;
#pragma unroll
  for (int j = 0; j < 8; ++j) { const float4 gg = ((const float4*)g)[lane + 64 * j];
    o[64 * j] = make_uint2(pk2(v[j].x * rs * gg.x, v[j].y * rs * gg.y), pk2(v[j].z * rs * gg.z, v[j].w * rs * gg.w)); }
}

template <bool OUT_F32>
__global__ __launch_bounds__(256) void k_gemm_naive(const bf16_t* __restrict__ A, int lda, const bf16_t* __restrict__ Bt, int ldb, void* __restrict__ C, int ldc, int K) {
  __shared__ __attribute__((aligned(16))) bf16_t sA[64 * 40];
  __shared__ __attribute__((aligned(16))) bf16_t sB[64 * 40];
  const int tid = threadIdx.x, lane = tid & 63, w = tid >> 6;
  const int m0 = blockIdx.y * 64, n0 = blockIdx.x * 64, lr = tid >> 2, lc = (tid & 3) * 8;
  f32x4 acc0 = {0, 0, 0, 0}, acc1 = acc0, acc2 = acc0, acc3 = acc0;
  for (int k0 = 0; k0 < K; k0 += 32) {
    const uint4 va = *(const uint4*)(A + (size_t)(m0 + lr) * lda + k0 + lc);
    const uint4 vb = *(const uint4*)(Bt + (size_t)(n0 + lr) * ldb + k0 + lc);
    __syncthreads();
    *(uint4*)(sA + lr * 40 + lc) = va; *(uint4*)(sB + lr * 40 + lc) = vb;
    __syncthreads();
    const bf16x8 a = *(const bf16x8*)(sA + (16 * w + (lane & 15)) * 40 + (lane >> 4) * 8);
    const bf16x8 b0 = *(const bf16x8*)(sB + (0 + (lane & 15)) * 40 + (lane >> 4) * 8);
    const bf16x8 b1 = *(const bf16x8*)(sB + (16 + (lane & 15)) * 40 + (lane >> 4) * 8);
    const bf16x8 b2 = *(const bf16x8*)(sB + (32 + (lane & 15)) * 40 + (lane >> 4) * 8);
    const bf16x8 b3 = *(const bf16x8*)(sB + (48 + (lane & 15)) * 40 + (lane >> 4) * 8);
    acc0 = __builtin_amdgcn_mfma_f32_16x16x32_bf16(a, b0, acc0, 0, 0, 0);
    acc1 = __builtin_amdgcn_mfma_f32_16x16x32_bf16(a, b1, acc1, 0, 0, 0);
    acc2 = __builtin_amdgcn_mfma_f32_16x16x32_bf16(a, b2, acc2, 0, 0, 0);
    acc3 = __builtin_amdgcn_mfma_f32_16x16x32_bf16(a, b3, acc3, 0, 0, 0);
  }
#pragma unroll
  for (int j = 0; j < 4; ++j) {
    const size_t row = m0 + 16 * w + (lane >> 4) * 4 + j; const int col = n0 + (lane & 15);
    if (OUT_F32) { float* c = (float*)C + row * ldc + col; c[0] = acc0[j]; c[16] = acc1[j]; c[32] = acc2[j]; c[48] = acc3[j]; }
    else { bf16_t* c = (bf16_t*)C + row * ldc + col; c[0] = (bf16_t)f2bf(acc0[j]); c[16] = (bf16_t)f2bf(acc1[j]); c[32] = (bf16_t)f2bf(acc2[j]); c[48] = (bf16_t)f2bf(acc3[j]); }
  }
}

__global__ __launch_bounds__(256) void k_postproj(bf16_t* __restrict__ PROJ, const float* __restrict__ a_qn, const float* __restrict__ a_kn,
                                                  const float* __restrict__ b_qn, const float* __restrict__ b_kvn, const float2* __restrict__ tab) {
  const int row = blockIdx.x * 4 + (threadIdx.x >> 6), lane = threadIdx.x & 63;
  const int t = row & (SEQ - 1), pr = t >> 6, pc = t & 63;
  bf16_t* p = PROJ + (size_t)row * NP;
  {
    const int a = lane >> 5, j = lane & 31;
    const float2 cs = a == 0 ? tab[T_AR + pr * 32 + j] : tab[T_AC + pc * 32 + j];
    const int d1 = 64 * a + j, d2 = d1 + 32;
    for (int hb = 0; hb < 10; ++hb) {
      unsigned* pp = (unsigned*)(p + hb * 128) + lane;
      const unsigned v = *pp; const float x1 = bf2f(v & 0xffffu), x2 = bf2f(v >> 16);
      const float rs = rsqrtf(wave_sum(x1 * x1 + x2 * x2) * (1.f / 128.f) + EPS);
      const float* g = hb < 8 ? a_qn : a_kn;
      const float y1 = x1 * rs * g[d1], y2 = x2 * rs * g[d2];
      *pp = pk2(y1 * cs.x - y2 * cs.y, y2 * cs.x + y1 * cs.y);
    }
  }
  {
    uint4* pp = (uint4*)(p + C_BCQ) + lane; const uint4 v = *pp; float x[8];
    x[0] = bf2f(v.x & 0xffffu); x[1] = bf2f(v.x >> 16); x[2] = bf2f(v.y & 0xffffu); x[3] = bf2f(v.y >> 16);
    x[4] = bf2f(v.z & 0xffffu); x[5] = bf2f(v.z >> 16); x[6] = bf2f(v.w & 0xffffu); x[7] = bf2f(v.w >> 16);
    float ss = 0.f;
#pragma unroll
    for (int i = 0; i < 8; ++i) ss += x[i] * x[i];
    const float rs = rsqrtf(wave_sum(ss) * (1.f / 512.f) + EPS);
    const float4 g0 = ((const float4*)b_qn)[2 * lane], g1 = ((const float4*)b_qn)[2 * lane + 1];
    *pp = make_uint4(pk2(x[0] * rs * g0.x, x[1] * rs * g0.y), pk2(x[2] * rs * g0.z, x[3] * rs * g0.w),
                     pk2(x[4] * rs * g1.x, x[5] * rs * g1.y), pk2(x[6] * rs * g1.z, x[7] * rs * g1.w));
  }
  {
    uint2* pp = (uint2*)(p + C_BCKV) + lane; const uint2 v = *pp;
    const float x0 = bf2f(v.x & 0xffffu), x1 = bf2f(v.x >> 16), x2 = bf2f(v.y & 0xffffu), x3 = bf2f(v.y >> 16);
    const float rs = rsqrtf(wave_sum(x0 * x0 + x1 * x1 + x2 * x2 + x3 * x3) * (1.f / 256.f) + EPS);
    const float4 g = ((const float4*)b_kvn)[lane];
    *pp = make_uint2(pk2(x0 * rs * g.x, x1 * rs * g.y), pk2(x2 * rs * g.z, x3 * rs * g.w));
  }
  if (lane < 32) {
    const int a = lane >> 4, j = lane & 15;
    const float2 cs = a == 0 ? tab[T_BR + pr * 16 + j] : tab[T_BC + pc * 16 + j];
    unsigned* pp = (unsigned*)(p + C_BKR) + lane; const unsigned v = *pp; const float x1 = bf2f(v & 0xffffu), x2 = bf2f(v >> 16);
    *pp = pk2(x1 * cs.x - x2 * cs.y, x2 * cs.x + x1 * cs.y);
  }
}

__global__ __launch_bounds__(256) void k_rope_qpe(bf16_t* __restrict__ QB, const float2* __restrict__ tab) {
  const int row = blockIdx.x * 4 + (threadIdx.x >> 6), lane = threadIdx.x & 63;
  const int t = row & (SEQ - 1), pr = t >> 6, pc = t & 63;
  unsigned* p = (unsigned*)(QB + (size_t)row * 768 + 512);
#pragma unroll
  for (int i = 0; i < 2; ++i) {
    const int pi = lane + 64 * i, a = (pi >> 4) & 1, j = pi & 15;
    const float2 cs = a == 0 ? tab[T_BR + pr * 16 + j] : tab[T_BC + pc * 16 + j];
    const unsigned v = p[pi]; const float x1 = bf2f(v & 0xffffu), x2 = bf2f(v >> 16);
    p[pi] = pk2(x1 * cs.x - x2 * cs.y, x2 * cs.x + x1 * cs.y);
  }
}

DEVI float dot8(const uint4 kv, const float* q) {
  return bf2f(kv.x & 0xffffu) * q[0] + bf2f(kv.x >> 16) * q[1] + bf2f(kv.y & 0xffffu) * q[2] + bf2f(kv.y >> 16) * q[3] +
         bf2f(kv.z & 0xffffu) * q[4] + bf2f(kv.z >> 16) * q[5] + bf2f(kv.w & 0xffffu) * q[6] + bf2f(kv.w >> 16) * q[7];
}
template <int TYPE>
__global__ __launch_bounds__(256) void k_attn_naive(const bf16_t* __restrict__ PROJ, const bf16_t* __restrict__ QB, const bf16_t* __restrict__ KVB,
                                                    const float* __restrict__ rpb, bf16_t* __restrict__ MIX) {
  __shared__ float qs[4][192];
  __shared__ float ps[4][2048];
  constexpr int NH = TYPE == 0 ? 8 : 4;
  const int w = threadIdx.x >> 6, lane = threadIdx.x & 63;
  const int item = blockIdx.x * 4 + w, h = item % NH, row = item / NH, b = row >> 11, t = row & 2047;
  const float scale = TYPE == 1 ? 0.07216878364870322f : 0.08838834764831845f;
  if (TYPE == 0) { for (int d = lane; d < 128; d += 64) qs[w][d] = bf2f(PROJ[(size_t)row * NP + C_AQ + h * 128 + d]); }
  else if (TYPE == 2) { for (int d = lane; d < 128; d += 64) qs[w][d] = bf2f(PROJ[(size_t)row * NP + C_CQ + h * 128 + d]); }
  else { for (int d = lane; d < 128; d += 64) qs[w][d] = bf2f(QB[(size_t)row * 768 + h * 128 + d]); qs[w][128 + lane] = bf2f(QB[(size_t)row * 768 + 512 + h * 64 + lane]); }
  __syncthreads();
  const int r = t >> 6, c = t & 63;
  const int r0 = min(max(r - 4, 0), 24), c0 = min(max(c - 8, 0), 48);
  constexpr int NK = TYPE == 2 ? 128 : 2048;
  float lmax = -3.0e38f;
  for (int i = 0; i < NK / 64; ++i) {
    const int n = lane + 64 * i; int j; float bias = 0.f;
    if (TYPE == 2) { const int kr = r0 + (n >> 4), kc = c0 + (n & 15); j = kr * 64 + kc; bias = rpb[(h * 15 + (kr - r + 7)) * 31 + (kc - c + 15)]; } else j = n;
    const size_t krow = (size_t)b * 2048 + j;
    const bf16_t* kp = TYPE == 0 ? PROJ + krow * NP + C_AK + (h >> 2) * 128 : TYPE == 2 ? PROJ + krow * NP + C_CK + h * 128 : KVB + krow * 1024 + h * 256;
    float acc = 0.f;
#pragma unroll
    for (int d = 0; d < 128; d += 8) acc += dot8(*(const uint4*)(kp + d), &qs[w][d]);
    if (TYPE == 1) { const bf16_t* kp2 = PROJ + krow * NP + C_BKR;
#pragma unroll
      for (int d = 0; d < 64; d += 8) acc += dot8(*(const uint4*)(kp2 + d), &qs[w][128 + d]); }
    const float s = acc * scale + bias;
    ps[w][n] = s; lmax = fmaxf(lmax, s);
  }
  const float mx = wave_max(lmax);
  float lsum = 0.f;
  for (int i = 0; i < NK / 64; ++i) { const int n = lane + 64 * i; const float p = __expf(ps[w][n] - mx); ps[w][n] = p; lsum += p; }
  const float l = wave_sum(lsum);
  __syncthreads();
  float o0 = 0.f, o1 = 0.f;
  for (int n = 0; n < NK; ++n) {
    int j; if (TYPE == 2) j = (r0 + (n >> 4)) * 64 + c0 + (n & 15); else j = n;
    const size_t krow = (size_t)b * 2048 + j;
    const bf16_t* vp = TYPE == 0 ? PROJ + krow * NP + C_AV + (h >> 2) * 128 : TYPE == 2 ? PROJ + krow * NP + C_CV + h * 128 : KVB + krow * 1024 + h * 256 + 128;
    const unsigned v = ((const unsigned*)vp)[lane]; const float p = ps[w][n];
    o0 += p * bf2f(v & 0xffffu); o1 += p * bf2f(v >> 16);
  }
  const int gcol = (TYPE == 0 ? C_AG : TYPE == 1 ? C_BG : C_CG) + h * 128, mcol = (TYPE == 0 ? 0 : TYPE == 1 ? 1024 : 1536) + h * 128;
  const unsigned gv = ((const unsigned*)(PROJ + (size_t)row * NP + gcol))[lane];
  const float g0 = bf2f(gv & 0xffffu), g1 = bf2f(gv >> 16), il = 1.f / l;
  ((unsigned*)(MIX + (size_t)row * DMIX + mcol))[lane] = pk2(o0 * il * (g0 / (1.f + __expf(-g0))), o1 * il * (g1 / (1.f + __expf(-g1))));
}

__global__ __launch_bounds__(256) void k_rowpass(const float* __restrict__ Y, const float* resid, const float* __restrict__ g_post, float* out,
                                                 const float* __restrict__ g_next, bf16_t* __restrict__ xn) {
  const int row = blockIdx.x * 4 + (threadIdx.x >> 6), lane = threadIdx.x & 63;
  const float4* yr = (const float4*)(Y + (size_t)row * DM) + lane; const float4* xr = (const float4*)(resid + (size_t)row * DM) + lane;
  float4 v[8]; float ss = 0.f;
#pragma unroll
  for (int j = 0; j < 8; ++j) { v[j] = yr[64 * j]; ss += v[j].x * v[j].x + v[j].y * v[j].y + v[j].z * v[j].z + v[j].w * v[j].w; }
  const float rs = rsqrtf(wave_sum(ss) * (1.f / DM) + EPS);
  float4* orow = (float4*)(out + (size_t)row * DM) + lane; float s2 = 0.f;
#pragma unroll
  for (int j = 0; j < 8; ++j) { const float4 gg = ((const float4*)g_post)[lane + 64 * j]; const float4 xx = xr[64 * j];
    v[j].x = xx.x + v[j].x * rs * gg.x; v[j].y = xx.y + v[j].y * rs * gg.y; v[j].z = xx.z + v[j].z * rs * gg.z; v[j].w = xx.w + v[j].w * rs * gg.w;
    orow[64 * j] = v[j]; s2 += v[j].x * v[j].x + v[j].y * v[j].y + v[j].z * v[j].z + v[j].w * v[j].w; }
  if (g_next) {
    const float r2 = rsqrtf(wave_sum(s2) * (1.f / DM) + EPS);
    uint2* o = (uint2*)(xn + (size_t)row * DM) + lane;
#pragma unroll
    for (int j = 0; j < 8; ++j) { const float4 gg = ((const float4*)g_next)[lane + 64 * j];
      o[64 * j] = make_uint2(pk2(v[j].x * r2 * gg.x, v[j].y * r2 * gg.y), pk2(v[j].z * r2 * gg.z, v[j].w * r2 * gg.w)); }
  }
}

namespace pg8 {
#define PG8_LAS __attribute__((address_space(3)))
typedef unsigned u32x4 __attribute__((ext_vector_type(4)));
constexpr int BM = 256, BK = 64, HALF = 128, HTB = HALF * BK * 2, STAGE_BYTES = 8 * HTB, NXCD = 8, WGM = 8;
__host__ __device__ __forceinline__ int lds_byte(int r, int c) { const int st = (r >> 4) * 2 + (c >> 5), rr = r & 15, cc = c & 31, ob = rr * 64 + cc * 2; return st * 1024 + (ob ^ (((ob >> 9) & 1) << 5)); }
__host__ __device__ __forceinline__ void stage_rc(int b, int& R, int& C) { const int st = b / 1024, sb = b % 1024, swz = sb ^ (((sb >> 9) & 1) << 5); R = (st >> 1) * 16 + swz / 64; C = (st & 1) * 32 + (swz % 64) / 2; }
__host__ __device__ __forceinline__ int perm32(int rho) { const int n = rho >> 4, i = rho & 15; return 8 * (i >> 2) + 4 * n + (i & 3); }
struct Unit { int pm, pn, slot; };
struct Gemm { const bf16_t* A; const bf16_t* Bt; };
struct StaticOrder {
    int nM, nN, nwg, G, c;
    __host__ __device__ void init(int M, int N, int G_, int c_) { nM = M / BM; nN = N / BM; nwg = nM * nN; G = G_; c = c_; }
    __host__ __device__ bool next(int i, Unit& u) const {
        const long L = (long)i * G + c; if (L >= nwg) return false;
        int wgid = (int)L; { const int q = nwg / NXCD, r = nwg % NXCD, xcd = wgid % NXCD, off = wgid / NXCD; wgid = (xcd < r ? xcd * (q + 1) : r * (q + 1) + (xcd - r) * q) + off; }
        const int nig = WGM * nN, gid = wgid / nig, fm = gid * WGM, gsz = (nM - fm) < WGM ? (nM - fm) : WGM;
        u.pm = fm + ((wgid % nig) % gsz); u.pn = (wgid % nig) / gsz; u.slot = i & 1; return true;
    }
    __device__ __forceinline__ void a_ready(const Unit&) const {}
    __device__ __forceinline__ void done(const Unit&) const {}
};
__device__ __forceinline__ unsigned cvt_pk_bf16(float lo, float hi) { unsigned r; asm volatile("v_cvt_pk_bf16_f32 %0, %1, %2" : "=v"(r) : "v"(lo), "v"(hi)); return r; }
struct EpiF32 {
    static constexpr bool PERM = false, AFTER_DRAIN = false;
    float* C; int ldc;
    __device__ __forceinline__ void operator()(const f32x4 (&acc)[2][2][4][2], const Unit& u, int wr, int wc, int fr, int fq) const {
        const int row0 = u.pm * BM + wr * 64 + fr, col0 = u.pn * BM + wc * 32 + 4 * fq;
#pragma unroll
        for (int ai = 0; ai < 2; ++ai)
#pragma unroll
            for (int m = 0; m < 4; ++m) { float* rowp = C + (size_t)(row0 + ai * HALF + m * 16) * ldc + col0;
#pragma unroll
                for (int bj = 0; bj < 2; ++bj)
#pragma unroll
                    for (int n = 0; n < 2; ++n) *(f32x4*)(rowp + bj * HALF + n * 16) = acc[ai][bj][m][n]; }
    }
};
struct EpiNone {
    static constexpr bool PERM = true, AFTER_DRAIN = false;
    __device__ __forceinline__ void operator()(const f32x4 (&acc)[2][2][4][2], const Unit&, int, int, int, int) const {
#pragma unroll
        for (int ai = 0; ai < 2; ++ai)
#pragma unroll
            for (int bj = 0; bj < 2; ++bj)
#pragma unroll
                for (int m = 0; m < 4; ++m)
#pragma unroll
                    for (int n = 0; n < 2; ++n) asm volatile("" :: "v"(acc[ai][bj][m][n]));
    }
};
struct EpiBf16 {
    static constexpr bool PERM = true, AFTER_DRAIN = false;
    bf16_t* O; int ldc;
    __device__ __forceinline__ void operator()(const f32x4 (&acc)[2][2][4][2], const Unit& u, int wr, int wc, int fr, int fq) const {
        const int row0 = u.pm * BM + wr * 64 + fr, col0 = u.pn * BM + wc * 32 + 8 * fq;
#pragma unroll
        for (int ai = 0; ai < 2; ++ai)
#pragma unroll
            for (int m = 0; m < 4; ++m) { bf16_t* rowp = O + (size_t)(row0 + ai * HALF + m * 16) * ldc + col0;
#pragma unroll
                for (int bj = 0; bj < 2; ++bj) { const f32x4 v0 = acc[ai][bj][m][0], v1 = acc[ai][bj][m][1];
                    u32x4 w; w.x = cvt_pk_bf16(v0[0], v0[1]); w.y = cvt_pk_bf16(v0[2], v0[3]); w.z = cvt_pk_bf16(v1[0], v1[1]); w.w = cvt_pk_bf16(v1[2], v1[3]);
                    *(u32x4*)(rowp + bj * HALF) = w; } }
    }
};

template <int KW, int LDA> struct RsOrder : StaticOrder {
    const bf16_t* A; PG8_LAS float* tab;
    __device__ __forceinline__ void a_ready(const Unit& u) const {
        int l_ = threadIdx.x; asm volatile("" : "+v"(l_));
        const int lane = l_ & 63, wid = l_ >> 6, rr = lane >> 4, c = lane & 15;
        constexpr int NV = KW / 16 / 8;
        const bf16_t* base = A + (size_t)(u.pm * BM + wid * 32 + rr) * LDA + c * (KW / 16);
#pragma unroll 2
        for (int i = 0; i < 8; ++i) {
            float ss = 0.f;
#pragma unroll
            for (int v = 0; v < NV; ++v) { const u32x4 x = *(const u32x4*)(base + (size_t)(4 * i) * LDA + v * 8);
#pragma unroll
                for (int e = 0; e < 4; ++e) { const float a = __uint_as_float(x[e] << 16), b = __uint_as_float(x[e] & 0xffff0000u); ss += a * a + b * b; } }
            ss += __shfl_xor(ss, 1); ss += __shfl_xor(ss, 2); ss += __shfl_xor(ss, 4); ss += __shfl_xor(ss, 8);
            if (c == 0) tab[u.slot * 256 + wid * 32 + 4 * i + rr] = rsqrtf(ss * (1.f / KW) + 1e-6f);
        }
    }
};
template <int ROPE_PN> struct EpiBf16Rs {
    static constexpr bool PERM = true, AFTER_DRAIN = false;
    bf16_t* O; int ldc; const PG8_LAS float* rst; const float2* tab_r; const float2* tab_c;
    __device__ __forceinline__ void operator()(const f32x4 (&acc)[2][2][4][2], const Unit& u, int wr, int wc, int fr, int fq) const {
        const int row0 = u.pm * BM + wr * 64 + fr, col0 = u.pn * BM + wc * 32 + 8 * fq;
        const bool rope = (ROPE_PN >= 0) && (u.pn == ROPE_PN);
#pragma unroll
        for (int ai = 0; ai < 2; ++ai)
#pragma unroll
            for (int m = 0; m < 4; ++m) { const int row = row0 + ai * HALF + m * 16; bf16_t* rowp = O + (size_t)row * ldc + col0;
                const float rs = rst[u.slot * 256 + ai * HALF + wr * 64 + m * 16 + fr];
                f32x4 c01 = {1.f, 0.f, 1.f, 0.f}, c23 = c01;
                if (rope) { const int t = row & 2047; const float2* tp = (wc & 1) ? tab_c + (t & 63) * 16 + 4 * fq : tab_r + (t >> 6) * 16 + 4 * fq;
                    c01 = *(const f32x4*)tp; c23 = *(const f32x4*)(tp + 2); }
#pragma unroll
                for (int bj = 0; bj < 2; ++bj) { f32x4 v0 = acc[ai][bj][m][0] * rs, v1 = acc[ai][bj][m][1] * rs;
                    if (rope) { const f32x4 a0 = v0, a1 = v1;
                        v0[0] = a0[0] * c01[0] - a0[1] * c01[1]; v0[1] = a0[1] * c01[0] + a0[0] * c01[1]; v0[2] = a0[2] * c01[2] - a0[3] * c01[3]; v0[3] = a0[3] * c01[2] + a0[2] * c01[3];
                        v1[0] = a1[0] * c23[0] - a1[1] * c23[1]; v1[1] = a1[1] * c23[0] + a1[0] * c23[1]; v1[2] = a1[2] * c23[2] - a1[3] * c23[3]; v1[3] = a1[3] * c23[2] + a1[2] * c23[3]; }
                    u32x4 w; w.x = cvt_pk_bf16(v0[0], v0[1]); w.y = cvt_pk_bf16(v0[2], v0[3]); w.z = cvt_pk_bf16(v1[0], v1[1]); w.w = cvt_pk_bf16(v1[2], v1[3]);
                    *(u32x4*)(rowp + bj * HALF) = w; } }
    }
};

template <int K, int LDA, int LDB, class Epi, class Sched, bool ALIGN_EPI = false, bool SP2 = false>
__device__ __forceinline__ void gemm_phase(PG8_LAS unsigned char* lds, const Gemm g, const Sched& S, const Epi& E) {
    int tid_ = threadIdx.x; asm volatile("" : "+v"(tid_));
    const int tid = tid_, wid = __builtin_amdgcn_readfirstlane(tid >> 6), lane = tid & 63, wr = wid >> 2, wc = wid & 3, fr = lane & 15, fq = lane >> 4;
    constexpr int nt = K / BK;
    unsigned voffA[2], voffB[2];
#pragma unroll
    for (int i = 0; i < 2; ++i) { int R, C; stage_rc(tid * 16 + i * 8192, R, C); const int Rb = Epi::PERM ? ((R & ~31) + perm32(R & 31)) : R;
        voffA[i] = (unsigned)(R * LDA + C) * 2u; voffB[i] = (unsigned)(Rb * LDB + C) * 2u; }
    constexpr size_t kstep = (size_t)(BK * 2);
    constexpr size_t hsA = (size_t)HALF * LDA * 2, hsB = (size_t)HALF * LDB * 2;
    constexpr size_t tsA = 2 * hsA, tsB = 2 * hsB;
    const unsigned ldsw = (unsigned)wid * 1024u;
    const int aoff = lds_byte(wr * 64 + fr, fq * 8), boff = lds_byte(wc * 32 + fr, fq * 8);
#define PG8_SA(b, h) (((b) * 2 + (h)) * HTB)
#define PG8_SB(b, h) ((4 + (b) * 2 + (h)) * HTB)
#define PG8_STAGE(bufoff, gbase, voff) do { _Pragma("unroll") for (int _i = 0; _i < 2; ++_i) \
        __builtin_amdgcn_global_load_lds((const unsigned*)((const char*)(gbase) + (voff)[_i]), (PG8_LAS unsigned*)(lds + (bufoff) + ldsw + _i * 8192), 16, 0, 0); } while (0)
#define PG8_LDA(dst, b, h) do { _Pragma("unroll") for (int m = 0; m < 4; ++m) _Pragma("unroll") for (int k = 0; k < 2; ++k) dst[m][k] = *(const PG8_LAS bf16x8*)(lds + PG8_SA(b, h) + aoff + m * 2048 + k * 1024); } while (0)
#define PG8_LDB(dst, b, h) do { _Pragma("unroll") for (int n = 0; n < 2; ++n) _Pragma("unroll") for (int k = 0; k < 2; ++k) dst[n][k] = *(const PG8_LAS bf16x8*)(lds + PG8_SB(b, h) + boff + n * 2048 + k * 1024); } while (0)
#define PG8_MMA(ai, bj, At, Bt) do { __builtin_amdgcn_s_setprio(1); _Pragma("unroll") for (int m = 0; m < 4; ++m) _Pragma("unroll") for (int n = 0; n < 2; ++n) _Pragma("unroll") for (int k = 0; k < 2; ++k) \
        acc[ai][bj][m][n] = __builtin_amdgcn_mfma_f32_16x16x32_bf16(Bt[n][k], At[m][k], acc[ai][bj][m][n], 0, 0, 0); __builtin_amdgcn_s_setprio(0); } while (0)
#define PG8_WAIT_V(n) asm volatile("s_waitcnt vmcnt(" #n ")" ::: "memory")
#define PG8_WAIT_L(n) asm volatile("s_waitcnt lgkmcnt(" #n ")" ::: "memory")
#define PG8_BAR __builtin_amdgcn_s_barrier()
#define PG8_SCHED __builtin_amdgcn_sched_barrier(0)
    Unit cur, nxt; int ui = 0;
    if (!S.next(0, cur)) return;
    f32x4 acc[2][2][4][2];
#pragma unroll
    for (int a = 0; a < 2; ++a)
#pragma unroll
        for (int b = 0; b < 2; ++b)
#pragma unroll
            for (int m = 0; m < 4; ++m)
#pragma unroll
                for (int n = 0; n < 2; ++n) acc[a][b][m][n] = (f32x4){0.f, 0.f, 0.f, 0.f};
    bf16x8 At[4][2], B0[2][2], B1[2][2];
    const char* cA = (const char*)g.A + (size_t)cur.pm * tsA; const char* cB = (const char*)g.Bt + (size_t)cur.pn * tsB;
    S.a_ready(cur);
    if constexpr (SP2) {
        PG8_STAGE(PG8_SB(0, 0), cB, voffB); PG8_STAGE(PG8_SB(0, 1), cB + hsB, voffB); PG8_STAGE(PG8_SA(0, 0), cA, voffA); PG8_STAGE(PG8_SA(0, 1), cA + hsA, voffA);
        if (wr == 1) PG8_BAR;
        PG8_WAIT_V(2); PG8_BAR;
        PG8_STAGE(PG8_SB(1, 0), cB + kstep, voffB); PG8_STAGE(PG8_SA(1, 0), cA + kstep, voffA); PG8_STAGE(PG8_SB(1, 1), cB + hsB + kstep, voffB);
        PG8_WAIT_V(6); PG8_BAR;
    } else {
        PG8_STAGE(PG8_SB(0, 0), cB, voffB); PG8_STAGE(PG8_SA(0, 0), cA, voffA); PG8_STAGE(PG8_SB(0, 1), cB + hsB, voffB); PG8_STAGE(PG8_SA(0, 1), cA + hsA, voffA);
        if (wr == 1) PG8_BAR;
        PG8_WAIT_V(4); PG8_BAR;
        PG8_STAGE(PG8_SB(1, 0), cB + kstep, voffB); PG8_STAGE(PG8_SA(1, 0), cA + kstep, voffA); PG8_STAGE(PG8_SB(1, 1), cB + hsB + kstep, voffB);
        PG8_WAIT_V(6); PG8_BAR;
    }
    for (;;) {
        const bool has_next = S.next(ui + 1, nxt);
        const char* nA = has_next ? (const char*)g.A + (size_t)nxt.pm * tsA : cA; const char* nB = has_next ? (const char*)g.Bt + (size_t)nxt.pn * tsB : cB;
#pragma unroll 1
        for (int t = 0; t < nt; t += 2) {
            const bool last = (t == nt - 2);
            const char* a1 = cA + (size_t)(t + 1) * kstep;
            const char* a2 = last ? nA : cA + (size_t)(t + 2) * kstep; const char* b2 = last ? nB : cB + (size_t)(t + 2) * kstep;
            const char* a3 = a2 + kstep; const char* b3 = b2 + kstep;
            if (last && has_next) S.a_ready(nxt);
            if constexpr (SP2) {
            PG8_LDB(B0, 0, 0); PG8_LDB(B1, 0, 1); PG8_SCHED; PG8_LDA(At, 0, 0); PG8_STAGE(PG8_SA(1, 1), a1 + hsA, voffA);
            PG8_WAIT_V(8); PG8_WAIT_L(0); PG8_BAR; PG8_MMA(0, 0, At, B0); PG8_MMA(0, 1, At, B1); PG8_BAR; PG8_SCHED;
            PG8_LDA(At, 0, 1); PG8_STAGE(PG8_SB(0, 0), b2, voffB); PG8_STAGE(PG8_SB(0, 1), b2 + hsB, voffB); PG8_STAGE(PG8_SA(0, 0), a2, voffA);
            PG8_WAIT_V(8); PG8_WAIT_L(0); PG8_BAR; PG8_MMA(1, 0, At, B0); PG8_MMA(1, 1, At, B1); PG8_BAR; PG8_SCHED;
            PG8_LDB(B0, 1, 0); PG8_LDB(B1, 1, 1); PG8_SCHED; PG8_LDA(At, 1, 0); PG8_STAGE(PG8_SA(0, 1), a2 + hsA, voffA);
            PG8_WAIT_V(8); PG8_WAIT_L(0); PG8_BAR; PG8_MMA(0, 0, At, B0); PG8_MMA(0, 1, At, B1); PG8_BAR; PG8_SCHED;
            PG8_LDA(At, 1, 1); PG8_STAGE(PG8_SB(1, 0), b3, voffB); PG8_STAGE(PG8_SB(1, 1), b3 + hsB, voffB); PG8_STAGE(PG8_SA(1, 0), a3, voffA);
            PG8_WAIT_V(8); PG8_WAIT_L(0); PG8_BAR; PG8_MMA(1, 0, At, B0); PG8_MMA(1, 1, At, B1); PG8_BAR; PG8_SCHED;
            } else {
            PG8_LDB(B0, 0, 0); PG8_SCHED; PG8_LDA(At, 0, 0); PG8_STAGE(PG8_SA(1, 1), a1 + hsA, voffA);
            PG8_WAIT_L(8); PG8_BAR; PG8_WAIT_L(0); PG8_MMA(0, 0, At, B0); PG8_BAR; PG8_SCHED;
            PG8_LDB(B1, 0, 1); PG8_STAGE(PG8_SB(0, 0), b2, voffB);
            PG8_BAR; PG8_WAIT_L(0); PG8_MMA(0, 1, At, B1); PG8_BAR;
            PG8_LDA(At, 0, 1); PG8_STAGE(PG8_SA(0, 0), a2, voffA);
            PG8_BAR; PG8_WAIT_L(0); PG8_MMA(1, 0, At, B0); PG8_BAR; PG8_SCHED;
            PG8_STAGE(PG8_SB(0, 1), b2 + hsB, voffB);
            PG8_WAIT_V(6); PG8_BAR; PG8_MMA(1, 1, At, B1); PG8_BAR;
            PG8_LDB(B0, 1, 0); PG8_SCHED; PG8_LDA(At, 1, 0); PG8_STAGE(PG8_SA(0, 1), a2 + hsA, voffA);
            PG8_WAIT_L(8); PG8_BAR; PG8_WAIT_L(0); PG8_MMA(0, 0, At, B0); PG8_BAR; PG8_SCHED;
            PG8_LDB(B1, 1, 1); PG8_STAGE(PG8_SB(1, 0), b3, voffB);
            PG8_BAR; PG8_WAIT_L(0); PG8_MMA(0, 1, At, B1); PG8_BAR;
            PG8_LDA(At, 1, 1); PG8_STAGE(PG8_SA(1, 0), a3, voffA);
            PG8_BAR; PG8_WAIT_L(0); PG8_MMA(1, 0, At, B0); PG8_BAR; PG8_SCHED;
            PG8_STAGE(PG8_SB(1, 1), b3 + hsB, voffB);
            PG8_WAIT_V(6); PG8_BAR; PG8_MMA(1, 1, At, B1); PG8_BAR;
            }
        }
        if constexpr (ALIGN_EPI) { if (wr == 0) PG8_BAR; }
        if constexpr (!Epi::AFTER_DRAIN) { E(acc, cur, wr, wc, fr, fq); S.done(cur); }
        if (!has_next) break;
#pragma unroll
        for (int a = 0; a < 2; ++a)
#pragma unroll
            for (int b = 0; b < 2; ++b)
#pragma unroll
                for (int m = 0; m < 4; ++m)
#pragma unroll
                    for (int n = 0; n < 2; ++n) acc[a][b][m][n] = (f32x4){0.f, 0.f, 0.f, 0.f};
        cur = nxt; cA = nA; cB = nB; ++ui;
        if constexpr (ALIGN_EPI) { if (wr == 1) PG8_BAR; }
    }
    PG8_WAIT_V(0);
    if constexpr (!ALIGN_EPI) { if (wr == 0) PG8_BAR; }
    PG8_BAR;
    if constexpr (Epi::AFTER_DRAIN) { E.fused(acc, cur, wr, wc, fr, fq, lds, wid, lane); S.done(cur); }
#undef PG8_SA
#undef PG8_SB
#undef PG8_STAGE
#undef PG8_LDA
#undef PG8_LDB
#undef PG8_MMA
#undef PG8_WAIT_V
#undef PG8_WAIT_L
#undef PG8_BAR
#undef PG8_SCHED
}
}
namespace att {
using f32x16 = __attribute__((ext_vector_type(16))) float;
using s16x4  = __attribute__((ext_vector_type(4))) short;
using u32x4  = __attribute__((ext_vector_type(4))) unsigned;
constexpr int NW = 8, QBLK = 32, KVBLK = 64;
constexpr int SHM_V = 16384, SHM_K = 16384, SHM_P = 8192;
constexpr int OFF_V = 0, OFF_K = 2 * SHM_V, OFF_P = OFF_K + 2 * SHM_K, OFF_WS = OFF_P + 2 * SHM_P, OFF_BIAS = OFF_WS + NW * 64 * 4, OFF_QPE = OFF_BIAS + 2048, LDS_ATT = OFF_QPE + NW * 4096;
constexpr float THR = 8.f;
#define KSWZ(row, colB) ((row) * 256 + ((colB) ^ (((row) & 7) << 4)))
#define PSWZ(row, colB) ((row) * 128 + ((colB) ^ ((((row) >> 1) & 7) << 4)))
#define SBAR() __builtin_amdgcn_sched_barrier(0)
DEVI int crow(int r, int hi) { return (r & 3) + 8 * (r >> 2) + 4 * hi; }
DEVI unsigned cvtpk(float lo, float hi) { unsigned r; asm volatile("v_cvt_pk_bf16_f32 %0, %1, %2" : "=v"(r) : "v"(lo), "v"(hi)); return r; }

template <int TYPE> DEVI void partialSM(f32x16& p0, f32x16& p1, float& m_reg, float& mn, float& alpha) {
  constexpr float SCALE = TYPE == 1 ? 0.07216878364870322f : 0.08838834764831845f;
  constexpr float C = SCALE * 1.4426950408889634f;
  float pmax = p0[0];
#pragma unroll
  for (int r = 1; r < 16; ++r) pmax = fmaxf(pmax, p0[r]);
#pragma unroll
  for (int r = 0; r < 16; ++r) pmax = fmaxf(pmax, p1[r]);
  { auto rr = __builtin_amdgcn_permlane32_swap(__float_as_uint(pmax), __float_as_uint(pmax), false, false);
    pmax = fmaxf(__uint_as_float(rr[0]), __uint_as_float(rr[1])); }
  if (__builtin_expect(__all(pmax - m_reg <= THR / SCALE), 1)) { mn = m_reg; alpha = 1.f; }
  else { mn = fmaxf(m_reg, pmax); alpha = __builtin_amdgcn_exp2f((m_reg - mn) * C); m_reg = mn; }
  const float mnC = -mn * C;
#pragma unroll
  for (int r = 0; r < 16; ++r) p0[r] = fmaf(p0[r], C, mnC);
#pragma unroll
  for (int r = 0; r < 16; ++r) p1[r] = fmaf(p1[r], C, mnC);
#pragma unroll
  for (int r = 0; r < 16; ++r) p0[r] = __builtin_amdgcn_exp2f(p0[r]);
}
DEVI void finishSM(f32x16& p0, f32x16& p1, float alpha, float& l_reg, bf16x8& pa0, bf16x8& pa1, bf16x8& pa2, bf16x8& pa3) {
#pragma unroll
  for (int r = 0; r < 16; ++r) p1[r] = __builtin_amdgcn_exp2f(p1[r]);
  float ps = 0;
#pragma unroll
  for (int r = 0; r < 16; ++r) ps += p0[r];
#pragma unroll
  for (int r = 0; r < 16; ++r) ps += p1[r];
  { auto rr = __builtin_amdgcn_permlane32_swap(__float_as_uint(ps), __float_as_uint(ps), false, false);
    ps = __uint_as_float(rr[0]) + __uint_as_float(rr[1]); }
  l_reg = l_reg * alpha + ps;
#define PK4(P, BASE, OUT) do { unsigned a0 = cvtpk(P[BASE + 0], P[BASE + 1]), a1 = cvtpk(P[BASE + 2], P[BASE + 3]);   \
    unsigned b0 = cvtpk(P[BASE + 4], P[BASE + 5]), b1 = cvtpk(P[BASE + 6], P[BASE + 7]);                              \
    auto r0 = __builtin_amdgcn_permlane32_swap(a0, b0, false, false); auto r1 = __builtin_amdgcn_permlane32_swap(a1, b1, false, false); \
    u32x4 w = {r0[0], r1[0], r0[1], r1[1]}; OUT = *reinterpret_cast<bf16x8*>(&w); } while (0)
  PK4(p0, 0, pa0); PK4(p0, 8, pa1); PK4(p1, 0, pa2); PK4(p1, 8, pa3);
#undef PK4
}
template <int TYPE> DEVI void qkt(f32x16& p0, f32x16& p1, const char* Ks, const char* Ps, const bf16x8* qr, const char* Qe, int r32, int hi) {
  p0 = f32x16{}; p1 = f32x16{};
#pragma unroll
  for (int d0 = 0; d0 < 8; ++d0) { const int cb = (d0 * 16 + hi * 8) * 2;
    const bf16x8 b0 = *reinterpret_cast<const bf16x8*>(Ks + KSWZ(r32, cb));
    const bf16x8 b1 = *reinterpret_cast<const bf16x8*>(Ks + KSWZ(32 + r32, cb));
    p0 = __builtin_amdgcn_mfma_f32_32x32x16_bf16(b0, qr[d0], p0, 0, 0, 0);
    p1 = __builtin_amdgcn_mfma_f32_32x32x16_bf16(b1, qr[d0], p1, 0, 0, 0); }
  if constexpr (TYPE == 1) {
#pragma unroll
    for (int d0 = 0; d0 < 4; ++d0) { const int cb = (d0 * 16 + hi * 8) * 2;
      const bf16x8 b0 = *reinterpret_cast<const bf16x8*>(Ps + PSWZ(r32, cb));
      const bf16x8 b1 = *reinterpret_cast<const bf16x8*>(Ps + PSWZ(32 + r32, cb));
      const bf16x8 qe = *reinterpret_cast<const bf16x8*>(Qe + PSWZ(r32, cb));
      p0 = __builtin_amdgcn_mfma_f32_32x32x16_bf16(b0, qe, p0, 0, 0, 0);
      p1 = __builtin_amdgcn_mfma_f32_32x32x16_bf16(b1, qe, p1, 0, 0, 0); }
  }
}
DEVI int v_st(int k, int c) { const int kk = (k & ~0xC) | ((k & 4) << 1) | ((k & 8) >> 1); return ((kk >> 3) * 4 + (c >> 5)) * 512 + ((kk & 7) * 32 + (c & 31)) * 2; }
DEVI int v_rd_base(int lane) { return ((lane & 3) << 3) | (((lane >> 2) & 3) << 6) | (((lane >> 4) & 1) << 5) | (((lane >> 5) & 1) << 8); }
constexpr int v_rd_off(int d0, int ks, int half) { return d0 * 512 + ks * 4096 + half * 2048; }
template <int OFF> DEVI s16x4 tr_read(int vb) { s16x4 r; asm volatile("ds_read_b64_tr_b16 %0, %1 offset:%2" : "=&v"(r) : "v"(vb), "i"(OFF) : "memory"); return r; }
template <int D0> DEVI void pv_one(f32x16& od, int vb, bf16x8 pa0, bf16x8 pa1, bf16x8 pa2, bf16x8 pa3) {
  const s16x4 l0 = tr_read<v_rd_off(D0, 0, 0)>(vb), h0 = tr_read<v_rd_off(D0, 0, 1)>(vb), l1 = tr_read<v_rd_off(D0, 1, 0)>(vb), h1 = tr_read<v_rd_off(D0, 1, 1)>(vb);
  const s16x4 l2 = tr_read<v_rd_off(D0, 2, 0)>(vb), h2 = tr_read<v_rd_off(D0, 2, 1)>(vb), l3 = tr_read<v_rd_off(D0, 3, 0)>(vb), h3 = tr_read<v_rd_off(D0, 3, 1)>(vb);
  asm volatile("s_waitcnt lgkmcnt(0)" ::: "memory"); SBAR();
#define PK(L, H) (bf16x8){L[0], L[1], L[2], L[3], H[0], H[1], H[2], H[3]}
  od = __builtin_amdgcn_mfma_f32_32x32x16_bf16(pa0, PK(l0, h0), od, 0, 0, 0);
  od = __builtin_amdgcn_mfma_f32_32x32x16_bf16(pa1, PK(l1, h1), od, 0, 0, 0);
  od = __builtin_amdgcn_mfma_f32_32x32x16_bf16(pa2, PK(l2, h2), od, 0, 0, 0);
  od = __builtin_amdgcn_mfma_f32_32x32x16_bf16(pa3, PK(l3, h3), od, 0, 0, 0);
#undef PK
}
DEVI void pv_d0(f32x16* o, int vb, bf16x8 pa0, bf16x8 pa1, bf16x8 pa2, bf16x8 pa3) {
  pv_one<0>(o[0], vb, pa0, pa1, pa2, pa3); pv_one<1>(o[1], vb, pa0, pa1, pa2, pa3); pv_one<2>(o[2], vb, pa0, pa1, pa2, pa3); pv_one<3>(o[3], vb, pa0, pa1, pa2, pa3);
}
DEVI void nb_mask(f32x16& p0, f32x16& p1, int kr, int r, int r0, int c, int c0, int hi, const float* bt) {
  const bool active = (unsigned)(kr - r0) < 8u;
  if (!active) {
#pragma unroll
    for (int i = 0; i < 16; ++i) { p0[i] = -1e30f; p1[i] = -1e30f; }
  } else {
    const float* bp = bt + (kr - r + 7) * 31 + 15 - c + 4 * hi;
    const int dk = 4 * hi - c0;
#pragma unroll
    for (int i = 0; i < 16; ++i) { const int kc = (i & 3) + 8 * (i >> 2);
      p0[i] = ((unsigned)(kc + dk) < 16u) ? p0[i] + bp[kc] : -1e30f;
      p1[i] = ((unsigned)(kc + 32 + dk) < 16u) ? p1[i] + bp[kc + 32] : -1e30f; }
  }
}

template <int TYPE, int SDEPTH>
DEVI void attn_unit(int b, int h, int qb, const bf16_t* __restrict__ PROJ, const bf16_t* __restrict__ QB, const bf16_t* __restrict__ KVB,
                    const float* __restrict__ rpb, const float* __restrict__ qgain, const float2* __restrict__ tab, bf16_t* __restrict__ MIX, char* lds) {
  constexpr float SCALE = TYPE == 1 ? 0.07216878364870322f : 0.08838834764831845f;
  constexpr int NQ = 8;
  constexpr int LDQ = TYPE == 1 ? 768 : NP, LDK = TYPE == 1 ? 1024 : NP;
  int tid_ = threadIdx.x; asm volatile("" : "+v"(tid_));
  const int tid = tid_, wid = tid >> 6, lane = tid & 63, r32 = lane & 31, hi = lane >> 5;
  const size_t row0 = (size_t)b * SEQ + qb * 256, kb0 = (size_t)b * SEQ;
  const bf16_t* Qp = TYPE == 0 ? PROJ + row0 * NP + C_AQ + h * 128 : TYPE == 2 ? PROJ + row0 * NP + C_CQ + h * 128 : QB + row0 * 768 + h * 128;
  const bf16_t* Kh = TYPE == 0 ? PROJ + kb0 * NP + C_AK + (h >> 2) * 128 : TYPE == 2 ? PROJ + kb0 * NP + C_CK + h * 128 : KVB + kb0 * 1024 + h * 256;
  const bf16_t* Vh = TYPE == 0 ? PROJ + kb0 * NP + C_AV + (h >> 2) * 128 : TYPE == 2 ? PROJ + kb0 * NP + C_CV + h * 128 : KVB + kb0 * 1024 + h * 256 + 128;
  const bf16_t* Ph = PROJ + kb0 * NP + C_BKR;
  char* V_lds = lds + OFF_V; char* K_lds = lds + OFF_K; char* P_lds = lds + OFF_P;
  float* wsf = (float*)(lds + OFF_WS) + wid * 64; float* li_l = wsf; float* al_l = wsf + 32;
  float* bt = (float*)(lds + OFF_BIAS);
  int kt0 = 0, NT = SEQ / KVBLK;
  if (TYPE == 2) { if (qb == 0) { kt0 = 0; NT = 8; } else if (qb == 7) { kt0 = 24; NT = 8; } else { kt0 = min(4 * qb - 4, 20); NT = 12; } }
  const int nr = 4 * qb + (wid >> 1), nc = 32 * (wid & 1) + r32, nr0 = min(max(nr - 4, 0), 24), nc0 = min(max(nc - 8, 0), 48);
  if (TYPE == 2) { for (int i = tid; i < 465; i += 512) bt[i] = rpb[h * 465 + i] * (1.f / SCALE); }
  float m_reg = -1e30f, l_reg = 0; f32x16 o[4] = {}; bf16x8 qr[NQ];
  const bf16_t* Qw = Qp + (size_t)(wid * QBLK + r32) * LDQ + hi * 8;
#pragma unroll
  for (int d0 = 0; d0 < 8; ++d0) qr[d0] = *reinterpret_cast<const bf16x8*>(Qw + d0 * 16);
  if constexpr (TYPE == 0) {
    float ss = 0.f;
#pragma unroll
    for (int d0 = 0; d0 < 8; ++d0) { const u32x4 w = __builtin_bit_cast(u32x4, qr[d0]);
#pragma unroll
      for (int e = 0; e < 4; ++e) { const float x1 = __uint_as_float(w[e] << 16), x2 = __uint_as_float(w[e] & 0xffff0000u); ss += x1 * x1 + x2 * x2; } }
    { auto rr = __builtin_amdgcn_permlane32_swap(__float_as_uint(ss), __float_as_uint(ss), false, false); ss = __uint_as_float(rr[0]) + __uint_as_float(rr[1]); }
    const float rs = rsqrtf(ss * (1.f / 128.f) + EPS);
    const int t_ = qb * 256 + wid * QBLK + r32, pr = t_ >> 6, pc = t_ & 63;
#pragma unroll
    for (int d0 = 0; d0 < 8; ++d0) { const int ax = d0 >> 2, j0 = (d0 & 3) * 8 + hi * 4;
      const float4 g0 = *(const float4*)(qgain + 64 * ax + j0), g1 = *(const float4*)(qgain + 64 * ax + 32 + j0);
      const float4* tp = (const float4*)(tab + (ax == 0 ? T_AR + pr * 32 : T_AC + pc * 32) + j0); const float4 c01 = tp[0], c23 = tp[1];
      const u32x4 w = __builtin_bit_cast(u32x4, qr[d0]); u32x4 o_;
      { const float x1 = __uint_as_float(w[0] << 16) * rs * g0.x, x2 = __uint_as_float(w[0] & 0xffff0000u) * rs * g1.x; o_[0] = pk2(x1 * c01.x - x2 * c01.y, x2 * c01.x + x1 * c01.y); }
      { const float x1 = __uint_as_float(w[1] << 16) * rs * g0.y, x2 = __uint_as_float(w[1] & 0xffff0000u) * rs * g1.y; o_[1] = pk2(x1 * c01.z - x2 * c01.w, x2 * c01.z + x1 * c01.w); }
      { const float x1 = __uint_as_float(w[2] << 16) * rs * g0.z, x2 = __uint_as_float(w[2] & 0xffff0000u) * rs * g1.z; o_[2] = pk2(x1 * c23.x - x2 * c23.y, x2 * c23.x + x1 * c23.y); }
      { const float x1 = __uint_as_float(w[3] << 16) * rs * g0.w, x2 = __uint_as_float(w[3] & 0xffff0000u) * rs * g1.w; o_[3] = pk2(x1 * c23.z - x2 * c23.w, x2 * c23.z + x1 * c23.w); }
      qr[d0] = __builtin_bit_cast(bf16x8, o_); }
  }
  const char* Qe = lds + OFF_QPE + wid * 4096;
  if constexpr (TYPE == 1) {
#pragma unroll
    for (int i = 0; i < 4; ++i) { const int idx = i * 64 + lane, rw = idx >> 3, ch = idx & 7;
      *(u32x4*)(lds + OFF_QPE + wid * 4096 + PSWZ(rw, ch * 16)) = *reinterpret_cast<const u32x4*>(QB + (row0 + wid * QBLK + rw) * 768 + 512 + h * 64 + ch * 8); } }
  const int sr = tid >> 4, sc = (tid & 15) * 8, vst0 = v_st(sr, sc), vst1 = v_st(32 + sr, sc);
  const int pr_ = tid >> 3, pc_ = (tid & 7) * 8;
  const int vb0 = (int)(uintptr_t)V_lds + v_rd_base(lane);
  struct { bf16x8 vs0, vs1, ks0, ks1, ps; } sr_[2];
#define SLOAD(i, k0) do { const size_t kk_ = (size_t)(kt0 * KVBLK + (k0)); \
    sr_[i].vs0 = *reinterpret_cast<const bf16x8*>(&Vh[(kk_ + sr) * LDK + sc]); sr_[i].vs1 = *reinterpret_cast<const bf16x8*>(&Vh[(kk_ + 32 + sr) * LDK + sc]); \
    sr_[i].ks0 = *reinterpret_cast<const bf16x8*>(&Kh[(kk_ + sr) * LDK + sc]); sr_[i].ks1 = *reinterpret_cast<const bf16x8*>(&Kh[(kk_ + 32 + sr) * LDK + sc]); \
    if constexpr (TYPE == 1) sr_[i].ps = *reinterpret_cast<const bf16x8*>(&Ph[(kk_ + pr_) * NP + pc_]); } while (0)
#define SWRITE(bf, i) do { *(bf16x8*)(V_lds + (bf) * SHM_V + vst0) = sr_[i].vs0; *(bf16x8*)(V_lds + (bf) * SHM_V + vst1) = sr_[i].vs1; const int kc = sc * 2; \
    *(bf16x8*)(K_lds + (bf) * SHM_K + KSWZ(sr, kc)) = sr_[i].ks0; *(bf16x8*)(K_lds + (bf) * SHM_K + KSWZ(32 + sr, kc)) = sr_[i].ks1; \
    if constexpr (TYPE == 1) *(bf16x8*)(P_lds + (bf) * SHM_P + PSWZ(pr_, pc_ * 2)) = sr_[i].ps; } while (0)
#define SWAIT() do { if constexpr (SDEPTH == 2) { if constexpr (TYPE == 1) asm volatile("s_waitcnt vmcnt(5)" ::: "memory"); else asm volatile("s_waitcnt vmcnt(4)" ::: "memory"); } \
    else asm volatile("s_waitcnt vmcnt(0)" ::: "memory"); } while (0)
#define RESC(a) do { if (__any((a) < 1.f)) { if (hi == 0) al_l[r32] = (a); asm volatile("s_waitcnt lgkmcnt(0)" ::: "memory"); \
    _Pragma("unroll") for (int d = 0; d < 4; ++d) _Pragma("unroll") for (int r = 0; r < 16; ++r) o[d][r] *= al_l[crow(r, hi)]; } } while (0)
#define MASK(P0, P1, j) do { if constexpr (TYPE == 2) nb_mask(P0, P1, kt0 + (j), nr, nr0, nc, nc0, hi, bt); } while (0)
  f32x16 pA0, pA1, pB0, pB1; float mnA, mnB, alA, alB; bf16x8 pa0, pa1, pa2, pa3;
  constexpr int SE = 0, SO = SDEPTH - 1;
  if constexpr (TYPE == 2) {
    const int wnr0 = __builtin_amdgcn_readfirstlane(nr0);
#define ACT(j) ((unsigned)(kt0 + (j) - wnr0) < 8u)
#define TILE(j, bf) do { if (ACT(j)) { qkt<TYPE>(pA0, pA1, K_lds + (bf) * SHM_K, P_lds, qr, Qe, r32, hi); MASK(pA0, pA1, j); partialSM<TYPE>(pA0, pA1, m_reg, mnA, alA); RESC(alA); \
      finishSM(pA0, pA1, alA, l_reg, pa0, pa1, pa2, pa3); SBAR(); pv_d0(o, vb0 + (bf) * SHM_V, pa0, pa1, pa2, pa3); } } while (0)
    SLOAD(0, 0); asm volatile("s_waitcnt vmcnt(0)" ::: "memory"); SWRITE(0, 0); __syncthreads();
    SLOAD(1, KVBLK); if constexpr (SDEPTH == 2) SLOAD(0, 2 * KVBLK);
    for (int j = 0; j < NT; j += 2) {
      TILE(j, 0);
      SWAIT(); SWRITE(1, 1);
      if constexpr (SDEPTH == 2) { if (j + 3 < NT) SLOAD(1, (j + 3) * KVBLK); }
      __syncthreads();
      if constexpr (SDEPTH == 1) { if (j + 2 < NT) SLOAD(0, (j + 2) * KVBLK); }
      TILE(j + 1, 1);
      if (j + 2 < NT) { SWAIT(); SWRITE(0, 0);
        if constexpr (SDEPTH == 2) { if (j + 4 < NT) SLOAD(0, (j + 4) * KVBLK); }
        __syncthreads();
        if constexpr (SDEPTH == 1) SLOAD(1, (j + 3) * KVBLK); }
    }
#undef TILE
#undef ACT
  } else {
  SLOAD(SE, 0); asm volatile("s_waitcnt vmcnt(0)" ::: "memory"); SWRITE(0, SE); __syncthreads();
  qkt<TYPE>(pA0, pA1, K_lds, P_lds, qr, Qe, r32, hi); MASK(pA0, pA1, 0); partialSM<TYPE>(pA0, pA1, m_reg, mnA, alA);
  SLOAD(SO, KVBLK); if constexpr (SDEPTH == 2) { if (2 < NT) SLOAD(SE, 2 * KVBLK); }
  SWAIT(); SWRITE(1, SO); __syncthreads();
  for (int j = 1; j + 1 < NT; j += 2) {
    SBAR(); qkt<TYPE>(pB0, pB1, K_lds + SHM_K, P_lds + SHM_P, qr, Qe, r32, hi); MASK(pB0, pB1, j);
    finishSM(pA0, pA1, alA, l_reg, pa0, pa1, pa2, pa3); SBAR();
    SLOAD(SO, (j + SDEPTH) * KVBLK); SBAR();
    pv_d0(o, vb0, pa0, pa1, pa2, pa3); partialSM<TYPE>(pB0, pB1, m_reg, mnB, alB);
    __syncthreads(); SWAIT(); SWRITE(0, SE);
    RESC(alB); __syncthreads();
    SBAR(); qkt<TYPE>(pA0, pA1, K_lds, P_lds, qr, Qe, r32, hi); MASK(pA0, pA1, j + 1);
    finishSM(pB0, pB1, alB, l_reg, pa0, pa1, pa2, pa3); SBAR();
    if (SDEPTH == 1 || j + 3 < NT) SLOAD(SE, (j + 1 + SDEPTH) * KVBLK); SBAR();
    pv_d0(o, vb0 + SHM_V, pa0, pa1, pa2, pa3); partialSM<TYPE>(pA0, pA1, m_reg, mnA, alA);
    __syncthreads(); SWAIT(); SWRITE(1, SO);
    RESC(alA); __syncthreads();
  }
  SBAR(); qkt<TYPE>(pB0, pB1, K_lds + SHM_K, P_lds + SHM_P, qr, Qe, r32, hi); MASK(pB0, pB1, NT - 1);
  finishSM(pA0, pA1, alA, l_reg, pa0, pa1, pa2, pa3); SBAR();
  pv_d0(o, vb0, pa0, pa1, pa2, pa3); partialSM<TYPE>(pB0, pB1, m_reg, mnB, alB);
  __syncthreads(); RESC(alB);
  finishSM(pB0, pB1, alB, l_reg, pa0, pa1, pa2, pa3); SBAR();
  pv_d0(o, vb0 + SHM_V, pa0, pa1, pa2, pa3);
  }
  if (hi == 0) li_l[r32] = l_reg; asm volatile("s_waitcnt lgkmcnt(0)" ::: "memory");
  float rli[16];
#pragma unroll
  for (int r = 0; r < 16; ++r) rli[r] = __builtin_amdgcn_rcpf(li_l[crow(r, hi)]);
  __syncthreads();
  bf16_t* stg = (bf16_t*)(lds + wid * 8192);
#pragma unroll
  for (int r = 0; r < 16; ++r) { const int orow = crow(r, hi);
#pragma unroll
    for (int d0 = 0; d0 < 4; ++d0) stg[orow * 128 + d0 * 32 + r32] = (bf16_t)f2bf(o[d0][r] * rli[r]); }
  asm volatile("s_waitcnt lgkmcnt(0)" ::: "memory");
  constexpr int GCOL = TYPE == 0 ? C_AG : TYPE == 1 ? C_BG : C_CG, MCOL = TYPE == 0 ? 0 : TYPE == 1 ? 1024 : 1536;
  const bf16_t* Gp = PROJ + (row0 + wid * QBLK) * NP + GCOL + h * 128; bf16_t* Op = MIX + (row0 + wid * QBLK) * DMIX + MCOL + h * 128;
#pragma unroll
  for (int i = 0; i < 8; ++i) { const int pidx = i * 64 + lane, row = pidx >> 4, ch = pidx & 15;
    const u32x4 ov = *(const u32x4*)(stg + row * 128 + ch * 8); const u32x4 gv = *(const u32x4*)(Gp + (size_t)row * NP + ch * 8);
    u32x4 w;
#pragma unroll
    for (int e = 0; e < 4; ++e) { const float g0 = bf2f(gv[e] & 0xffffu), g1 = bf2f(gv[e] >> 16), o0 = bf2f(ov[e] & 0xffffu), o1 = bf2f(ov[e] >> 16);
      w[e] = pk2(o0 * g0 * __builtin_amdgcn_rcpf(1.f + __expf(-g0)), o1 * g1 * __builtin_amdgcn_rcpf(1.f + __expf(-g1))); }
    *(u32x4*)(Op + (size_t)row * DMIX + ch * 8) = w; }
  __syncthreads();
#undef SLOAD
#undef SWRITE
#undef SWAIT
#undef RESC
#undef MASK
}
#undef SBAR
}
#ifndef AMASK
#define AMASK 7
#endif
#ifndef REP_KIND
#define REP_KIND -1
#endif
#ifndef G1_NOEPI
#define G1_NOEPI 0
#endif
#ifndef G1_ALIGN
#define G1_ALIGN true
#endif
#ifndef G1_SP2
#define G1_SP2 true
#endif
#ifndef AREP
#define AREP 7
#endif
#define NREP(k) ((k) == REP_KIND ? 2 : 1)
constexpr int NWAVES = 8;
constexpr int N_PHASES = 1 + 5 * DEPTH;
constexpr size_t WS_CTL = 0, CTL_ZERO_BYTES = 64 * 1024;
constexpr int CW_BAR = 1024;
constexpr int RING_OFF = 0, RING_BYTES = 131072;
constexpr int LDSCTL_OFF = RING_BYTES, MISC_OFF = LDSCTL_OFF + 320, RST_OFF = LDSCTL_OFF + 1024;
constexpr int LDS_BYTES = 147456;

#define GAS __attribute__((address_space(1)))
#define LAS __attribute__((address_space(3)))
typedef GAS unsigned gu32;
#define RLX_AGENT __ATOMIC_RELAXED, __HIP_MEMORY_SCOPE_AGENT

#define XB_TMO      128
#define XB_XCNT(j)  (256  + 64 * (j))
#define XB_XSUB(j)  (1280 + 64 * (j))
#define XB_XGEN(j)  (2304 + 64 * (j))
#define XB_TOP      3328
#define XB_TOPGEN   3392
#define XCD_BAR_WORDS 3456
#define XB_SPIN_CAP (1u << 18)
__device__ __forceinline__ unsigned xb_ld(unsigned* p)              { return __hip_atomic_load(p, __ATOMIC_RELAXED, __HIP_MEMORY_SCOPE_AGENT); }
__device__ __forceinline__ unsigned xb_add(unsigned* p, unsigned v) { return __hip_atomic_fetch_add(p, v, __ATOMIC_RELAXED, __HIP_MEMORY_SCOPE_AGENT); }
__device__ __forceinline__ unsigned xb_xcc_id() { return (unsigned)__builtin_amdgcn_s_getreg((3 << 11) | 20) & 0xFu; }
#define XB_SPIN(cond, bar) do { unsigned _sp = 0; while (cond) { __builtin_amdgcn_s_sleep(1); \
    if ((++_sp & 255u) == 0u) { if (xb_ld(&(bar)[XB_TMO])) break; if (_sp > XB_SPIN_CAP) { atomicAdd(&(bar)[XB_TMO], 1u); break; } } } } while (0)
struct XcdBarrier { unsigned* bar; unsigned x; volatile LAS unsigned* st; };
__device__ __forceinline__ XcdBarrier xcd_barrier_post(unsigned* bar, volatile LAS unsigned* st) {
    XcdBarrier b; b.bar = bar; b.x = xb_xcc_id(); b.st = st;
    if (threadIdx.x == 0) (void)xb_add(&bar[XB_XCNT(b.x)], 1u);
    return b;
}
__device__ __forceinline__ void xcd_barrier_complete(unsigned* bar, unsigned x, unsigned& nloc, unsigned& nx) {
    const unsigned G = gridDim.x * gridDim.y * gridDim.z;
    unsigned sum, cnt, mine, sp = 0u;
    for (;;) {
        sum = 0u; cnt = 0u; mine = 0u;
#pragma unroll
        for (unsigned j = 0; j < 16; ++j) { const unsigned c = xb_ld(&bar[XB_XCNT(j)]); sum += c; cnt += (c > 0u) ? 1u : 0u; mine = (j == x) ? c : mine; }
        if (sum == G) break;
        __builtin_amdgcn_s_sleep(1);
        if ((++sp & 255u) == 0u) { if (xb_ld(&bar[XB_TMO])) break; if (sp > XB_SPIN_CAP) { atomicAdd(&bar[XB_TMO], 1u); break; } }
    }
    nloc = mine > 0u ? mine : 1u; nx = cnt > 0u ? cnt : 1u;
}
__device__ __forceinline__ void xcd_barrier(const XcdBarrier& b) {
    asm volatile("s_waitcnt vmcnt(0)" ::: "memory");
    __syncthreads();
    if (threadIdx.x == 0) {
        unsigned* bar = b.bar;
        __builtin_amdgcn_s_waitcnt(0);
        unsigned nloc = b.st[0], nx = b.st[1];
        if (nloc == 0u) { xcd_barrier_complete(bar, b.x, nloc, nx); b.st[0] = nloc; b.st[1] = nx; }
        const unsigned old = xb_add(&bar[XB_XSUB(b.x)], 1u);
        const unsigned gen = old / nloc;
        if (old + 1u == (gen + 1u) * nloc) {
            __builtin_amdgcn_fence(__ATOMIC_RELEASE, "agent");
            asm volatile("s_waitcnt vmcnt(0)" ::: "memory");
            const unsigned og = xb_add(&bar[XB_TOP], 1u);
            const unsigned tg = og / nx;
            if (og + 1u == (tg + 1u) * nx) xb_add(&bar[XB_TOPGEN], 1u);
            else XB_SPIN(xb_ld(&bar[XB_TOPGEN]) == tg, bar);
            __builtin_amdgcn_fence(__ATOMIC_ACQUIRE, "agent");
            xb_add(&bar[XB_XGEN(b.x)], 1u);
            asm volatile("s_waitcnt vmcnt(0)" ::: "memory");
        } else {
            XB_SPIN(xb_ld(&bar[XB_XGEN(b.x)]) == gen, bar);
            __builtin_amdgcn_fence(__ATOMIC_ACQUIRE, "agent");
            asm volatile("s_waitcnt vmcnt(0)" ::: "memory");
        }
    }
    __syncthreads();
}

struct Args {
    const float* in[12]; float* out; unsigned char* ws;
    int ph_lo, ph_hi, li, amask;
};


DEVI int fwd_col(int mode, int o) {
    if (mode == 0) return o;
    if (mode == 1) {
        if (o < 1280) { const int d = o & 127, a = d >> 6, t = (d >> 5) & 1, j = d & 31; return (o & ~127) + 64 * a + 2 * j + t; }
        if (o < 3328) return o;
        if (o < 3392) { const int d = o - 3328, a = d >> 5, t = (d >> 4) & 1, j = d & 15; return 3328 + 32 * a + 2 * j + t; }
        return o + 192;
    }
    const int h = o / 192, d = o - h * 192;
    if (d < 128) return h * 128 + d;
    { const int p = d - 128, a = p >> 5, t = (p >> 4) & 1, j = p & 15; return 512 + h * 64 + 32 * a + 2 * j + t; }
}
DEVI void p0_transpose_item(const float* __restrict__ W, int K, int Ns, int mode, const float* __restrict__ kgain, bf16_t* __restrict__ WT, LAS unsigned* scr, int item, int lane) {
    const int nblk = Ns / 64, kb = item / nblk, nb = item - kb * nblk, k0 = 64 * kb, n0 = 64 * nb;
    const int ks = lane >> 4, n4 = (lane & 15) * 4;
    float4 v[16];
#pragma unroll
    for (int i = 0; i < 16; ++i) { const int k = 8 * (i >> 1) + 2 * ks + (i & 1); v[i] = *(const float4*)(W + (size_t)(k0 + k) * Ns + n0 + n4); }
#pragma unroll
    for (int i = 0; i < 8; ++i) { const int kp = 4 * i + ks; float g0 = 1.f, g1 = 1.f;
        if (kgain) { g0 = kgain[k0 + 2 * kp]; g1 = kgain[k0 + 2 * kp + 1]; }
        LAS unsigned* d = scr + kp * 65 + n4;
        d[0] = pk2(v[2 * i].x * g0, v[2 * i + 1].x * g1); d[1] = pk2(v[2 * i].y * g0, v[2 * i + 1].y * g1);
        d[2] = pk2(v[2 * i].z * g0, v[2 * i + 1].z * g1); d[3] = pk2(v[2 * i].w * g0, v[2 * i + 1].w * g1); }
    asm volatile("s_waitcnt lgkmcnt(0)" ::: "memory");
    const int c = lane & 7;
#pragma unroll
    for (int i = 0; i < 8; ++i) { const int n = 8 * i + (lane >> 3); const LAS unsigned* s = scr + (4 * c) * 65 + n;
        uint4 o; o.x = s[0]; o.y = s[65]; o.z = s[130]; o.w = s[195];
        *(uint4*)(WT + (size_t)fwd_col(mode, n0 + n) * K + k0 + 8 * c) = o; }
    asm volatile("s_waitcnt lgkmcnt(0)" ::: "memory");
}
DEVI void rmsnorm_row_xn(const float* __restrict__ xrow, const float* __restrict__ g, bf16_t* __restrict__ orow, int lane) {
    const float4* xr = (const float4*)xrow + lane;
    float4 v[8]; float ss = 0.f;
#pragma unroll
    for (int j = 0; j < 8; ++j) { v[j] = xr[64 * j]; ss += v[j].x * v[j].x + v[j].y * v[j].y + v[j].z * v[j].z + v[j].w * v[j].w; }
    const float rs = rsqrtf(wave_sum(ss) * (1.f / DM) + EPS);
    uint2* o = (uint2*)orow + lane;
#pragma unroll
    for (int j = 0; j < 8; ++j) { const float4 gg = ((const float4*)g)[lane + 64 * j];
        o[64 * j] = make_uint2(pk2(v[j].x * rs * gg.x, v[j].y * rs * gg.y), pk2(v[j].z * rs * gg.z, v[j].w * rs * gg.w)); }
}
DEVI void phase_prologue(const Args& args, LAS unsigned char* L, int gw, int NGW, int wave, int lane) {
    unsigned char* ws = args.ws;
    LAS unsigned* scr = (LAS unsigned*)(L + RING_OFF + wave * 16384);
    constexpr int I_IN = (DM / 64) * (DIN / 64), I_OUT = (DMIX / 64) * (DM / 64), I_UQ = (512 / 64) * (768 / 64), I_UKV = (256 / 64) * (1024 / 64), I_L = I_IN + I_OUT + I_UQ + I_UKV;
    for (int it = gw; it < DEPTH * I_L; it += NGW) {
        const int l = it / I_L; int r = it % I_L;
        if (r < I_IN) { p0_transpose_item(args.in[3] + (size_t)l * DM * DIN, DM, DIN, 1, nullptr, (bf16_t*)(ws + WS_WIN + l * WIN_L), scr, r, lane); continue; } r -= I_IN;
        if (r < I_OUT) { p0_transpose_item(args.in[11] + (size_t)l * DMIX * DM, DMIX, DM, 0, nullptr, (bf16_t*)(ws + WS_WOUT + l * WOUT_L), scr, r, lane); continue; } r -= I_OUT;
        if (r < I_UQ) { p0_transpose_item(args.in[8] + (size_t)l * 512 * 768, 512, 768, 2, args.in[6] + l * 512, (bf16_t*)(ws + WS_WUQ + l * WUQ_L), scr, r, lane); continue; } r -= I_UQ;
        p0_transpose_item(args.in[9] + (size_t)l * 256 * 1024, 256, 1024, 0, args.in[7] + l * 256, (bf16_t*)(ws + WS_WUKV + l * WUKV_L), scr, r, lane);
    }
    for (int it = gw; it < DEPTH * 192 * 4; it += NGW) { const int l = it / 768, r = (it % 768) >> 2, q = it & 3;
        ((uint4*)((bf16_t*)(ws + WS_WIN + l * WIN_L) + (size_t)(3392 + r) * DM))[q * 64 + lane] = make_uint4(0u, 0u, 0u, 0u); }
    bf16_t* XN = (bf16_t*)(ws + WS_XN);
    for (int m = gw; m < M; m += NGW) rmsnorm_row_xn(args.in[0] + (size_t)m * DM, args.in[1], XN + (size_t)m * DM, lane);
    float2* tab = (float2*)(ws + WS_TAB);
    for (int i = gw * 64 + lane; i < T_N; i += NGW * 64) {
        int pos, j; float n;
        if (i < T_AC) { pos = i >> 5; j = i & 31; n = 64.f; }
        else if (i < T_BR) { pos = (i - T_AC) >> 5; j = i & 31; n = 64.f; }
        else if (i < T_BC) { pos = (i - T_BR) >> 4; j = i & 15; n = 32.f; }
        else { pos = (i - T_BC) >> 4; j = i & 15; n = 32.f; }
        const float inv = 1.0f / powf(10000.f, (float)(2 * j) / n);
        const float ang = (float)pos * inv;
        const float k = rintf(ang * 0.15915494309189535f);
        float r = fmaf(-k, 6.28318548202514648f, ang); r = fmaf(-k, -1.74845553e-7f, r);
        tab[i] = make_float2(cosf(r), sinf(r));
    }
}
DEVI void postproj_row(bf16_t* __restrict__ p, int row, int lane, const float* __restrict__ a_qn, const float* __restrict__ a_kn,
                       const float* __restrict__ b_qn, const float* __restrict__ b_kvn, const float2* __restrict__ tab) {
    const int t = row & (SEQ - 1), pr = t >> 6, pc = t & 63;
    {
        const int a = lane >> 5, j = lane & 31;
        const float2 cs = a == 0 ? tab[T_AR + pr * 32 + j] : tab[T_AC + pc * 32 + j];
        const int d1 = 64 * a + j, d2 = d1 + 32;
        const float gq1 = a_qn[d1], gq2 = a_qn[d2], gk1 = a_kn[d1], gk2 = a_kn[d2];
        unsigned v[10];
#pragma unroll
        for (int hb = 0; hb < 10; ++hb) v[hb] = ((const unsigned*)(p + hb * 128))[lane];
#pragma unroll
        for (int hb = 0; hb < 10; ++hb) {
            const float x1 = bf2f(v[hb] & 0xffffu), x2 = bf2f(v[hb] >> 16);
            const float rs = rsqrtf(wave_sum(x1 * x1 + x2 * x2) * (1.f / 128.f) + EPS);
            const float y1 = x1 * rs * (hb < 8 ? gq1 : gk1), y2 = x2 * rs * (hb < 8 ? gq2 : gk2);
            ((unsigned*)(p + hb * 128))[lane] = pk2(y1 * cs.x - y2 * cs.y, y2 * cs.x + y1 * cs.y);
        }
    }
    {
        uint4* pp = (uint4*)(p + C_BCQ) + lane; const uint4 v = *pp; float x[8];
        x[0] = bf2f(v.x & 0xffffu); x[1] = bf2f(v.x >> 16); x[2] = bf2f(v.y & 0xffffu); x[3] = bf2f(v.y >> 16);
        x[4] = bf2f(v.z & 0xffffu); x[5] = bf2f(v.z >> 16); x[6] = bf2f(v.w & 0xffffu); x[7] = bf2f(v.w >> 16);
        float ss = 0.f;
#pragma unroll
        for (int i = 0; i < 8; ++i) ss += x[i] * x[i];
        const float rs = rsqrtf(wave_sum(ss) * (1.f / 512.f) + EPS);
        const float4 g0 = ((const float4*)b_qn)[2 * lane], g1 = ((const float4*)b_qn)[2 * lane + 1];
        *pp = make_uint4(pk2(x[0] * rs * g0.x, x[1] * rs * g0.y), pk2(x[2] * rs * g0.z, x[3] * rs * g0.w),
                         pk2(x[4] * rs * g1.x, x[5] * rs * g1.y), pk2(x[6] * rs * g1.z, x[7] * rs * g1.w));
    }
    {
        uint2* pp = (uint2*)(p + C_BCKV) + lane; const uint2 v = *pp;
        const float x0 = bf2f(v.x & 0xffffu), x1 = bf2f(v.x >> 16), x2 = bf2f(v.y & 0xffffu), x3 = bf2f(v.y >> 16);
        const float rs = rsqrtf(wave_sum(x0 * x0 + x1 * x1 + x2 * x2 + x3 * x3) * (1.f / 256.f) + EPS);
        const float4 g = ((const float4*)b_kvn)[lane];
        *pp = make_uint2(pk2(x0 * rs * g.x, x1 * rs * g.y), pk2(x2 * rs * g.z, x3 * rs * g.w));
    }
    if (lane < 32) {
        const int a = lane >> 4, j = lane & 15;
        const float2 cs = a == 0 ? tab[T_BR + pr * 16 + j] : tab[T_BC + pc * 16 + j];
        unsigned* pp = (unsigned*)(p + C_BKR) + lane; const unsigned v = *pp; const float x1 = bf2f(v & 0xffffu), x2 = bf2f(v >> 16);
        *pp = pk2(x1 * cs.x - x2 * cs.y, x2 * cs.x + x1 * cs.y);
    }
}
DEVI void postprojK_row(bf16_t* __restrict__ p, int row, int lane, const float* __restrict__ a_kn, const float2* __restrict__ tab) {
    const int t = row & (SEQ - 1), pr = t >> 6, pc = t & 63;
    const int a = lane >> 5, j = lane & 31;
    const float2 cs = a == 0 ? tab[T_AR + pr * 32 + j] : tab[T_AC + pc * 32 + j];
    const float gk1 = a_kn[64 * a + j], gk2 = a_kn[64 * a + j + 32];
    unsigned* pk = (unsigned*)(p + C_AK); const unsigned v0 = pk[lane], v1 = pk[64 + lane];
    unsigned vr = 0; const int a2 = lane >> 4, j2 = lane & 15; float2 cs2 = make_float2(1.f, 0.f);
    if (lane < 32) { vr = ((const unsigned*)(p + C_BKR))[lane]; cs2 = a2 == 0 ? tab[T_BR + pr * 16 + j2] : tab[T_BC + pc * 16 + j2]; }
    { const float x1 = bf2f(v0 & 0xffffu), x2 = bf2f(v0 >> 16); const float rs = rsqrtf(wave_sum(x1 * x1 + x2 * x2) * (1.f / 128.f) + EPS);
      const float y1 = x1 * rs * gk1, y2 = x2 * rs * gk2; pk[lane] = pk2(y1 * cs.x - y2 * cs.y, y2 * cs.x + y1 * cs.y); }
    { const float x1 = bf2f(v1 & 0xffffu), x2 = bf2f(v1 >> 16); const float rs = rsqrtf(wave_sum(x1 * x1 + x2 * x2) * (1.f / 128.f) + EPS);
      const float y1 = x1 * rs * gk1, y2 = x2 * rs * gk2; pk[64 + lane] = pk2(y1 * cs.x - y2 * cs.y, y2 * cs.x + y1 * cs.y); }
    if (lane < 32) { const float x1 = bf2f(vr & 0xffffu), x2 = bf2f(vr >> 16); ((unsigned*)(p + C_BKR))[lane] = pk2(x1 * cs2.x - x2 * cs2.y, x2 * cs2.x + x1 * cs2.y); }
}
template <bool FIRST>
DEVI void rowpass_row(const bf16_t* __restrict__ yrow, const float* __restrict__ xrow, const bf16_t* __restrict__ x1row_in, const float* __restrict__ g_post, float* __restrict__ orow_,
                      bf16_t* __restrict__ x1row_out, const float* __restrict__ g_next, bf16_t* __restrict__ xnrow, int lane) {
    const uint2* yr = (const uint2*)yrow + lane;
    float4 v[8]; float ss = 0.f;
#pragma unroll
    for (int j = 0; j < 8; ++j) { const uint2 yv = yr[64 * j]; v[j] = make_float4(bf2f(yv.x & 0xffffu), bf2f(yv.x >> 16), bf2f(yv.y & 0xffffu), bf2f(yv.y >> 16)); ss += v[j].x * v[j].x + v[j].y * v[j].y + v[j].z * v[j].z + v[j].w * v[j].w; }
    const float rs = rsqrtf(wave_sum(ss) * (1.f / DM) + EPS);
    float s2 = 0.f;
#pragma unroll
    for (int j = 0; j < 8; ++j) { const float4 gg = ((const float4*)g_post)[lane + 64 * j]; float4 xx;
        if (FIRST) xx = ((const float4*)xrow)[lane + 64 * j];
        else { const uint2 xv = ((const uint2*)x1row_in)[lane + 64 * j]; xx = make_float4(bf2f(xv.x & 0xffffu), bf2f(xv.x >> 16), bf2f(xv.y & 0xffffu), bf2f(xv.y >> 16)); }
        v[j].x = xx.x + v[j].x * rs * gg.x; v[j].y = xx.y + v[j].y * rs * gg.y; v[j].z = xx.z + v[j].z * rs * gg.z; v[j].w = xx.w + v[j].w * rs * gg.w;
        if (FIRST) { ((uint2*)x1row_out)[lane + 64 * j] = make_uint2(pk2(v[j].x, v[j].y), pk2(v[j].z, v[j].w)); s2 += v[j].x * v[j].x + v[j].y * v[j].y + v[j].z * v[j].z + v[j].w * v[j].w; }
        else ((float4*)orow_)[lane + 64 * j] = v[j]; }
    if (FIRST) {
        const float r2 = rsqrtf(wave_sum(s2) * (1.f / DM) + EPS);
        uint2* o = (uint2*)xnrow + lane;
#pragma unroll
        for (int j = 0; j < 8; ++j) { const float4 gg = ((const float4*)g_next)[lane + 64 * j];
            o[64 * j] = make_uint2(pk2(v[j].x * r2 * gg.x, v[j].y * r2 * gg.y), pk2(v[j].z * r2 * gg.z, v[j].w * r2 * gg.w)); }
    }
}

__global__ void __launch_bounds__(NWAVES * 64, 2) mk_fwd(Args args) {
    extern __shared__ __attribute__((aligned(16))) unsigned char lds[];
    LAS unsigned char* L = (LAS unsigned char*)lds;
    volatile LAS unsigned* MISC = (volatile LAS unsigned*)(L + MISC_OFF);
    const int G = gridDim.x; const int bx = blockIdx.x;
    const int vcu = (G % 8 == 0) ? (bx % 8) * (G / 8) + bx / 8 : bx;
    unsigned char* ws = args.ws;
    gu32* ctl = (gu32*)(ws + WS_CTL);
    for (int u = threadIdx.x; u < (LDS_BYTES - LDSCTL_OFF) / 4; u += NWAVES * 64) ((LAS unsigned*)(L + LDSCTL_OFF))[u] = 0u;
    __syncthreads();
    XcdBarrier bar; bar.bar = (unsigned*)(ctl + CW_BAR) + args.li * XCD_BAR_WORDS; bar.x = 0; bar.st = nullptr;
    const bool multi = (args.ph_hi - args.ph_lo) > 1;
    if (multi) bar = xcd_barrier_post((unsigned*)(ctl + CW_BAR) + args.li * XCD_BAR_WORDS, MISC + 8);
    bf16_t* XN = (bf16_t*)(ws + WS_XN); bf16_t* PROJ = (bf16_t*)(ws + WS_PROJ); bf16_t* Y = (bf16_t*)(ws + WS_Y);
    bf16_t* QB = (bf16_t*)(ws + WS_QB); bf16_t* KVB = (bf16_t*)(ws + WS_KVB); bf16_t* MIX = (bf16_t*)(ws + WS_MIX);
    const int lo = args.ph_lo, hi = args.ph_hi;
#define IN(k) (lo <= (k) && (k) < hi)
#define SEAM(k) do { if (IN(k) && IN((k) + 1)) xcd_barrier(bar); } while (0)
    const int NGW = G * NWAVES;
#define FRESH_IDS() int tid__ = threadIdx.x; asm volatile("" : "+v"(tid__)); const int lane_ = tid__ & 63, wave_ = __builtin_amdgcn_readfirstlane(tid__ >> 6), gw_ = vcu * NWAVES + wave_
    const float2* tab = (const float2*)(ws + WS_TAB);
    if (IN(0)) { for (int rep_ = 0; rep_ < NREP(0); ++rep_) { FRESH_IDS(); phase_prologue(args, L, gw_, NGW, wave_, lane_); } }
    SEAM(0);
#define LAYER(l) do { \
        constexpr int pb = 1 + 5 * (l); \
        if (IN(pb + 0)) { for (int rep_ = 0; rep_ < NREP(1); ++rep_) { \
            pg8::Gemm g{XN, (const bf16_t*)(ws + WS_WIN + (l) * WIN_L)}; pg8::StaticOrder S; S.init(M, NP, G, bx); \
            pg8::EpiBf16 E{PROJ, NP}; \
            pg8::gemm_phase<DM, DM, DM, pg8::EpiBf16, pg8::StaticOrder, true, true>(L + RING_OFF, g, S, E); \
        } } \
        SEAM(pb + 0); \
        if (IN(pb + 1)) { for (int rep_ = 0; rep_ < NREP(3); ++rep_) { \
            if (rep_ == 0) { FRESH_IDS(); for (int m = gw_; m < M; m += NGW) postprojK_row(PROJ + (size_t)m * NP, m, lane_, args.in[5] + (l) * 128, tab); } \
            { pg8::Gemm g{PROJ + C_BCQ, (const bf16_t*)(ws + WS_WUQ + (l) * WUQ_L)}; pg8::RsOrder<512, NP> S; S.init(M, 768, G, bx); S.A = PROJ + C_BCQ; S.tab = (LAS float*)(L + RST_OFF); \
              pg8::EpiBf16Rs<2> E{QB, 768, (const LAS float*)(L + RST_OFF), tab + T_BR, tab + T_BC}; \
              pg8::gemm_phase<512, NP, 512, pg8::EpiBf16Rs<2>, pg8::RsOrder<512, NP>, true, true>(L + RING_OFF, g, S, E); } \
            { pg8::Gemm g{PROJ + C_BCKV, (const bf16_t*)(ws + WS_WUKV + (l) * WUKV_L)}; pg8::RsOrder<256, NP> S; S.init(M, 1024, G, bx); S.A = PROJ + C_BCKV; S.tab = (LAS float*)(L + RST_OFF); \
              pg8::EpiBf16Rs<-1> E{KVB, 1024, (const LAS float*)(L + RST_OFF), tab, tab}; \
              pg8::gemm_phase<256, NP, 256, pg8::EpiBf16Rs<-1>, pg8::RsOrder<256, NP>, true, true>(L + RING_OFF, g, S, E); } \
        } } \
        SEAM(pb + 1); \
        if (IN(pb + 2)) { for (int rep_ = 0; rep_ < NREP(4); ++rep_) { \
            const float* rpb_l = args.in[10] + (size_t)(l) * 4 * 465; const float* qg_l = args.in[4] + (l) * 128; \
            for (int u = vcu; u < 1024; u += G) { \
                if (u < 512) { if (rep_ == 0 || (AREP & 1)) { const int kvh = u >> 8, b_ = (u & 255) >> 5, i_ = u & 31; att::attn_unit<0, 2>(b_, kvh * 4 + (i_ >> 3), i_ & 7, PROJ, QB, KVB, rpb_l, qg_l, tab, MIX, (char*)lds + RING_OFF); } } \
                else if (u < 768) { if (rep_ == 0 || (AREP & 2)) { const int ub = u - 512, b_ = ub >> 5, i_ = ub & 31; att::attn_unit<1, 1>(b_, i_ >> 3, i_ & 7, PROJ, QB, KVB, rpb_l, qg_l, tab, MIX, (char*)lds + RING_OFF); } } \
                else { if (rep_ == 0 || (AREP & 4)) { const int ub = u - 768, b_ = ub >> 5, i_ = ub & 31; att::attn_unit<2, 2>(b_, i_ >> 3, i_ & 7, PROJ, QB, KVB, rpb_l, qg_l, tab, MIX, (char*)lds + RING_OFF); } } \
            } \
        } } \
        SEAM(pb + 2); \
        if (IN(pb + 3)) { for (int rep_ = 0; rep_ < NREP(5); ++rep_) { \
            pg8::Gemm g{MIX, (const bf16_t*)(ws + WS_WOUT + (l) * WOUT_L)}; pg8::StaticOrder S; S.init(M, DM, G, bx); \
            pg8::EpiBf16 E{Y, DM}; \
            pg8::gemm_phase<DMIX, DMIX, DMIX, pg8::EpiBf16, pg8::StaticOrder, true, true>(L + RING_OFF, g, S, E); \
        } } \
        SEAM(pb + 3); \
        if (IN(pb + 4)) { FRESH_IDS(); bf16_t* X1B = (bf16_t*)(ws + WS_X1B); for (int m = gw_; m < M; m += NGW) rowpass_row<(l) == 0>(Y + (size_t)m * DM, args.in[0] + (size_t)m * DM, X1B + (size_t)m * DM, args.in[2] + (l) * DM, args.out + (size_t)m * DM, \
                X1B + (size_t)m * DM, args.in[1] + (((l) + 1) % DEPTH) * DM, XN + (size_t)m * DM, lane_); } \
        SEAM(pb + 4); \
    } while (0)
    LAYER(0);
    LAYER(1);
#undef LAYER
#undef IN
#undef SEAM
}

static int g_grid = 0;
static void launch_mk(Args a, int lo, int hi, int li, hipStream_t stream) {
    a.ph_lo = lo; a.ph_hi = hi; a.li = li;
    hipLaunchKernelGGL(mk_fwd, dim3(g_grid), dim3(NWAVES * 64), LDS_BYTES, stream, a);
}

extern "C" void kernel_launch(void* const* d_in, const int* in_sizes, int n_in, void* d_out, int out_size, void* d_ws, size_t ws_size, hipStream_t stream) {
  if (n_in != 12 || in_sizes[0] != M * DM || out_size != M * DM || ws_size < WS_END) {
    fprintf(stderr, "kernel_launch: unexpected shapes n_in %d in0 %d out %d ws %zu (need %zu)\n", n_in, n_in > 0 ? in_sizes[0] : -1, out_size, ws_size, (size_t)WS_END); return; }
  if (g_grid == 0) {
    int dev = 0, cus = 0, per_cu = 0;
    if (hipGetDevice(&dev) != hipSuccess || hipDeviceGetAttribute(&cus, hipDeviceAttributeMultiprocessorCount, dev) != hipSuccess) { fprintf(stderr, "kernel_launch: device query failed\n"); g_grid = -1; return; }
    if (hipFuncSetAttribute((const void*)mk_fwd, hipFuncAttributeMaxDynamicSharedMemorySize, LDS_BYTES) != hipSuccess) { fprintf(stderr, "kernel_launch: hipFuncSetAttribute failed\n"); g_grid = -1; return; }
    if (hipOccupancyMaxActiveBlocksPerMultiprocessor(&per_cu, (const void*)mk_fwd, NWAVES * 64, LDS_BYTES) != hipSuccess || per_cu < 1) { fprintf(stderr, "kernel_launch: occupancy query says %d blocks/CU\n", per_cu); g_grid = -1; (void)hipGetLastError(); return; }
    g_grid = cus;
  }
  if (g_grid < 0) return;
  const float* x = (const float*)d_in[0]; const float* norm_pre = (const float*)d_in[1]; const float* norm_post = (const float*)d_in[2];
  const float* w_in = (const float*)d_in[3]; const float* a_qn = (const float*)d_in[4]; const float* a_kn = (const float*)d_in[5];
  const float* b_qn = (const float*)d_in[6]; const float* b_kvn = (const float*)d_in[7]; const float* w_uq = (const float*)d_in[8];
  const float* w_ukv = (const float*)d_in[9]; const float* rpb = (const float*)d_in[10]; const float* w_out = (const float*)d_in[11];
  char* ws = (char*)d_ws; float* out = (float*)d_out;
  (void)hipMemsetAsync(ws + WS_CTL, 0, CTL_ZERO_BYTES, stream);
  Args a{}; for (int i = 0; i < 12; ++i) a.in[i] = (const float*)d_in[i]; a.out = out; a.ws = (unsigned char*)d_ws; a.amask = AMASK;
  launch_mk(a, 0, N_PHASES, 0, stream);
  (void)x; (void)norm_pre; (void)norm_post; (void)w_in; (void)a_qn; (void)a_kn; (void)b_qn; (void)b_kvn; (void)w_uq; (void)w_ukv; (void)rpb; (void)w_out;
}
```

```cpp
#include <hip/hip_runtime.h>
#include <cstdint>
#include <cstdio>

typedef unsigned short bf16_t;
typedef short bf16x8 __attribute__((ext_vector_type(8)));
typedef float f32x4 __attribute__((ext_vector_type(4)));
#define DEVI __device__ __forceinline__

constexpr int BATCH = 8, SEQ = 2048, DM = 2048, DEPTH = 2;
constexpr int M = BATCH * SEQ;
constexpr int DIN = 5952, NP = 6144;
constexpr int DMIX = 2048;
constexpr float EPS = 1e-6f;
constexpr int C_AQ = 0, C_AK = 1024, C_AV = 1280, C_AG = 1536, C_BCQ = 2560, C_BCKV = 3072, C_BKR = 3328, C_BG = 3584,
              C_CQ = 4096, C_CK = 4608, C_CV = 5120, C_CG = 5632;
constexpr size_t MiB = 1u << 20;
constexpr size_t WS_TAB = 1 * MiB;
constexpr size_t WS_WIN = 2 * MiB, WIN_L = 24 * MiB;
constexpr size_t WS_WOUT = 50 * MiB, WOUT_L = 8 * MiB;
constexpr size_t WS_WUQ = 66 * MiB, WUQ_L = 1 * MiB;
constexpr size_t WS_WUKV = 68 * MiB, WUKV_L = 1 * MiB;
constexpr size_t WS_XN = 70 * MiB;
constexpr size_t WS_PROJ = 134 * MiB;
constexpr size_t WS_Y = WS_PROJ;
constexpr size_t WS_QB = 326 * MiB;
constexpr size_t WS_KVB = 350 * MiB;
constexpr size_t WS_MIX = 382 * MiB;
constexpr size_t WS_X1B = 446 * MiB;
constexpr size_t WS_END = 510 * MiB;
constexpr int T_AR = 0, T_AC = 1024, T_BR = 3072, T_BC = 3584, T_N = 4608;

DEVI float bf2f(unsigned v) { return __uint_as_float(v << 16); }
DEVI unsigned f2bf(float f) { unsigned u = __float_as_uint(f); return (u + 0x7fffu + ((u >> 16) & 1u)) >> 16; }
DEVI unsigned pk2(float lo, float hi) { return f2bf(lo) | (f2bf(hi) << 16); }
DEVI float wave_sum(float v) {
#pragma unroll
  for (int o = 1; o < 64; o <<= 1) v += __shfl_xor(v, o);
  return v;
}
DEVI float wave_max(float v) {
#pragma unroll
  for (int o = 1; o < 64; o <<= 1) v = fmaxf(v, __shfl_xor(v, o));
  return v;
}

DEVI int perm128(int p) { const int a = p >> 6, j = (p & 63) >> 1, t = p & 1; return 64 * a + 32 * t + j; }
DEVI int perm64(int p) { const int a = p >> 5, j = (p & 31) >> 1, t = p & 1; return 32 * a + 16 * t + j; }
DEVI int map_col(int mode, int s) {
  if (mode == 0) return s;
  if (mode == 1) {
    if (s < 1280) return (s & ~127) + perm128(s & 127);
    if (s < 3328) return s;
    if (s < 3392) return 3328 + perm64(s - 3328);
    if (s < 3584) return -1;
    return s - 192;
  }
  if (s < 512) return (s >> 7) * 192 + (s & 127);
  const int h = (s - 512) >> 6, p = (s - 512) & 63;
  return h * 192 + 128 + perm64(p);
}

__global__ __launch_bounds__(256) void k_transpose_cvt(const float* __restrict__ src, bf16_t* __restrict__ dst, int K, int Ns, int mode) {
  __shared__ float tile[32][33];
  const int n0 = blockIdx.x * 32, k0 = blockIdx.y * 32, tx = threadIdx.x & 31, ty = threadIdx.x >> 5;
  const int so = map_col(mode, n0 + tx);
#pragma unroll
  for (int i = 0; i < 4; ++i) { const int kk = ty + 8 * i; tile[kk][tx] = so >= 0 ? src[(size_t)(k0 + kk) * Ns + so] : 0.f; }
  __syncthreads();
#pragma unroll
  for (int i = 0; i < 4; ++i) { const int nn = ty + 8 * i; dst[(size_t)(n0 + nn) * K + k0 + tx] = (bf16_t)f2bf(tile[tx][nn]); }
}

__global__ __launch_bounds__(256) void k_rope_tab(float2* tab) {
  const int i = blockIdx.x * 256 + threadIdx.x; if (i >= T_N) return;
  int pos, j; float n;
  if (i < T_AC) { pos = i >> 5; j = i & 31; n = 64.f; }
  else if (i < T_BR) { pos = (i - T_AC) >> 5; j = i & 31; n = 64.f; }
  else if (i < T_BC) { pos = (i - T_BR) >> 4; j = i & 15; n = 32.f; }
  else { pos = (i - T_BC) >> 4; j = i & 15; n = 32.f; }
  const float inv = 1.0f / powf(10000.f, (float)(2 * j) / n);
  const float ang = (float)pos * inv;
  const float k = rintf(ang * 0.15915494309189535f);
  float r = fmaf(-k, 6.28318548202514648f, ang); r = fmaf(-k, -1.74845553e-7f, r);
  tab[i] = make_float2(cosf(r), sinf(r));
}

__global__ __launch_bounds__(256) void k_rmsnorm_xn(const float* __restrict__ x, const float* __restrict__ g, bf16_t* __restrict__ xn) {
  const int row = blockIdx.x * 4 + (threadIdx.x >> 6), lane = threadIdx.x & 63;
  const float4* xr = (const float4*)(x + (size_t)row * DM) + lane;
  float4 v[8]; float ss = 0.f;
#pragma unroll
  for (int j = 0; j < 8; ++j) { v[j] = xr[64 * j]; ss += v[j].x * v[j].x + v[j].y * v[j].y + v[j].z * v[j].z + v[j].w * v[j].w; }
  const float rs = rsqrtf(wave_sum(ss) * (1.f / DM) + EPS);
  uint2* o = (uint2*)(xn + (size_t)row * DM) + lane;
#pragma unroll
  for (int j = 0; j < 8; ++j) { const float4 gg = ((const float4*)g)[lane + 64 * j];
    o[64 * j] = make_uint2(pk2(v[j].x * rs * gg.x, v[j].y * rs * gg.y), pk2(v[j].z * rs * gg.z, v[j].w * rs * gg.w)); }
}

template <bool OUT_F32>
__global__ __launch_bounds__(256) void k_gemm_naive(const bf16_t* __restrict__ A, int lda, const bf16_t* __restrict__ Bt, int ldb, void* __restrict__ C, int ldc, int K) {
  __shared__ __attribute__((aligned(16))) bf16_t sA[64 * 40];
  __shared__ __attribute__((aligned(16))) bf16_t sB[64 * 40];
  const int tid = threadIdx.x, lane = tid & 63, w = tid >> 6;
  const int m0 = blockIdx.y * 64, n0 = blockIdx.x * 64, lr = tid >> 2, lc = (tid & 3) * 8;
  f32x4 acc0 = {0, 0, 0, 0}, acc1 = acc0, acc2 = acc0, acc3 = acc0;
  for (int k0 = 0; k0 < K; k0 += 32) {
    const uint4 va = *(const uint4*)(A + (size_t)(m0 + lr) * lda + k0 + lc);
    const uint4 vb = *(const uint4*)(Bt + (size_t)(n0 + lr) * ldb + k0 + lc);
    __syncthreads();
    *(uint4*)(sA + lr * 40 + lc) = va; *(uint4*)(sB + lr * 40 + lc) = vb;
    __syncthreads();
    const bf16x8 a = *(const bf16x8*)(sA + (16 * w + (lane & 15)) * 40 + (lane >> 4) * 8);
    const bf16x8 b0 = *(const bf16x8*)(sB + (0 + (lane & 15)) * 40 + (lane >> 4) * 8);
    const bf16x8 b1 = *(const bf16x8*)(sB + (16 + (lane & 15)) * 40 + (lane >> 4) * 8);
    const bf16x8 b2 = *(const bf16x8*)(sB + (32 + (lane & 15)) * 40 + (lane >> 4) * 8);
    const bf16x8 b3 = *(const bf16x8*)(sB + (48 + (lane & 15)) * 40 + (lane >> 4) * 8);
    acc0 = __builtin_amdgcn_mfma_f32_16x16x32_bf16(a, b0, acc0, 0, 0, 0);
    acc1 = __builtin_amdgcn_mfma_f32_16x16x32_bf16(a, b1, acc1, 0, 0, 0);
    acc2 = __builtin_amdgcn_mfma_f32_16x16x32_bf16(a, b2, acc2, 0, 0, 0);
    acc3 = __builtin_amdgcn_mfma_f32_16x16x32_bf16(a, b3, acc3, 0, 0, 0);
  }
#pragma unroll
  for (int j = 0; j < 4; ++j) {
    const size_t row = m0 + 16 * w + (lane >> 4) * 4 + j; const int col = n0 + (lane & 15);
    if (OUT_F32) { float* c = (float*)C + row * ldc + col; c[0] = acc0[j]; c[16] = acc1[j]; c[32] = acc2[j]; c[48] = acc3[j]; }
    else { bf16_t* c = (bf16_t*)C + row * ldc + col; c[0] = (bf16_t)f2bf(acc0[j]); c[16] = (bf16_t)f2bf(acc1[j]); c[32] = (bf16_t)f2bf(acc2[j]); c[48] = (bf16_t)f2bf(acc3[j]); }
  }
}

__global__ __launch_bounds__(256) void k_postproj(bf16_t* __restrict__ PROJ, const float* __restrict__ a_qn, const float* __restrict__ a_kn,
                                                  const float* __restrict__ b_qn, const float* __restrict__ b_kvn, const float2* __restrict__ tab) {
  const int row = blockIdx.x * 4 + (threadIdx.x >> 6), lane = threadIdx.x & 63;
  const int t = row & (SEQ - 1), pr = t >> 6, pc = t & 63;
  bf16_t* p = PROJ + (size_t)row * NP;
  {
    const int a = lane >> 5, j = lane & 31;
    const float2 cs = a == 0 ? tab[T_AR + pr * 32 + j] : tab[T_AC + pc * 32 + j];
    const int d1 = 64 * a + j, d2 = d1 + 32;
    for (int hb = 0; hb < 10; ++hb) {
      unsigned* pp = (unsigned*)(p + hb * 128) + lane;
      const unsigned v = *pp; const float x1 = bf2f(v & 0xffffu), x2 = bf2f(v >> 16);
      const float rs = rsqrtf(wave_sum(x1 * x1 + x2 * x2) * (1.f / 128.f) + EPS);
      const float* g = hb < 8 ? a_qn : a_kn;
      const float y1 = x1 * rs * g[d1], y2 = x2 * rs * g[d2];
      *pp = pk2(y1 * cs.x - y2 * cs.y, y2 * cs.x + y1 * cs.y);
    }
  }
  {
    uint4* pp = (uint4*)(p + C_BCQ) + lane; const uint4 v = *pp; float x[8];
    x[0] = bf2f(v.x & 0xffffu); x[1] = bf2f(v.x >> 16); x[2] = bf2f(v.y & 0xffffu); x[3] = bf2f(v.y >> 16);
    x[4] = bf2f(v.z & 0xffffu); x[5] = bf2f(v.z >> 16); x[6] = bf2f(v.w & 0xffffu); x[7] = bf2f(v.w >> 16);
    float ss = 0.f;
#pragma unroll
    for (int i = 0; i < 8; ++i) ss += x[i] * x[i];
    const float rs = rsqrtf(wave_sum(ss) * (1.f / 512.f) + EPS);
    const float4 g0 = ((const float4*)b_qn)[2 * lane], g1 = ((const float4*)b_qn)[2 * lane + 1];
    *pp = make_uint4(pk2(x[0] * rs * g0.x, x[1] * rs * g0.y), pk2(x[2] * rs * g0.z, x[3] * rs * g0.w),
                     pk2(x[4] * rs * g1.x, x[5] * rs * g1.y), pk2(x[6] * rs * g1.z, x[7] * rs * g1.w));
  }
  {
    uint2* pp = (uint2*)(p + C_BCKV) + lane; const uint2 v = *pp;
    const float x0 = bf2f(v.x & 0xffffu), x1 = bf2f(v.x >> 16), x2 = bf2f(v.y & 0xffffu), x3 = bf2f(v.y >> 16);
    const float rs = rsqrtf(wave_sum(x0 * x0 + x1 * x1 + x2 * x2 + x3 * x3) * (1.f / 256.f) + EPS);
    const float4 g = ((const float4*)b_kvn)[lane];
    *pp = make_uint2(pk2(x0 * rs * g.x, x1 * rs * g.y), pk2(x2 * rs * g.z, x3 * rs * g.w));
  }
  if (lane < 32) {
    const int a = lane >> 4, j = lane & 15;
    const float2 cs = a == 0 ? tab[T_BR + pr * 16 + j] : tab[T_BC + pc * 16 + j];
    unsigned* pp = (unsigned*)(p + C_BKR) + lane; const unsigned v = *pp; const float x1 = bf2f(v & 0xffffu), x2 = bf2f(v >> 16);
    *pp = pk2(x1 * cs.x - x2 * cs.y, x2 * cs.x + x1 * cs.y);
  }
}

__global__ __launch_bounds__(256) void k_rope_qpe(bf16_t* __restrict__ QB, const float2* __restrict__ tab) {
  const int row = blockIdx.x * 4 + (threadIdx.x >> 6), lane = threadIdx.x & 63;
  const int t = row & (SEQ - 1), pr = t >> 6, pc = t & 63;
  unsigned* p = (unsigned*)(QB + (size_t)row * 768 + 512);
#pragma unroll
  for (int i = 0; i < 2; ++i) {
    const int pi = lane + 64 * i, a = (pi >> 4) & 1, j = pi & 15;
    const float2 cs = a == 0 ? tab[T_BR + pr * 16 + j] : tab[T_BC + pc * 16 + j];
    const unsigned v = p[pi]; const float x1 = bf2f(v & 0xffffu), x2 = bf2f(v >> 16);
    p[pi] = pk2(x1 * cs.x - x2 * cs.y, x2 * cs.x + x1 * cs.y);
  }
}

DEVI float dot8(const uint4 kv, const float* q) {
  return bf2f(kv.x & 0xffffu) * q[0] + bf2f(kv.x >> 16) * q[1] + bf2f(kv.y & 0xffffu) * q[2] + bf2f(kv.y >> 16) * q[3] +
         bf2f(kv.z & 0xffffu) * q[4] + bf2f(kv.z >> 16) * q[5] + bf2f(kv.w & 0xffffu) * q[6] + bf2f(kv.w >> 16) * q[7];
}
template <int TYPE>
__global__ __launch_bounds__(256) void k_attn_naive(const bf16_t* __restrict__ PROJ, const bf16_t* __restrict__ QB, const bf16_t* __restrict__ KVB,
                                                    const float* __restrict__ rpb, bf16_t* __restrict__ MIX) {
  __shared__ float qs[4][192];
  __shared__ float ps[4][2048];
  constexpr int NH = TYPE == 0 ? 8 : 4;
  const int w = threadIdx.x >> 6, lane = threadIdx.x & 63;
  const int item = blockIdx.x * 4 + w, h = item % NH, row = item / NH, b = row >> 11, t = row & 2047;
  const float scale = TYPE == 1 ? 0.07216878364870322f : 0.08838834764831845f;
  if (TYPE == 0) { for (int d = lane; d < 128; d += 64) qs[w][d] = bf2f(PROJ[(size_t)row * NP + C_AQ + h * 128 + d]); }
  else if (TYPE == 2) { for (int d = lane; d < 128; d += 64) qs[w][d] = bf2f(PROJ[(size_t)row * NP + C_CQ + h * 128 + d]); }
  else { for (int d = lane; d < 128; d += 64) qs[w][d] = bf2f(QB[(size_t)row * 768 + h * 128 + d]); qs[w][128 + lane] = bf2f(QB[(size_t)row * 768 + 512 + h * 64 + lane]); }
  __syncthreads();
  const int r = t >> 6, c = t & 63;
  const int r0 = min(max(r - 4, 0), 24), c0 = min(max(c - 8, 0), 48);
  constexpr int NK = TYPE == 2 ? 128 : 2048;
  float lmax = -3.0e38f;
  for (int i = 0; i < NK / 64; ++i) {
    const int n = lane + 64 * i; int j; float bias = 0.f;
    if (TYPE == 2) { const int kr = r0 + (n >> 4), kc = c0 + (n & 15); j = kr * 64 + kc; bias = rpb[(h * 15 + (kr - r + 7)) * 31 + (kc - c + 15)]; } else j = n;
    const size_t krow = (size_t)b * 2048 + j;
    const bf16_t* kp = TYPE == 0 ? PROJ + krow * NP + C_AK + (h >> 2) * 128 : TYPE == 2 ? PROJ + krow * NP + C_CK + h * 128 : KVB + krow * 1024 + h * 256;
    float acc = 0.f;
#pragma unroll
    for (int d = 0; d < 128; d += 8) acc += dot8(*(const uint4*)(kp + d), &qs[w][d]);
    if (TYPE == 1) { const bf16_t* kp2 = PROJ + krow * NP + C_BKR;
#pragma unroll
      for (int d = 0; d < 64; d += 8) acc += dot8(*(const uint4*)(kp2 + d), &qs[w][128 + d]); }
    const float s = acc * scale + bias;
    ps[w][n] = s; lmax = fmaxf(lmax, s);
  }
  const float mx = wave_max(lmax);
  float lsum = 0.f;
  for (int i = 0; i < NK / 64; ++i) { const int n = lane + 64 * i; const float p = __expf(ps[w][n] - mx); ps[w][n] = p; lsum += p; }
  const float l = wave_sum(lsum);
  __syncthreads();
  float o0 = 0.f, o1 = 0.f;
  for (int n = 0; n < NK; ++n) {
    int j; if (TYPE == 2) j = (r0 + (n >> 4)) * 64 + c0 + (n & 15); else j = n;
    const size_t krow = (size_t)b * 2048 + j;
    const bf16_t* vp = TYPE == 0 ? PROJ + krow * NP + C_AV + (h >> 2) * 128 : TYPE == 2 ? PROJ + krow * NP + C_CV + h * 128 : KVB + krow * 1024 + h * 256 + 128;
    const unsigned v = ((const unsigned*)vp)[lane]; const float p = ps[w][n];
    o0 += p * bf2f(v & 0xffffu); o1 += p * bf2f(v >> 16);
  }
  const int gcol = (TYPE == 0 ? C_AG : TYPE == 1 ? C_BG : C_CG) + h * 128, mcol = (TYPE == 0 ? 0 : TYPE == 1 ? 1024 : 1536) + h * 128;
  const unsigned gv = ((const unsigned*)(PROJ + (size_t)row * NP + gcol))[lane];
  const float g0 = bf2f(gv & 0xffffu), g1 = bf2f(gv >> 16), il = 1.f / l;
  ((unsigned*)(MIX + (size_t)row * DMIX + mcol))[lane] = pk2(o0 * il * (g0 / (1.f + __expf(-g0))), o1 * il * (g1 / (1.f + __expf(-g1))));
}

__global__ __launch_bounds__(256) void k_rowpass(const float* __restrict__ Y, const float* resid, const float* __restrict__ g_post, float* out,
                                                 const float* __restrict__ g_next, bf16_t* __restrict__ xn) {
  const int row = blockIdx.x * 4 + (threadIdx.x >> 6), lane = threadIdx.x & 63;
  const float4* yr = (const float4*)(Y + (size_t)row * DM) + lane; const float4* xr = (const float4*)(resid + (size_t)row * DM) + lane;
  float4 v[8]; float ss = 0.f;
#pragma unroll
  for (int j = 0; j < 8; ++j) { v[j] = yr[64 * j]; ss += v[j].x * v[j].x + v[j].y * v[j].y + v[j].z * v[j].z + v[j].w * v[j].w; }
  const float rs = rsqrtf(wave_sum(ss) * (1.f / DM) + EPS);
  float4* orow = (float4*)(out + (size_t)row * DM) + lane; float s2 = 0.f;
#pragma unroll
  for (int j = 0; j < 8; ++j) { const float4 gg = ((const float4*)g_post)[lane + 64 * j]; const float4 xx = xr[64 * j];
    v[j].x = xx.x + v[j].x * rs * gg.x; v[j].y = xx.y + v[j].y * rs * gg.y; v[j].z = xx.z + v[j].z * rs * gg.z; v[j].w = xx.w + v[j].w * rs * gg.w;
    orow[64 * j] = v[j]; s2 += v[j].x * v[j].x + v[j].y * v[j].y + v[j].z * v[j].z + v[j].w * v[j].w; }
  if (g_next) {
    const float r2 = rsqrtf(wave_sum(s2) * (1.f / DM) + EPS);
    uint2* o = (uint2*)(xn + (size_t)row * DM) + lane;
#pragma unroll
    for (int j = 0; j < 8; ++j) { const float4 gg = ((const float4*)g_next)[lane + 64 * j];
      o[64 * j] = make_uint2(pk2(v[j].x * r2 * gg.x, v[j].y * r2 * gg.y), pk2(v[j].z * r2 * gg.z, v[j].w * r2 * gg.w)); }
  }
}

namespace pg8 {
#define PG8_LAS __attribute__((address_space(3)))
typedef unsigned u32x4 __attribute__((ext_vector_type(4)));
constexpr int BM = 256, BK = 64, HALF = 128, HTB = HALF * BK * 2, STAGE_BYTES = 8 * HTB, NXCD = 8, WGM = 8;
__host__ __device__ __forceinline__ int lds_byte(int r, int c) { const int st = (r >> 4) * 2 + (c >> 5), rr = r & 15, cc = c & 31, ob = rr * 64 + cc * 2; return st * 1024 + (ob ^ (((ob >> 9) & 1) << 5)); }
__host__ __device__ __forceinline__ void stage_rc(int b, int& R, int& C) { const int st = b / 1024, sb = b % 1024, swz = sb ^ (((sb >> 9) & 1) << 5); R = (st >> 1) * 16 + swz / 64; C = (st & 1) * 32 + (swz % 64) / 2; }
__host__ __device__ __forceinline__ int perm32(int rho) { const int n = rho >> 4, i = rho & 15; return 8 * (i >> 2) + 4 * n + (i & 3); }
struct Unit { int pm, pn, slot; };
struct Gemm { const bf16_t* A; const bf16_t* Bt; };
struct StaticOrder {
    int nM, nN, nwg, G, c;
    __host__ __device__ void init(int M, int N, int G_, int c_) { nM = M / BM; nN = N / BM; nwg = nM * nN; G = G_; c = c_; }
    __host__ __device__ bool next(int i, Unit& u) const {
        const long L = (long)i * G + c; if (L >= nwg) return false;
        int wgid = (int)L; { const int q = nwg / NXCD, r = nwg % NXCD, xcd = wgid % NXCD, off = wgid / NXCD; wgid = (xcd < r ? xcd * (q + 1) : r * (q + 1) + (xcd - r) * q) + off; }
        const int nig = WGM * nN, gid = wgid / nig, fm = gid * WGM, gsz = (nM - fm) < WGM ? (nM - fm) : WGM;
        u.pm = fm + ((wgid % nig) % gsz); u.pn = (wgid % nig) / gsz; u.slot = i & 1; return true;
    }
    __device__ __forceinline__ void a_ready(const Unit&) const {}
    __device__ __forceinline__ void done(const Unit&) const {}
};
__device__ __forceinline__ unsigned cvt_pk_bf16(float lo, float hi) { unsigned r; asm volatile("v_cvt_pk_bf16_f32 %0, %1, %2" : "=v"(r) : "v"(lo), "v"(hi)); return r; }
struct EpiF32 {
    static constexpr bool PERM = false, AFTER_DRAIN = false;
    float* C; int ldc;
    __device__ __forceinline__ void operator()(const f32x4 (&acc)[2][2][4][2], const Unit& u, int wr, int wc, int fr, int fq) const {
        const int row0 = u.pm * BM + wr * 64 + fr, col0 = u.pn * BM + wc * 32 + 4 * fq;
#pragma unroll
        for (int ai = 0; ai < 2; ++ai)
#pragma unroll
            for (int m = 0; m < 4; ++m) { float* rowp = C + (size_t)(row0 + ai * HALF + m * 16) * ldc + col0;
#pragma unroll
                for (int bj = 0; bj < 2; ++bj)
#pragma unroll
                    for (int n = 0; n < 2; ++n) *(f32x4*)(rowp + bj * HALF + n * 16) = acc[ai][bj][m][n]; }
    }
};
struct EpiNone {
    static constexpr bool PERM = true, AFTER_DRAIN = false;
    __device__ __forceinline__ void operator()(const f32x4 (&acc)[2][2][4][2], const Unit&, int, int, int, int) const {
#pragma unroll
        for (int ai = 0; ai < 2; ++ai)
#pragma unroll
            for (int bj = 0; bj < 2; ++bj)
#pragma unroll
                for (int m = 0; m < 4; ++m)
#pragma unroll
                    for (int n = 0; n < 2; ++n) asm volatile("" :: "v"(acc[ai][bj][m][n]));
    }
};
struct EpiBf16 {
    static constexpr bool PERM = true, AFTER_DRAIN = false;
    bf16_t* O; int ldc; int sc_lo, sc_hi; float sc;
    __device__ __forceinline__ void operator()(const f32x4 (&acc)[2][2][4][2], const Unit& u, int wr, int wc, int fr, int fq) const {
        const int row0 = u.pm * BM + wr * 64 + fr, col0 = u.pn * BM + wc * 32 + 8 * fq;
        const float s_ = (u.pn >= sc_lo && u.pn < sc_hi) ? sc : 1.f;
#pragma unroll
        for (int ai = 0; ai < 2; ++ai)
#pragma unroll
            for (int m = 0; m < 4; ++m) { bf16_t* rowp = O + (size_t)(row0 + ai * HALF + m * 16) * ldc + col0;
#pragma unroll
                for (int bj = 0; bj < 2; ++bj) { const f32x4 v0 = acc[ai][bj][m][0] * s_, v1 = acc[ai][bj][m][1] * s_;
                    u32x4 w; w.x = cvt_pk_bf16(v0[0], v0[1]); w.y = cvt_pk_bf16(v0[2], v0[3]); w.z = cvt_pk_bf16(v1[0], v1[1]); w.w = cvt_pk_bf16(v1[2], v1[3]);
                    *(u32x4*)(rowp + bj * HALF) = w; } }
    }
};

template <int KW, int LDA> struct RsOrder : StaticOrder {
    const bf16_t* A; PG8_LAS float* tab;
    __device__ __forceinline__ void a_ready(const Unit& u) const {
        int l_ = threadIdx.x; asm volatile("" : "+v"(l_));
        const int lane = l_ & 63, wid = l_ >> 6, rr = lane >> 4, c = lane & 15;
        constexpr int NV = KW / 16 / 8;
        const bf16_t* base = A + (size_t)(u.pm * BM + wid * 32 + rr) * LDA + c * (KW / 16);
#pragma unroll 2
        for (int i = 0; i < 8; ++i) {
            float ss = 0.f;
#pragma unroll
            for (int v = 0; v < NV; ++v) { const u32x4 x = *(const u32x4*)(base + (size_t)(4 * i) * LDA + v * 8);
#pragma unroll
                for (int e = 0; e < 4; ++e) { const float a = __uint_as_float(x[e] << 16), b = __uint_as_float(x[e] & 0xffff0000u); ss += a * a + b * b; } }
            ss += __shfl_xor(ss, 1); ss += __shfl_xor(ss, 2); ss += __shfl_xor(ss, 4); ss += __shfl_xor(ss, 8);
            if (c == 0) tab[u.slot * 256 + wid * 32 + 4 * i + rr] = rsqrtf(ss * (1.f / KW) + 1e-6f);
        }
    }
};
template <int ROPE_PN> struct EpiBf16Rs {
    static constexpr bool PERM = true, AFTER_DRAIN = false;
    bf16_t* O; int ldc; const PG8_LAS float* rst; const float2* tab_r; const float2* tab_c; float gsc;
    __device__ __forceinline__ void operator()(const f32x4 (&acc)[2][2][4][2], const Unit& u, int wr, int wc, int fr, int fq) const {
        const int row0 = u.pm * BM + wr * 64 + fr, col0 = u.pn * BM + wc * 32 + 8 * fq;
        const bool rope = (ROPE_PN >= 0) && (u.pn == ROPE_PN);
#pragma unroll
        for (int ai = 0; ai < 2; ++ai)
#pragma unroll
            for (int m = 0; m < 4; ++m) { const int row = row0 + ai * HALF + m * 16; bf16_t* rowp = O + (size_t)row * ldc + col0;
                const float rs = rst[u.slot * 256 + ai * HALF + wr * 64 + m * 16 + fr] * gsc;
                f32x4 c01 = {1.f, 0.f, 1.f, 0.f}, c23 = c01;
                if (rope) { const int t = row & 2047; const float2* tp = (wc & 1) ? tab_c + (t & 63) * 16 + 4 * fq : tab_r + (t >> 6) * 16 + 4 * fq;
                    c01 = *(const f32x4*)tp; c23 = *(const f32x4*)(tp + 2); }
#pragma unroll
                for (int bj = 0; bj < 2; ++bj) { f32x4 v0 = acc[ai][bj][m][0] * rs, v1 = acc[ai][bj][m][1] * rs;
                    if (rope) { const f32x4 a0 = v0, a1 = v1;
                        v0[0] = a0[0] * c01[0] - a0[1] * c01[1]; v0[1] = a0[1] * c01[0] + a0[0] * c01[1]; v0[2] = a0[2] * c01[2] - a0[3] * c01[3]; v0[3] = a0[3] * c01[2] + a0[2] * c01[3];
                        v1[0] = a1[0] * c23[0] - a1[1] * c23[1]; v1[1] = a1[1] * c23[0] + a1[0] * c23[1]; v1[2] = a1[2] * c23[2] - a1[3] * c23[3]; v1[3] = a1[3] * c23[2] + a1[2] * c23[3]; }
                    u32x4 w; w.x = cvt_pk_bf16(v0[0], v0[1]); w.y = cvt_pk_bf16(v0[2], v0[3]); w.z = cvt_pk_bf16(v1[0], v1[1]); w.w = cvt_pk_bf16(v1[2], v1[3]);
                    *(u32x4*)(rowp + bj * HALF) = w; } }
    }
};

template <int K, int LDA, int LDB, class Epi, class Sched, bool ALIGN_EPI = false, bool SP2 = false>
__device__ __forceinline__ void gemm_phase(PG8_LAS unsigned char* lds, const Gemm g, const Sched& S, const Epi& E) {
    int tid_ = threadIdx.x; asm volatile("" : "+v"(tid_));
    const int tid = tid_, wid = __builtin_amdgcn_readfirstlane(tid >> 6), lane = tid & 63, wr = wid >> 2, wc = wid & 3, fr = lane & 15, fq = lane >> 4;
    constexpr int nt = K / BK;
    unsigned voffA[2], voffB[2];
#pragma unroll
    for (int i = 0; i < 2; ++i) { int R, C; stage_rc(tid * 16 + i * 8192, R, C); const int Rb = Epi::PERM ? ((R & ~31) + perm32(R & 31)) : R;
        voffA[i] = (unsigned)(R * LDA + C) * 2u; voffB[i] = (unsigned)(Rb * LDB + C) * 2u; }
    constexpr size_t kstep = (size_t)(BK * 2);
    constexpr size_t hsA = (size_t)HALF * LDA * 2, hsB = (size_t)HALF * LDB * 2;
    constexpr size_t tsA = 2 * hsA, tsB = 2 * hsB;
    const unsigned ldsw = (unsigned)wid * 1024u;
    const int aoff = lds_byte(wr * 64 + fr, fq * 8), boff = lds_byte(wc * 32 + fr, fq * 8);
#define PG8_SA(b, h) (((b) * 2 + (h)) * HTB)
#define PG8_SB(b, h) ((4 + (b) * 2 + (h)) * HTB)
#define PG8_STAGE(bufoff, gbase, voff) do { _Pragma("unroll") for (int _i = 0; _i < 2; ++_i) \
        __builtin_amdgcn_global_load_lds((const unsigned*)((const char*)(gbase) + (voff)[_i]), (PG8_LAS unsigned*)(lds + (bufoff) + ldsw + _i * 8192), 16, 0, 0); } while (0)
#define PG8_LDA(dst, b, h) do { _Pragma("unroll") for (int m = 0; m < 4; ++m) _Pragma("unroll") for (int k = 0; k < 2; ++k) dst[m][k] = *(const PG8_LAS bf16x8*)(lds + PG8_SA(b, h) + aoff + m * 2048 + k * 1024); } while (0)
#define PG8_LDB(dst, b, h) do { _Pragma("unroll") for (int n = 0; n < 2; ++n) _Pragma("unroll") for (int k = 0; k < 2; ++k) dst[n][k] = *(const PG8_LAS bf16x8*)(lds + PG8_SB(b, h) + boff + n * 2048 + k * 1024); } while (0)
#define PG8_MMA(ai, bj, At, Bt) do { __builtin_amdgcn_s_setprio(1); _Pragma("unroll") for (int m = 0; m < 4; ++m) _Pragma("unroll") for (int n = 0; n < 2; ++n) _Pragma("unroll") for (int k = 0; k < 2; ++k) \
        acc[ai][bj][m][n] = __builtin_amdgcn_mfma_f32_16x16x32_bf16(Bt[n][k], At[m][k], acc[ai][bj][m][n], 0, 0, 0); __builtin_amdgcn_s_setprio(0); } while (0)
#define PG8_WAIT_V(n) asm volatile("s_waitcnt vmcnt(" #n ")" ::: "memory")
#define PG8_WAIT_L(n) asm volatile("s_waitcnt lgkmcnt(" #n ")" ::: "memory")
#define PG8_BAR __builtin_amdgcn_s_barrier()
#define PG8_SCHED __builtin_amdgcn_sched_barrier(0)
    Unit cur, nxt; int ui = 0;
    if (!S.next(0, cur)) return;
    f32x4 acc[2][2][4][2];
#pragma unroll
    for (int a = 0; a < 2; ++a)
#pragma unroll
        for (int b = 0; b < 2; ++b)
#pragma unroll
            for (int m = 0; m < 4; ++m)
#pragma unroll
                for (int n = 0; n < 2; ++n) acc[a][b][m][n] = (f32x4){0.f, 0.f, 0.f, 0.f};
    bf16x8 At[4][2], B0[2][2], B1[2][2];
    const char* cA = (const char*)g.A + (size_t)cur.pm * tsA; const char* cB = (const char*)g.Bt + (size_t)cur.pn * tsB;
    S.a_ready(cur);
    if constexpr (SP2) {
        PG8_STAGE(PG8_SB(0, 0), cB, voffB); PG8_STAGE(PG8_SB(0, 1), cB + hsB, voffB); PG8_STAGE(PG8_SA(0, 0), cA, voffA); PG8_STAGE(PG8_SA(0, 1), cA + hsA, voffA);
        if (wr == 1) PG8_BAR;
        PG8_WAIT_V(2); PG8_BAR;
        PG8_STAGE(PG8_SB(1, 0), cB + kstep, voffB); PG8_STAGE(PG8_SA(1, 0), cA + kstep, voffA); PG8_STAGE(PG8_SB(1, 1), cB + hsB + kstep, voffB);
        PG8_WAIT_V(6); PG8_BAR;
    } else {
        PG8_STAGE(PG8_SB(0, 0), cB, voffB); PG8_STAGE(PG8_SA(0, 0), cA, voffA); PG8_STAGE(PG8_SB(0, 1), cB + hsB, voffB); PG8_STAGE(PG8_SA(0, 1), cA + hsA, voffA);
        if (wr == 1) PG8_BAR;
        PG8_WAIT_V(4); PG8_BAR;
        PG8_STAGE(PG8_SB(1, 0), cB + kstep, voffB); PG8_STAGE(PG8_SA(1, 0), cA + kstep, voffA); PG8_STAGE(PG8_SB(1, 1), cB + hsB + kstep, voffB);
        PG8_WAIT_V(6); PG8_BAR;
    }
    for (;;) {
        const bool has_next = S.next(ui + 1, nxt);
        const char* nA = has_next ? (const char*)g.A + (size_t)nxt.pm * tsA : cA; const char* nB = has_next ? (const char*)g.Bt + (size_t)nxt.pn * tsB : cB;
#pragma unroll 1
        for (int t = 0; t < nt; t += 2) {
            const bool last = (t == nt - 2);
            const char* a1 = cA + (size_t)(t + 1) * kstep;
            const char* a2 = last ? nA : cA + (size_t)(t + 2) * kstep; const char* b2 = last ? nB : cB + (size_t)(t + 2) * kstep;
            const char* a3 = a2 + kstep; const char* b3 = b2 + kstep;
            if (last && has_next) S.a_ready(nxt);
            if constexpr (SP2) {
            PG8_LDB(B0, 0, 0); PG8_LDB(B1, 0, 1); PG8_SCHED; PG8_LDA(At, 0, 0); PG8_STAGE(PG8_SA(1, 1), a1 + hsA, voffA);
            PG8_WAIT_V(8); PG8_WAIT_L(0); PG8_BAR; PG8_MMA(0, 0, At, B0); PG8_MMA(0, 1, At, B1); PG8_BAR; PG8_SCHED;
            PG8_LDA(At, 0, 1); PG8_STAGE(PG8_SB(0, 0), b2, voffB); PG8_STAGE(PG8_SB(0, 1), b2 + hsB, voffB); PG8_STAGE(PG8_SA(0, 0), a2, voffA);
            PG8_WAIT_V(8); PG8_WAIT_L(0); PG8_BAR; PG8_MMA(1, 0, At, B0); PG8_MMA(1, 1, At, B1); PG8_BAR; PG8_SCHED;
            PG8_LDB(B0, 1, 0); PG8_LDB(B1, 1, 1); PG8_SCHED; PG8_LDA(At, 1, 0); PG8_STAGE(PG8_SA(0, 1), a2 + hsA, voffA);
            PG8_WAIT_V(8); PG8_WAIT_L(0); PG8_BAR; PG8_MMA(0, 0, At, B0); PG8_MMA(0, 1, At, B1); PG8_BAR; PG8_SCHED;
            PG8_LDA(At, 1, 1); PG8_STAGE(PG8_SB(1, 0), b3, voffB); PG8_STAGE(PG8_SB(1, 1), b3 + hsB, voffB); PG8_STAGE(PG8_SA(1, 0), a3, voffA);
            PG8_WAIT_V(8); PG8_WAIT_L(0); PG8_BAR; PG8_MMA(1, 0, At, B0); PG8_MMA(1, 1, At, B1); PG8_BAR; PG8_SCHED;
            } else {
            PG8_LDB(B0, 0, 0); PG8_SCHED; PG8_LDA(At, 0, 0); PG8_STAGE(PG8_SA(1, 1), a1 + hsA, voffA);
            PG8_WAIT_L(8); PG8_BAR; PG8_WAIT_L(0); PG8_MMA(0, 0, At, B0); PG8_BAR; PG8_SCHED;
            PG8_LDB(B1, 0, 1); PG8_STAGE(PG8_SB(0, 0), b2, voffB);
            PG8_BAR; PG8_WAIT_L(0); PG8_MMA(0, 1, At, B1); PG8_BAR;
            PG8_LDA(At, 0, 1); PG8_STAGE(PG8_SA(0, 0), a2, voffA);
            PG8_BAR; PG8_WAIT_L(0); PG8_MMA(1, 0, At, B0); PG8_BAR; PG8_SCHED;
            PG8_STAGE(PG8_SB(0, 1), b2 + hsB, voffB);
            PG8_WAIT_V(6); PG8_BAR; PG8_MMA(1, 1, At, B1); PG8_BAR;
            PG8_LDB(B0, 1, 0); PG8_SCHED; PG8_LDA(At, 1, 0); PG8_STAGE(PG8_SA(0, 1), a2 + hsA, voffA);
            PG8_WAIT_L(8); PG8_BAR; PG8_WAIT_L(0); PG8_MMA(0, 0, At, B0); PG8_BAR; PG8_SCHED;
            PG8_LDB(B1, 1, 1); PG8_STAGE(PG8_SB(1, 0), b3, voffB);
            PG8_BAR; PG8_WAIT_L(0); PG8_MMA(0, 1, At, B1); PG8_BAR;
            PG8_LDA(At, 1, 1); PG8_STAGE(PG8_SA(1, 0), a3, voffA);
            PG8_BAR; PG8_WAIT_L(0); PG8_MMA(1, 0, At, B0); PG8_BAR; PG8_SCHED;
            PG8_STAGE(PG8_SB(1, 1), b3 + hsB, voffB);
            PG8_WAIT_V(6); PG8_BAR; PG8_MMA(1, 1, At, B1); PG8_BAR;
            }
        }
        if constexpr (ALIGN_EPI) { if (wr == 0) PG8_BAR; }
        if constexpr (!Epi::AFTER_DRAIN) { E(acc, cur, wr, wc, fr, fq); S.done(cur); }
        if (!has_next) break;
#pragma unroll
        for (int a = 0; a < 2; ++a)
#pragma unroll
            for (int b = 0; b < 2; ++b)
#pragma unroll
                for (int m = 0; m < 4; ++m)
#pragma unroll
                    for (int n = 0; n < 2; ++n) acc[a][b][m][n] = (f32x4){0.f, 0.f, 0.f, 0.f};
        cur = nxt; cA = nA; cB = nB; ++ui;
        if constexpr (ALIGN_EPI) { if (wr == 1) PG8_BAR; }
    }
    PG8_WAIT_V(0);
    if constexpr (!ALIGN_EPI) { if (wr == 0) PG8_BAR; }
    PG8_BAR;
    if constexpr (Epi::AFTER_DRAIN) { E.fused(acc, cur, wr, wc, fr, fq, lds, wid, lane); S.done(cur); }
#undef PG8_SA
#undef PG8_SB
#undef PG8_STAGE
#undef PG8_LDA
#undef PG8_LDB
#undef PG8_MMA
#undef PG8_WAIT_V
#undef PG8_WAIT_L
#undef PG8_BAR
#undef PG8_SCHED
}
}
#ifndef LAS
#define LAS __attribute__((address_space(3)))
#endif
namespace att {
using f32x16 = __attribute__((ext_vector_type(16))) float;
using s16x4  = __attribute__((ext_vector_type(4))) short;
using u32x4  = __attribute__((ext_vector_type(4))) unsigned;
constexpr int NW = 8, QBLK = 32, KVBLK = 64;
constexpr int SHM_V = 16384, SHM_K = 16384, SHM_P = 8192;
constexpr int OFF_V = 0, OFF_K = 2 * SHM_V, OFF_P = OFF_K + 2 * SHM_K, OFF_WS = OFF_P + 2 * SHM_P, OFF_BIAS = OFF_WS + NW * 64 * 4, OFF_QPE = OFF_BIAS + 2048, LDS_ATT = OFF_QPE + NW * 4096;
constexpr float THR = 8.f;
#define KSWZ(row, colB) ((row) * 256 + ((colB) ^ (((row) & 7) << 4)))
#define PSWZ(row, colB) ((row) * 128 + ((colB) ^ ((((row) >> 1) & 7) << 4)))
#define SBAR() __builtin_amdgcn_sched_barrier(0)
DEVI int crow(int r, int hi) { return (r & 3) + 8 * (r >> 2) + 4 * hi; }
DEVI unsigned cvtpk(float lo, float hi) { unsigned r; asm volatile("v_cvt_pk_bf16_f32 %0, %1, %2" : "=v"(r) : "v"(lo), "v"(hi)); return r; }

DEVI void partialSM2(f32x16& p0, f32x16& p1, float& mhat, f32x16& negm, float& alpha, bool first) {
  constexpr float THRL = 10.f;
  float pmax = p0[0];
#pragma unroll
  for (int r = 1; r < 16; ++r) pmax = fmaxf(pmax, p0[r]);
#pragma unroll
  for (int r = 0; r < 16; ++r) pmax = fmaxf(pmax, p1[r]);
  { auto rr = __builtin_amdgcn_permlane32_swap(__float_as_uint(pmax), __float_as_uint(pmax), false, false);
    pmax = fmaxf(__uint_as_float(rr[0]), __uint_as_float(rr[1])); }
  alpha = 1.f;
  if (__builtin_expect(first || __any(pmax > THRL), 0)) {
    const float dl = first ? pmax : fmaxf(pmax, 0.f);
    mhat += dl;
#pragma unroll
    for (int r = 0; r < 16; ++r) { p0[r] -= dl; p1[r] -= dl; }
#pragma unroll
    for (int r = 0; r < 16; ++r) negm[r] = -mhat;
    asm volatile("" : "+v"(negm));
    alpha = first ? 1.f : __builtin_amdgcn_exp2f(-dl);
  }
#pragma unroll
  for (int r = 0; r < 16; ++r) p0[r] = __builtin_amdgcn_exp2f(p0[r]);
}
template <int TYPE> DEVI void partialSM(f32x16& p0, f32x16& p1, float& m_reg, float& mn, float& alpha) {
  constexpr float SCALE = TYPE == 1 ? 0.07216878364870322f : 0.08838834764831845f;
  constexpr float C = SCALE * 1.4426950408889634f;
  float pmax = p0[0];
#pragma unroll
  for (int r = 1; r < 16; ++r) pmax = fmaxf(pmax, p0[r]);
#pragma unroll
  for (int r = 0; r < 16; ++r) pmax = fmaxf(pmax, p1[r]);
  { auto rr = __builtin_amdgcn_permlane32_swap(__float_as_uint(pmax), __float_as_uint(pmax), false, false);
    pmax = fmaxf(__uint_as_float(rr[0]), __uint_as_float(rr[1])); }
  if (__builtin_expect(__all(pmax - m_reg <= THR / SCALE), 1)) { mn = m_reg; alpha = 1.f; }
  else { mn = fmaxf(m_reg, pmax); alpha = __builtin_amdgcn_exp2f((m_reg - mn) * C); m_reg = mn; }
  const float mnC = -mn * C;
#pragma unroll
  for (int r = 0; r < 16; ++r) p0[r] = fmaf(p0[r], C, mnC);
#pragma unroll
  for (int r = 0; r < 16; ++r) p1[r] = fmaf(p1[r], C, mnC);
#pragma unroll
  for (int r = 0; r < 16; ++r) p0[r] = __builtin_amdgcn_exp2f(p0[r]);
}
DEVI void finishSM(f32x16& p0, f32x16& p1, float alpha, float& l_reg, bf16x8& pa0, bf16x8& pa1, bf16x8& pa2, bf16x8& pa3) {
#pragma unroll
  for (int r = 0; r < 16; ++r) p1[r] = __builtin_amdgcn_exp2f(p1[r]);
  float ps = 0;
#pragma unroll
  for (int r = 0; r < 16; ++r) ps += p0[r];
#pragma unroll
  for (int r = 0; r < 16; ++r) ps += p1[r];
  { auto rr = __builtin_amdgcn_permlane32_swap(__float_as_uint(ps), __float_as_uint(ps), false, false);
    ps = __uint_as_float(rr[0]) + __uint_as_float(rr[1]); }
  l_reg = l_reg * alpha + ps;
#define PK4(P, BASE, OUT) do { unsigned a0 = cvtpk(P[BASE + 0], P[BASE + 1]), a1 = cvtpk(P[BASE + 2], P[BASE + 3]);   \
    unsigned b0 = cvtpk(P[BASE + 4], P[BASE + 5]), b1 = cvtpk(P[BASE + 6], P[BASE + 7]);                              \
    auto r0 = __builtin_amdgcn_permlane32_swap(a0, b0, false, false); auto r1 = __builtin_amdgcn_permlane32_swap(a1, b1, false, false); \
    u32x4 w = {r0[0], r1[0], r0[1], r1[1]}; OUT = *reinterpret_cast<bf16x8*>(&w); } while (0)
  PK4(p0, 0, pa0); PK4(p0, 8, pa1); PK4(p1, 0, pa2); PK4(p1, 8, pa3);
#undef PK4
}
template <int TYPE> DEVI void qkt(f32x16& p0, f32x16& p1, const char* Ks, const char* Ps, const bf16x8* qr, const char* Qe, const f32x16& negm, int r32, int hi) {
  if constexpr (TYPE == 1) { p0 = f32x16{}; p1 = f32x16{}; } else { p0 = negm; p1 = negm; }
#pragma unroll
  for (int d0 = 0; d0 < 8; ++d0) { const int cb = (d0 * 16 + hi * 8) * 2;
    const bf16x8 b0 = *reinterpret_cast<const bf16x8*>(Ks + KSWZ(r32, cb));
    const bf16x8 b1 = *reinterpret_cast<const bf16x8*>(Ks + KSWZ(32 + r32, cb));
    p0 = __builtin_amdgcn_mfma_f32_32x32x16_bf16(b0, qr[d0], p0, 0, 0, 0);
    p1 = __builtin_amdgcn_mfma_f32_32x32x16_bf16(b1, qr[d0], p1, 0, 0, 0); }
  if constexpr (TYPE == 1) {
#pragma unroll
    for (int d0 = 0; d0 < 4; ++d0) { const int cb = (d0 * 16 + hi * 8) * 2;
      const bf16x8 b0 = *reinterpret_cast<const bf16x8*>(Ps + PSWZ(r32, cb));
      const bf16x8 b1 = *reinterpret_cast<const bf16x8*>(Ps + PSWZ(32 + r32, cb));
      const bf16x8 qe = *reinterpret_cast<const bf16x8*>(Qe + PSWZ(r32, cb));
      p0 = __builtin_amdgcn_mfma_f32_32x32x16_bf16(b0, qe, p0, 0, 0, 0);
      p1 = __builtin_amdgcn_mfma_f32_32x32x16_bf16(b1, qe, p1, 0, 0, 0); }
  }
}
DEVI int v_st(int k, int c) { const int kk = (k & ~0xC) | ((k & 4) << 1) | ((k & 8) >> 1); return ((kk >> 3) * 4 + (c >> 5)) * 512 + ((kk & 7) * 32 + (c & 31)) * 2; }
DEVI int v_rd_base(int lane) { return ((lane & 3) << 3) | (((lane >> 2) & 3) << 6) | (((lane >> 4) & 1) << 5) | (((lane >> 5) & 1) << 8); }
constexpr int v_rd_off(int d0, int ks, int half) { return d0 * 512 + ks * 4096 + half * 2048; }
template <int OFF> DEVI s16x4 tr_read(int vb) { s16x4 r; asm volatile("ds_read_b64_tr_b16 %0, %1 offset:%2" : "=&v"(r) : "v"(vb), "i"(OFF) : "memory"); return r; }
template <int D0> DEVI void pv_one(f32x16& od, int vb, bf16x8 pa0, bf16x8 pa1, bf16x8 pa2, bf16x8 pa3) {
  const s16x4 l0 = tr_read<v_rd_off(D0, 0, 0)>(vb), h0 = tr_read<v_rd_off(D0, 0, 1)>(vb), l1 = tr_read<v_rd_off(D0, 1, 0)>(vb), h1 = tr_read<v_rd_off(D0, 1, 1)>(vb);
  const s16x4 l2 = tr_read<v_rd_off(D0, 2, 0)>(vb), h2 = tr_read<v_rd_off(D0, 2, 1)>(vb), l3 = tr_read<v_rd_off(D0, 3, 0)>(vb), h3 = tr_read<v_rd_off(D0, 3, 1)>(vb);
  asm volatile("s_waitcnt lgkmcnt(0)" ::: "memory"); SBAR();
#define PK(L, H) (bf16x8){L[0], L[1], L[2], L[3], H[0], H[1], H[2], H[3]}
  od = __builtin_amdgcn_mfma_f32_32x32x16_bf16(pa0, PK(l0, h0), od, 0, 0, 0);
  od = __builtin_amdgcn_mfma_f32_32x32x16_bf16(pa1, PK(l1, h1), od, 0, 0, 0);
  od = __builtin_amdgcn_mfma_f32_32x32x16_bf16(pa2, PK(l2, h2), od, 0, 0, 0);
  od = __builtin_amdgcn_mfma_f32_32x32x16_bf16(pa3, PK(l3, h3), od, 0, 0, 0);
#undef PK
}
DEVI void pv_d0(f32x16* o, int vb, bf16x8 pa0, bf16x8 pa1, bf16x8 pa2, bf16x8 pa3) {
  pv_one<0>(o[0], vb, pa0, pa1, pa2, pa3); pv_one<1>(o[1], vb, pa0, pa1, pa2, pa3); pv_one<2>(o[2], vb, pa0, pa1, pa2, pa3); pv_one<3>(o[3], vb, pa0, pa1, pa2, pa3);
}
DEVI void nb_mask(f32x16& p0, f32x16& p1, int kr, int r, int r0, int c, int c0, int hi, const float* bt) {
  const bool active = (unsigned)(kr - r0) < 8u;
  if (!active) {
#pragma unroll
    for (int i = 0; i < 16; ++i) { p0[i] = -1e30f; p1[i] = -1e30f; }
  } else {
    const float* bp = bt + (kr - r + 7) * 31 + 15 - c + 4 * hi;
    const int dk = 4 * hi - c0;
#pragma unroll
    for (int i = 0; i < 16; ++i) { const int kc = (i & 3) + 8 * (i >> 2);
      p0[i] = ((unsigned)(kc + dk) < 16u) ? p0[i] + bp[kc] : -1e30f;
      p1[i] = ((unsigned)(kc + 32 + dk) < 16u) ? p1[i] + bp[kc + 32] : -1e30f; }
  }
}

template <int TYPE, int SDEPTH>
DEVI void attn_unit(int b, int h, int qb, const bf16_t* __restrict__ PROJ, const bf16_t* __restrict__ QB, const bf16_t* __restrict__ KVB,
                    const float* __restrict__ rpb, const float* __restrict__ qgain, const float2* __restrict__ tab, bf16_t* __restrict__ MIX, char* lds, LAS unsigned char* L3) {
  constexpr float SCALE = TYPE == 1 ? 0.07216878364870322f : 0.08838834764831845f;
  constexpr int NQ = 8;
  constexpr int LDQ = TYPE == 1 ? 768 : NP, LDK = TYPE == 1 ? 1024 : NP;
  int tid_ = threadIdx.x; asm volatile("" : "+v"(tid_));
  const int tid = tid_, wid = tid >> 6, lane = tid & 63, r32 = lane & 31, hi = lane >> 5;
  const size_t row0 = (size_t)b * SEQ + qb * 256, kb0 = (size_t)b * SEQ;
  const bf16_t* Qp = TYPE == 0 ? PROJ + row0 * NP + C_AQ + h * 128 : TYPE == 2 ? PROJ + row0 * NP + C_CQ + h * 128 : QB + row0 * 768 + h * 128;
  const bf16_t* Kh = TYPE == 0 ? PROJ + kb0 * NP + C_AK + (h >> 2) * 128 : TYPE == 2 ? PROJ + kb0 * NP + C_CK + h * 128 : KVB + kb0 * 1024 + h * 256;
  const bf16_t* Vh = TYPE == 0 ? PROJ + kb0 * NP + C_AV + (h >> 2) * 128 : TYPE == 2 ? PROJ + kb0 * NP + C_CV + h * 128 : KVB + kb0 * 1024 + h * 256 + 128;
  const bf16_t* Ph = PROJ + kb0 * NP + C_BKR;
  char* V_lds = lds + OFF_V; char* K_lds = lds + OFF_K; char* P_lds = lds + OFF_P;
  float* wsf = (float*)(lds + OFF_WS) + wid * 64; float* li_l = wsf; float* al_l = wsf + 32;
  float* bt = (float*)(lds + OFF_BIAS);
  int kt0 = 0, NT = SEQ / KVBLK;
  if (TYPE == 2) { if (qb == 0) { kt0 = 0; NT = 8; } else if (qb == 7) { kt0 = 24; NT = 8; } else { kt0 = min(4 * qb - 4, 20); NT = 12; } }
  const int nr = 4 * qb + (wid >> 1), nc = 32 * (wid & 1) + r32, nr0 = min(max(nr - 4, 0), 24), nc0 = min(max(nc - 8, 0), 48);
  if (TYPE == 2) { for (int i = tid; i < 465; i += 512) bt[i] = rpb[h * 465 + i] * 1.4426950408889634f; }
  float mhat = 0.f, l_reg = 0; bool first = true; f32x16 negm = {}; asm volatile("" : "+v"(negm)); f32x16 o[4] = {}; bf16x8 qr[NQ];
  const bf16_t* Qw = Qp + (size_t)(wid * QBLK + r32) * LDQ + hi * 8;
#pragma unroll
  for (int d0 = 0; d0 < 8; ++d0) qr[d0] = *reinterpret_cast<const bf16x8*>(Qw + d0 * 16);
  if constexpr (TYPE == 0) {
    float ss = 0.f;
#pragma unroll
    for (int d0 = 0; d0 < 8; ++d0) { const u32x4 w = __builtin_bit_cast(u32x4, qr[d0]);
#pragma unroll
      for (int e = 0; e < 4; ++e) { const float x1 = __uint_as_float(w[e] << 16), x2 = __uint_as_float(w[e] & 0xffff0000u); ss += x1 * x1 + x2 * x2; } }
    { auto rr = __builtin_amdgcn_permlane32_swap(__float_as_uint(ss), __float_as_uint(ss), false, false); ss = __uint_as_float(rr[0]) + __uint_as_float(rr[1]); }
    const float rs = rsqrtf(ss * (1.f / 128.f) + EPS) * (SCALE * 1.4426950408889634f);
    const int t_ = qb * 256 + wid * QBLK + r32, pr = t_ >> 6, pc = t_ & 63;
#pragma unroll
    for (int d0 = 0; d0 < 8; ++d0) { const int ax = d0 >> 2, j0 = (d0 & 3) * 8 + hi * 4;
      const float4 g0 = *(const float4*)(qgain + 64 * ax + j0), g1 = *(const float4*)(qgain + 64 * ax + 32 + j0);
      const float4* tp = (const float4*)(tab + (ax == 0 ? T_AR + pr * 32 : T_AC + pc * 32) + j0); const float4 c01 = tp[0], c23 = tp[1];
      const u32x4 w = __builtin_bit_cast(u32x4, qr[d0]); u32x4 o_;
      { const float x1 = __uint_as_float(w[0] << 16) * rs * g0.x, x2 = __uint_as_float(w[0] & 0xffff0000u) * rs * g1.x; o_[0] = pk2(x1 * c01.x - x2 * c01.y, x2 * c01.x + x1 * c01.y); }
      { const float x1 = __uint_as_float(w[1] << 16) * rs * g0.y, x2 = __uint_as_float(w[1] & 0xffff0000u) * rs * g1.y; o_[1] = pk2(x1 * c01.z - x2 * c01.w, x2 * c01.z + x1 * c01.w); }
      { const float x1 = __uint_as_float(w[2] << 16) * rs * g0.z, x2 = __uint_as_float(w[2] & 0xffff0000u) * rs * g1.z; o_[2] = pk2(x1 * c23.x - x2 * c23.y, x2 * c23.x + x1 * c23.y); }
      { const float x1 = __uint_as_float(w[3] << 16) * rs * g0.w, x2 = __uint_as_float(w[3] & 0xffff0000u) * rs * g1.w; o_[3] = pk2(x1 * c23.z - x2 * c23.w, x2 * c23.z + x1 * c23.w); }
      qr[d0] = __builtin_bit_cast(bf16x8, o_); }
  }
  const char* Qe = lds + OFF_QPE + wid * 4096;
  if constexpr (TYPE == 1) {
#pragma unroll
    for (int i = 0; i < 4; ++i) { const int idx = i * 64 + lane, rw = idx >> 3, ch = idx & 7;
      *(u32x4*)(lds + OFF_QPE + wid * 4096 + PSWZ(rw, ch * 16)) = *reinterpret_cast<const u32x4*>(QB + (row0 + wid * QBLK + rw) * 768 + 512 + h * 64 + ch * 8); } }
  const int sr = tid >> 4, sc = (tid & 15) * 8, vst0 = v_st(sr, sc), vst1 = v_st(32 + sr, sc);
  const int pr_ = tid >> 3, pc_ = (tid & 7) * 8;
  const int vb0 = (int)(uintptr_t)V_lds + v_rd_base(lane);
  struct { bf16x8 vs0, vs1, ks0, ks1, ps; } sr_[2];
#define SLOAD(i, k0) do { const size_t kk_ = (size_t)(kt0 * KVBLK + (k0)); \
    sr_[i].vs0 = *reinterpret_cast<const bf16x8*>(&Vh[(kk_ + sr) * LDK + sc]); sr_[i].vs1 = *reinterpret_cast<const bf16x8*>(&Vh[(kk_ + 32 + sr) * LDK + sc]); \
    sr_[i].ks0 = *reinterpret_cast<const bf16x8*>(&Kh[(kk_ + sr) * LDK + sc]); sr_[i].ks1 = *reinterpret_cast<const bf16x8*>(&Kh[(kk_ + 32 + sr) * LDK + sc]); \
    if constexpr (TYPE == 1) sr_[i].ps = *reinterpret_cast<const bf16x8*>(&Ph[(kk_ + pr_) * NP + pc_]); } while (0)
#define SWRITE(bf, i) do { *(bf16x8*)(V_lds + (bf) * SHM_V + vst0) = sr_[i].vs0; *(bf16x8*)(V_lds + (bf) * SHM_V + vst1) = sr_[i].vs1; const int kc = sc * 2; \
    *(bf16x8*)(K_lds + (bf) * SHM_K + KSWZ(sr, kc)) = sr_[i].ks0; *(bf16x8*)(K_lds + (bf) * SHM_K + KSWZ(32 + sr, kc)) = sr_[i].ks1; \
    if constexpr (TYPE == 1) *(bf16x8*)(P_lds + (bf) * SHM_P + PSWZ(pr_, pc_ * 2)) = sr_[i].ps; } while (0)
#define SWAIT() do { if constexpr (SDEPTH == 2) { if constexpr (TYPE == 1) asm volatile("s_waitcnt vmcnt(5)" ::: "memory"); else asm volatile("s_waitcnt vmcnt(4)" ::: "memory"); } \
    else asm volatile("s_waitcnt vmcnt(0)" ::: "memory"); } while (0)
#define RESC(a) do { if (__any((a) < 1.f)) { if (hi == 0) al_l[r32] = (a); asm volatile("s_waitcnt lgkmcnt(0)" ::: "memory"); \
    _Pragma("unroll") for (int d = 0; d < 4; ++d) _Pragma("unroll") for (int r = 0; r < 16; ++r) o[d][r] *= al_l[crow(r, hi)]; } } while (0)
#define MASK(P0, P1, j) do { if constexpr (TYPE == 2) nb_mask(P0, P1, kt0 + (j), nr, nr0, nc, nc0, hi, bt); } while (0)
  f32x16 pA0, pA1, pB0, pB1; float alA, alB; float m_reg = -1e30f, mn_ = 0.f; (void)mn_; (void)m_reg;
#define PSM(P0, P1, AL) do { if constexpr (TYPE == 1) partialSM<TYPE>(P0, P1, m_reg, mn_, AL); else { partialSM2(P0, P1, mhat, negm, AL, first); first = false; } } while (0)
  bf16x8 pa0, pa1, pa2, pa3;
  constexpr int SE = 0, SO = (SDEPTH == 2) ? 1 : 0;
  if constexpr (TYPE == 2) {
    const int wnr0 = __builtin_amdgcn_readfirstlane(nr0);
#define ACT(j) ((unsigned)(kt0 + (j) - wnr0) < 8u)
#define TILE(j, bf) do { if (ACT(j)) { qkt<TYPE>(pA0, pA1, K_lds + (bf) * SHM_K, P_lds, qr, Qe, negm, r32, hi); MASK(pA0, pA1, j); PSM(pA0, pA1, alA); RESC(alA); \
      finishSM(pA0, pA1, alA, l_reg, pa0, pa1, pa2, pa3); SBAR(); pv_d0(o, vb0 + (bf) * SHM_V, pa0, pa1, pa2, pa3); } } while (0)
    SLOAD(0, 0); asm volatile("s_waitcnt vmcnt(0)" ::: "memory"); SWRITE(0, 0); __syncthreads();
    SLOAD(1, KVBLK); if constexpr (SDEPTH == 2) SLOAD(0, 2 * KVBLK);
    for (int j = 0; j < NT; j += 2) {
      TILE(j, 0);
      SWAIT(); SWRITE(1, 1);
      if constexpr (SDEPTH == 2) { if (j + 3 < NT) SLOAD(1, (j + 3) * KVBLK); }
      __syncthreads();
      if constexpr (SDEPTH == 1) { if (j + 2 < NT) SLOAD(0, (j + 2) * KVBLK); }
      TILE(j + 1, 1);
      if (j + 2 < NT) { SWAIT(); SWRITE(0, 0);
        if constexpr (SDEPTH == 2) { if (j + 4 < NT) SLOAD(0, (j + 4) * KVBLK); }
        __syncthreads();
        if constexpr (SDEPTH == 1) SLOAD(1, (j + 3) * KVBLK); }
    }
#undef TILE
#undef ACT
  } else if constexpr (SDEPTH == 3) {
    unsigned kofs[2], vofs[2], pofs;
#pragma unroll
    for (int i = 0; i < 2; ++i) { const int q = 2 * wid + i;
      { const int row = 4 * q + (lane >> 4), c = (lane & 15) ^ (row & 7); kofs[i] = (unsigned)(row * LDK + c * 8); }
      { const int kk = (q >> 1) * 8 + ((lane & 31) >> 2), k = (kk & ~0xC) | ((kk & 4) << 1) | ((kk & 8) >> 1), col = ((q & 1) * 2 + (lane >> 5)) * 32 + (lane & 3) * 8; vofs[i] = (unsigned)(k * LDK + col); } }
    { const int row = 8 * wid + (lane >> 3), c = (lane & 7) ^ ((row >> 1) & 7); pofs = (unsigned)(row * NP + c * 8); }
    LAS unsigned char* Kd = L3 + OFF_K + wid * 2048; LAS unsigned char* Vd = L3 + OFF_V + wid * 2048; LAS unsigned char* Pd = L3 + OFF_P + wid * 1024;
#define DMA_K(t, bf) do { const bf16_t* kb_ = Kh + (size_t)(kt0 + (t)) * KVBLK * LDK; \
      __builtin_amdgcn_global_load_lds((const unsigned*)(kb_ + kofs[0]), (LAS unsigned*)(Kd + (bf) * SHM_K), 16, 0, 0); __builtin_amdgcn_global_load_lds((const unsigned*)(kb_ + kofs[1]), (LAS unsigned*)(Kd + (bf) * SHM_K + 1024), 16, 0, 0); \
      if constexpr (TYPE == 1) __builtin_amdgcn_global_load_lds((const unsigned*)(Ph + (size_t)(kt0 + (t)) * KVBLK * NP + pofs), (LAS unsigned*)(Pd + (bf) * SHM_P), 16, 0, 0); } while (0)
#define DMA_V(t, bf) do { const bf16_t* vb_ = Vh + (size_t)(kt0 + (t)) * KVBLK * LDK; \
      __builtin_amdgcn_global_load_lds((const unsigned*)(vb_ + vofs[0]), (LAS unsigned*)(Vd + (bf) * SHM_V), 16, 0, 0); __builtin_amdgcn_global_load_lds((const unsigned*)(vb_ + vofs[1]), (LAS unsigned*)(Vd + (bf) * SHM_V + 1024), 16, 0, 0); } while (0)
#define DBAR() do { asm volatile("s_waitcnt vmcnt(0)" ::: "memory"); __syncthreads(); } while (0)
    DMA_K(0, 0); DMA_K(1, 1); DMA_V(0, 0); DBAR();
    SBAR(); qkt<TYPE>(pA0, pA1, K_lds, P_lds, qr, Qe, negm, r32, hi); PSM(pA0, pA1, alA);
    __syncthreads();
    for (int t = 1; t + 1 < NT; t += 2) {
      DMA_K(t + 1, 0); DMA_V(t, 1);
      SBAR(); qkt<TYPE>(pB0, pB1, K_lds + SHM_K, P_lds + SHM_P, qr, Qe, negm, r32, hi);
      finishSM(pA0, pA1, alA, l_reg, pa0, pa1, pa2, pa3); SBAR();
      pv_d0(o, vb0, pa0, pa1, pa2, pa3); PSM(pB0, pB1, alB);
      RESC(alB); DBAR();
      if (t + 2 < NT) DMA_K(t + 2, 1); DMA_V(t + 1, 0);
      SBAR(); qkt<TYPE>(pA0, pA1, K_lds, P_lds, qr, Qe, negm, r32, hi);
      finishSM(pB0, pB1, alB, l_reg, pa0, pa1, pa2, pa3); SBAR();
      pv_d0(o, vb0 + SHM_V, pa0, pa1, pa2, pa3); PSM(pA0, pA1, alA);
      RESC(alA); DBAR();
    }
    DMA_V(NT - 1, 1);
    SBAR(); qkt<TYPE>(pB0, pB1, K_lds + SHM_K, P_lds + SHM_P, qr, Qe, negm, r32, hi);
    finishSM(pA0, pA1, alA, l_reg, pa0, pa1, pa2, pa3); SBAR();
    pv_d0(o, vb0, pa0, pa1, pa2, pa3); PSM(pB0, pB1, alB);
    RESC(alB); DBAR();
    finishSM(pB0, pB1, alB, l_reg, pa0, pa1, pa2, pa3); SBAR();
    pv_d0(o, vb0 + SHM_V, pa0, pa1, pa2, pa3);
#undef DMA_K
#undef DMA_V
#undef DBAR
#define KLOAD(t)
#define VLOAD(t)
#define KWRITE(t)
#define VWRITE(t)
#undef KLOAD
#undef VLOAD
#undef KWRITE
#undef VWRITE
  } else {
  SLOAD(SE, 0); asm volatile("s_waitcnt vmcnt(0)" ::: "memory"); SWRITE(0, SE); __syncthreads();
  qkt<TYPE>(pA0, pA1, K_lds, P_lds, qr, Qe, negm, r32, hi); MASK(pA0, pA1, 0); PSM(pA0, pA1, alA);
  SLOAD(SO, KVBLK); if constexpr (SDEPTH == 2) { if (2 < NT) SLOAD(SE, 2 * KVBLK); }
  SWAIT(); SWRITE(1, SO); __syncthreads();
  for (int j = 1; j + 1 < NT; j += 2) {
    SBAR(); qkt<TYPE>(pB0, pB1, K_lds + SHM_K, P_lds + SHM_P, qr, Qe, negm, r32, hi); MASK(pB0, pB1, j);
    finishSM(pA0, pA1, alA, l_reg, pa0, pa1, pa2, pa3); SBAR();
    SLOAD(SO, (j + SDEPTH) * KVBLK); SBAR();
    pv_d0(o, vb0, pa0, pa1, pa2, pa3); PSM(pB0, pB1, alB);
    __syncthreads(); SWAIT(); SWRITE(0, SE);
    RESC(alB); __syncthreads();
    SBAR(); qkt<TYPE>(pA0, pA1, K_lds, P_lds, qr, Qe, negm, r32, hi); MASK(pA0, pA1, j + 1);
    finishSM(pB0, pB1, alB, l_reg, pa0, pa1, pa2, pa3); SBAR();
    if (SDEPTH == 1 || j + 3 < NT) SLOAD(SE, (j + 1 + SDEPTH) * KVBLK); SBAR();
    pv_d0(o, vb0 + SHM_V, pa0, pa1, pa2, pa3); PSM(pA0, pA1, alA);
    __syncthreads(); SWAIT(); SWRITE(1, SO);
    RESC(alA); __syncthreads();
  }
  SBAR(); qkt<TYPE>(pB0, pB1, K_lds + SHM_K, P_lds + SHM_P, qr, Qe, negm, r32, hi); MASK(pB0, pB1, NT - 1);
  finishSM(pA0, pA1, alA, l_reg, pa0, pa1, pa2, pa3); SBAR();
  pv_d0(o, vb0, pa0, pa1, pa2, pa3); PSM(pB0, pB1, alB);
  __syncthreads(); RESC(alB);
  finishSM(pB0, pB1, alB, l_reg, pa0, pa1, pa2, pa3); SBAR();
  pv_d0(o, vb0 + SHM_V, pa0, pa1, pa2, pa3);
  }
  if (hi == 0) li_l[r32] = l_reg; asm volatile("s_waitcnt lgkmcnt(0)" ::: "memory");
  float rli[16];
#pragma unroll
  for (int r = 0; r < 16; ++r) rli[r] = __builtin_amdgcn_rcpf(li_l[crow(r, hi)]);
  __syncthreads();
  bf16_t* stg = (bf16_t*)(lds + wid * 8192);
#pragma unroll
  for (int r = 0; r < 16; ++r) { const int orow = crow(r, hi);
#pragma unroll
    for (int d0 = 0; d0 < 4; ++d0) stg[orow * 128 + d0 * 32 + r32] = (bf16_t)f2bf(o[d0][r] * rli[r]); }
  asm volatile("s_waitcnt lgkmcnt(0)" ::: "memory");
  constexpr int GCOL = TYPE == 0 ? C_AG : TYPE == 1 ? C_BG : C_CG, MCOL = TYPE == 0 ? 0 : TYPE == 1 ? 1024 : 1536;
  const bf16_t* Gp = PROJ + (row0 + wid * QBLK) * NP + GCOL + h * 128; bf16_t* Op = MIX + (row0 + wid * QBLK) * DMIX + MCOL + h * 128;
#pragma unroll
  for (int i = 0; i < 8; ++i) { const int pidx = i * 64 + lane, row = pidx >> 4, ch = pidx & 15;
    const u32x4 ov = *(const u32x4*)(stg + row * 128 + ch * 8); const u32x4 gv = *(const u32x4*)(Gp + (size_t)row * NP + ch * 8);
    u32x4 w;
#pragma unroll
    for (int e = 0; e < 4; ++e) { const float g0 = bf2f(gv[e] & 0xffffu), g1 = bf2f(gv[e] >> 16), o0 = bf2f(ov[e] & 0xffffu), o1 = bf2f(ov[e] >> 16);
      w[e] = pk2(o0 * g0 * __builtin_amdgcn_rcpf(1.f + __expf(-g0)), o1 * g1 * __builtin_amdgcn_rcpf(1.f + __expf(-g1))); }
    *(u32x4*)(Op + (size_t)row * DMIX + ch * 8) = w; }
  __syncthreads();
#undef SLOAD
#undef SWRITE
#undef SWAIT
#undef RESC
#undef MASK
#undef PSM
}
#undef SBAR
}
#ifndef AMASK
#define AMASK 7
#endif
#ifndef REP_KIND
#define REP_KIND -1
#endif
#ifndef G1_NOEPI
#define G1_NOEPI 0
#endif
#ifndef G1_ALIGN
#define G1_ALIGN true
#endif
#ifndef G1_SP2
#define G1_SP2 true
#endif
#ifndef AREP
#define AREP 7
#endif
#define NREP(k) ((k) == REP_KIND ? 2 : 1)
constexpr int NWAVES = 8;
constexpr int N_PHASES = 1 + 5 * DEPTH;
constexpr size_t WS_CTL = 0, CTL_ZERO_BYTES = 64 * 1024;
constexpr int CW_BAR = 1024;
constexpr int RING_OFF = 0, RING_BYTES = 131072;
constexpr int LDSCTL_OFF = RING_BYTES, MISC_OFF = LDSCTL_OFF + 320, RST_OFF = LDSCTL_OFF + 1024;
constexpr int LDS_BYTES = 147456;

#define GAS __attribute__((address_space(1)))
#ifndef LAS
#define LAS __attribute__((address_space(3)))
#endif
typedef GAS unsigned gu32;
#define RLX_AGENT __ATOMIC_RELAXED, __HIP_MEMORY_SCOPE_AGENT

#define XB_TMO      128
#define XB_XCNT(j)  (256  + 64 * (j))
#define XB_XSUB(j)  (1280 + 64 * (j))
#define XB_XGEN(j)  (2304 + 64 * (j))
#define XB_TOP      3328
#define XB_TOPGEN   3392
#define XCD_BAR_WORDS 3456
#define XB_SPIN_CAP (1u << 18)
__device__ __forceinline__ unsigned xb_ld(unsigned* p)              { return __hip_atomic_load(p, __ATOMIC_RELAXED, __HIP_MEMORY_SCOPE_AGENT); }
__device__ __forceinline__ unsigned xb_add(unsigned* p, unsigned v) { return __hip_atomic_fetch_add(p, v, __ATOMIC_RELAXED, __HIP_MEMORY_SCOPE_AGENT); }
__device__ __forceinline__ unsigned xb_xcc_id() { return (unsigned)__builtin_amdgcn_s_getreg((3 << 11) | 20) & 0xFu; }
#define XB_SPIN(cond, bar) do { unsigned _sp = 0; while (cond) { __builtin_amdgcn_s_sleep(1); \
    if ((++_sp & 255u) == 0u) { if (xb_ld(&(bar)[XB_TMO])) break; if (_sp > XB_SPIN_CAP) { atomicAdd(&(bar)[XB_TMO], 1u); break; } } } } while (0)
struct XcdBarrier { unsigned* bar; unsigned x; volatile LAS unsigned* st; };
__device__ __forceinline__ XcdBarrier xcd_barrier_post(unsigned* bar, volatile LAS unsigned* st) {
    XcdBarrier b; b.bar = bar; b.x = xb_xcc_id(); b.st = st;
    if (threadIdx.x == 0) (void)xb_add(&bar[XB_XCNT(b.x)], 1u);
    return b;
}
__device__ __forceinline__ void xcd_barrier_complete(unsigned* bar, unsigned x, unsigned& nloc, unsigned& nx) {
    const unsigned G = gridDim.x * gridDim.y * gridDim.z;
    unsigned sum, cnt, mine, sp = 0u;
    for (;;) {
        sum = 0u; cnt = 0u; mine = 0u;
#pragma unroll
        for (unsigned j = 0; j < 16; ++j) { const unsigned c = xb_ld(&bar[XB_XCNT(j)]); sum += c; cnt += (c > 0u) ? 1u : 0u; mine = (j == x) ? c : mine; }
        if (sum == G) break;
        __builtin_amdgcn_s_sleep(1);
        if ((++sp & 255u) == 0u) { if (xb_ld(&bar[XB_TMO])) break; if (sp > XB_SPIN_CAP) { atomicAdd(&bar[XB_TMO], 1u); break; } }
    }
    nloc = mine > 0u ? mine : 1u; nx = cnt > 0u ? cnt : 1u;
}
__device__ __forceinline__ void xcd_barrier(const XcdBarrier& b) {
    asm volatile("s_waitcnt vmcnt(0)" ::: "memory");
    __syncthreads();
    if (threadIdx.x == 0) {
        unsigned* bar = b.bar;
        __builtin_amdgcn_s_waitcnt(0);
        unsigned nloc = b.st[0], nx = b.st[1];
        if (nloc == 0u) { xcd_barrier_complete(bar, b.x, nloc, nx); b.st[0] = nloc; b.st[1] = nx; }
        const unsigned old = xb_add(&bar[XB_XSUB(b.x)], 1u);
        const unsigned gen = old / nloc;
        if (old + 1u == (gen + 1u) * nloc) {
            __builtin_amdgcn_fence(__ATOMIC_RELEASE, "agent");
            asm volatile("s_waitcnt vmcnt(0)" ::: "memory");
            const unsigned og = xb_add(&bar[XB_TOP], 1u);
            const unsigned tg = og / nx;
            if (og + 1u == (tg + 1u) * nx) xb_add(&bar[XB_TOPGEN], 1u);
            else XB_SPIN(xb_ld(&bar[XB_TOPGEN]) == tg, bar);
            __builtin_amdgcn_fence(__ATOMIC_ACQUIRE, "agent");
            xb_add(&bar[XB_XGEN(b.x)], 1u);
            asm volatile("s_waitcnt vmcnt(0)" ::: "memory");
        } else {
            XB_SPIN(xb_ld(&bar[XB_XGEN(b.x)]) == gen, bar);
            __builtin_amdgcn_fence(__ATOMIC_ACQUIRE, "agent");
            asm volatile("s_waitcnt vmcnt(0)" ::: "memory");
        }
    }
    __syncthreads();
}

struct Args {
    const float* in[12]; float* out; unsigned char* ws;
    int ph_lo, ph_hi, li, amask;
};


DEVI int fwd_col(int mode, int o) {
    if (mode == 0) return o;
    if (mode == 1) {
        if (o < 1280) { const int d = o & 127, a = d >> 6, t = (d >> 5) & 1, j = d & 31; return (o & ~127) + 64 * a + 2 * j + t; }
        if (o < 3328) return o;
        if (o < 3392) { const int d = o - 3328, a = d >> 5, t = (d >> 4) & 1, j = d & 15; return 3328 + 32 * a + 2 * j + t; }
        return o + 192;
    }
    const int h = o / 192, d = o - h * 192;
    if (d < 128) return h * 128 + d;
    { const int p = d - 128, a = p >> 5, t = (p >> 4) & 1, j = p & 15; return 512 + h * 64 + 32 * a + 2 * j + t; }
}
DEVI void p0_transpose_item(const float* __restrict__ W, int K, int Ns, int mode, const float* __restrict__ kgain, bf16_t* __restrict__ WT, LAS unsigned* scr, int item, int lane) {
    const int nblk = Ns / 64, kb = item / nblk, nb = item - kb * nblk, k0 = 64 * kb, n0 = 64 * nb;
    const int ks = lane >> 4, n4 = (lane & 15) * 4;
    float4 v[16];
#pragma unroll
    for (int i = 0; i < 16; ++i) { const int k = 8 * (i >> 1) + 2 * ks + (i & 1); v[i] = *(const float4*)(W + (size_t)(k0 + k) * Ns + n0 + n4); }
#pragma unroll
    for (int i = 0; i < 8; ++i) { const int kp = 4 * i + ks; float g0 = 1.f, g1 = 1.f;
        if (kgain) { g0 = kgain[k0 + 2 * kp]; g1 = kgain[k0 + 2 * kp + 1]; }
        LAS unsigned* d = scr + kp * 65 + n4;
        d[0] = pk2(v[2 * i].x * g0, v[2 * i + 1].x * g1); d[1] = pk2(v[2 * i].y * g0, v[2 * i + 1].y * g1);
        d[2] = pk2(v[2 * i].z * g0, v[2 * i + 1].z * g1); d[3] = pk2(v[2 * i].w * g0, v[2 * i + 1].w * g1); }
    asm volatile("s_waitcnt lgkmcnt(0)" ::: "memory");
    const int c = lane & 7;
#pragma unroll
    for (int i = 0; i < 8; ++i) { const int n = 8 * i + (lane >> 3); const LAS unsigned* s = scr + (4 * c) * 65 + n;
        uint4 o; o.x = s[0]; o.y = s[65]; o.z = s[130]; o.w = s[195];
        *(uint4*)(WT + (size_t)fwd_col(mode, n0 + n) * K + k0 + 8 * c) = o; }
    asm volatile("s_waitcnt lgkmcnt(0)" ::: "memory");
}
DEVI void rmsnorm_row_xn(const float* __restrict__ xrow, const float* __restrict__ g, bf16_t* __restrict__ orow, int lane) {
    const float4* xr = (const float4*)xrow + lane;
    float4 v[8]; float ss = 0.f;
#pragma unroll
    for (int j = 0; j < 8; ++j) { v[j] = xr[64 * j]; ss += v[j].x * v[j].x + v[j].y * v[j].y + v[j].z * v[j].z + v[j].w * v[j].w; }
    const float rs = rsqrtf(wave_sum(ss) * (1.f / DM) + EPS);
    uint2* o = (uint2*)orow + lane;
#pragma unroll
    for (int j = 0; j < 8; ++j) { const float4 gg = ((const float4*)g)[lane + 64 * j];
        o[64 * j] = make_uint2(pk2(v[j].x * rs * gg.x, v[j].y * rs * gg.y), pk2(v[j].z * rs * gg.z, v[j].w * rs * gg.w)); }
}
DEVI void phase_prologue(const Args& args, LAS unsigned char* L, int gw, int NGW, int wave, int lane) {
    unsigned char* ws = args.ws;
    LAS unsigned* scr = (LAS unsigned*)(L + RING_OFF + wave * 16384);
    constexpr int I_IN = (DM / 64) * (DIN / 64), I_OUT = (DMIX / 64) * (DM / 64), I_UQ = (512 / 64) * (768 / 64), I_UKV = (256 / 64) * (1024 / 64), I_L = I_IN + I_OUT + I_UQ + I_UKV;
    for (int it = gw; it < DEPTH * I_L; it += NGW) {
        const int l = it / I_L; int r = it % I_L;
        if (r < I_IN) { p0_transpose_item(args.in[3] + (size_t)l * DM * DIN, DM, DIN, 1, nullptr, (bf16_t*)(ws + WS_WIN + l * WIN_L), scr, r, lane); continue; } r -= I_IN;
        if (r < I_OUT) { p0_transpose_item(args.in[11] + (size_t)l * DMIX * DM, DMIX, DM, 0, nullptr, (bf16_t*)(ws + WS_WOUT + l * WOUT_L), scr, r, lane); continue; } r -= I_OUT;
        if (r < I_UQ) { p0_transpose_item(args.in[8] + (size_t)l * 512 * 768, 512, 768, 2, args.in[6] + l * 512, (bf16_t*)(ws + WS_WUQ + l * WUQ_L), scr, r, lane); continue; } r -= I_UQ;
        p0_transpose_item(args.in[9] + (size_t)l * 256 * 1024, 256, 1024, 0, args.in[7] + l * 256, (bf16_t*)(ws + WS_WUKV + l * WUKV_L), scr, r, lane);
    }
    for (int it = gw; it < DEPTH * 192 * 4; it += NGW) { const int l = it / 768, r = (it % 768) >> 2, q = it & 3;
        ((uint4*)((bf16_t*)(ws + WS_WIN + l * WIN_L) + (size_t)(3392 + r) * DM))[q * 64 + lane] = make_uint4(0u, 0u, 0u, 0u); }
    bf16_t* XN = (bf16_t*)(ws + WS_XN);
    for (int m = gw; m < M; m += NGW) rmsnorm_row_xn(args.in[0] + (size_t)m * DM, args.in[1], XN + (size_t)m * DM, lane);
    float2* tab = (float2*)(ws + WS_TAB);
    for (int i = gw * 64 + lane; i < T_N; i += NGW * 64) {
        int pos, j; float n;
        if (i < T_AC) { pos = i >> 5; j = i & 31; n = 64.f; }
        else if (i < T_BR) { pos = (i - T_AC) >> 5; j = i & 31; n = 64.f; }
        else if (i < T_BC) { pos = (i - T_BR) >> 4; j = i & 15; n = 32.f; }
        else { pos = (i - T_BC) >> 4; j = i & 15; n = 32.f; }
        const float inv = 1.0f / powf(10000.f, (float)(2 * j) / n);
        const float ang = (float)pos * inv;
        const float k = rintf(ang * 0.15915494309189535f);
        float r = fmaf(-k, 6.28318548202514648f, ang); r = fmaf(-k, -1.74845553e-7f, r);
        tab[i] = make_float2(cosf(r), sinf(r));
    }
}
DEVI void postproj_row(bf16_t* __restrict__ p, int row, int lane, const float* __restrict__ a_qn, const float* __restrict__ a_kn,
                       const float* __restrict__ b_qn, const float* __restrict__ b_kvn, const float2* __restrict__ tab) {
    const int t = row & (SEQ - 1), pr = t >> 6, pc = t & 63;
    {
        const int a = lane >> 5, j = lane & 31;
        const float2 cs = a == 0 ? tab[T_AR + pr * 32 + j] : tab[T_AC + pc * 32 + j];
        const int d1 = 64 * a + j, d2 = d1 + 32;
        const float gq1 = a_qn[d1], gq2 = a_qn[d2], gk1 = a_kn[d1], gk2 = a_kn[d2];
        unsigned v[10];
#pragma unroll
        for (int hb = 0; hb < 10; ++hb) v[hb] = ((const unsigned*)(p + hb * 128))[lane];
#pragma unroll
        for (int hb = 0; hb < 10; ++hb) {
            const float x1 = bf2f(v[hb] & 0xffffu), x2 = bf2f(v[hb] >> 16);
            const float rs = rsqrtf(wave_sum(x1 * x1 + x2 * x2) * (1.f / 128.f) + EPS);
            const float y1 = x1 * rs * (hb < 8 ? gq1 : gk1), y2 = x2 * rs * (hb < 8 ? gq2 : gk2);
            ((unsigned*)(p + hb * 128))[lane] = pk2(y1 * cs.x - y2 * cs.y, y2 * cs.x + y1 * cs.y);
        }
    }
    {
        uint4* pp = (uint4*)(p + C_BCQ) + lane; const uint4 v = *pp; float x[8];
        x[0] = bf2f(v.x & 0xffffu); x[1] = bf2f(v.x >> 16); x[2] = bf2f(v.y & 0xffffu); x[3] = bf2f(v.y >> 16);
        x[4] = bf2f(v.z & 0xffffu); x[5] = bf2f(v.z >> 16); x[6] = bf2f(v.w & 0xffffu); x[7] = bf2f(v.w >> 16);
        float ss = 0.f;
#pragma unroll
        for (int i = 0; i < 8; ++i) ss += x[i] * x[i];
        const float rs = rsqrtf(wave_sum(ss) * (1.f / 512.f) + EPS);
        const float4 g0 = ((const float4*)b_qn)[2 * lane], g1 = ((const float4*)b_qn)[2 * lane + 1];
        *pp = make_uint4(pk2(x[0] * rs * g0.x, x[1] * rs * g0.y), pk2(x[2] * rs * g0.z, x[3] * rs * g0.w),
                         pk2(x[4] * rs * g1.x, x[5] * rs * g1.y), pk2(x[6] * rs * g1.z, x[7] * rs * g1.w));
    }
    {
        uint2* pp = (uint2*)(p + C_BCKV) + lane; const uint2 v = *pp;
        const float x0 = bf2f(v.x & 0xffffu), x1 = bf2f(v.x >> 16), x2 = bf2f(v.y & 0xffffu), x3 = bf2f(v.y >> 16);
        const float rs = rsqrtf(wave_sum(x0 * x0 + x1 * x1 + x2 * x2 + x3 * x3) * (1.f / 256.f) + EPS);
        const float4 g = ((const float4*)b_kvn)[lane];
        *pp = make_uint2(pk2(x0 * rs * g.x, x1 * rs * g.y), pk2(x2 * rs * g.z, x3 * rs * g.w));
    }
    if (lane < 32) {
        const int a = lane >> 4, j = lane & 15;
        const float2 cs = a == 0 ? tab[T_BR + pr * 16 + j] : tab[T_BC + pc * 16 + j];
        unsigned* pp = (unsigned*)(p + C_BKR) + lane; const unsigned v = *pp; const float x1 = bf2f(v & 0xffffu), x2 = bf2f(v >> 16);
        *pp = pk2(x1 * cs.x - x2 * cs.y, x2 * cs.x + x1 * cs.y);
    }
}
DEVI void postprojK_row(bf16_t* __restrict__ p, int row, int lane, const float* __restrict__ a_kn, const float2* __restrict__ tab) {
    const int t = row & (SEQ - 1), pr = t >> 6, pc = t & 63;
    const int a = lane >> 5, j = lane & 31;
    const float2 cs = a == 0 ? tab[T_AR + pr * 32 + j] : tab[T_AC + pc * 32 + j];
    const float gk1 = a_kn[64 * a + j], gk2 = a_kn[64 * a + j + 32];
    unsigned* pk = (unsigned*)(p + C_AK); const unsigned v0 = pk[lane], v1 = pk[64 + lane];
    unsigned vr = 0; const int a2 = lane >> 4, j2 = lane & 15; float2 cs2 = make_float2(1.f, 0.f);
    if (lane < 32) { vr = ((const unsigned*)(p + C_BKR))[lane]; cs2 = a2 == 0 ? tab[T_BR + pr * 16 + j2] : tab[T_BC + pc * 16 + j2]; }
    { const float x1 = bf2f(v0 & 0xffffu), x2 = bf2f(v0 >> 16); const float rs = rsqrtf(wave_sum(x1 * x1 + x2 * x2) * (1.f / 128.f) + EPS);
      const float y1 = x1 * rs * gk1, y2 = x2 * rs * gk2; pk[lane] = pk2(y1 * cs.x - y2 * cs.y, y2 * cs.x + y1 * cs.y); }
    { const float x1 = bf2f(v1 & 0xffffu), x2 = bf2f(v1 >> 16); const float rs = rsqrtf(wave_sum(x1 * x1 + x2 * x2) * (1.f / 128.f) + EPS);
      const float y1 = x1 * rs * gk1, y2 = x2 * rs * gk2; pk[64 + lane] = pk2(y1 * cs.x - y2 * cs.y, y2 * cs.x + y1 * cs.y); }
    if (lane < 32) { const float x1 = bf2f(vr & 0xffffu), x2 = bf2f(vr >> 16); ((unsigned*)(p + C_BKR))[lane] = pk2(x1 * cs2.x - x2 * cs2.y, x2 * cs2.x + x1 * cs2.y); }
}
template <bool FIRST>
DEVI void rowpass_row(const bf16_t* __restrict__ yrow, const float* __restrict__ xrow, const bf16_t* __restrict__ x1row_in, const float* __restrict__ g_post, float* __restrict__ orow_,
                      bf16_t* __restrict__ x1row_out, const float* __restrict__ g_next, bf16_t* __restrict__ xnrow, int lane) {
    const uint2* yr = (const uint2*)yrow + lane;
    float4 v[8]; float ss = 0.f;
#pragma unroll
    for (int j = 0; j < 8; ++j) { const uint2 yv = yr[64 * j]; v[j] = make_float4(bf2f(yv.x & 0xffffu), bf2f(yv.x >> 16), bf2f(yv.y & 0xffffu), bf2f(yv.y >> 16)); ss += v[j].x * v[j].x + v[j].y * v[j].y + v[j].z * v[j].z + v[j].w * v[j].w; }
    const float rs = rsqrtf(wave_sum(ss) * (1.f / DM) + EPS);
    float s2 = 0.f;
#pragma unroll
    for (int j = 0; j < 8; ++j) { const float4 gg = ((const float4*)g_post)[lane + 64 * j]; float4 xx;
        if (FIRST) xx = ((const float4*)xrow)[lane + 64 * j];
        else { const uint2 xv = ((const uint2*)x1row_in)[lane + 64 * j]; xx = make_float4(bf2f(xv.x & 0xffffu), bf2f(xv.x >> 16), bf2f(xv.y & 0xffffu), bf2f(xv.y >> 16)); }
        v[j].x = xx.x + v[j].x * rs * gg.x; v[j].y = xx.y + v[j].y * rs * gg.y; v[j].z = xx.z + v[j].z * rs * gg.z; v[j].w = xx.w + v[j].w * rs * gg.w;
        if (FIRST) { ((uint2*)x1row_out)[lane + 64 * j] = make_uint2(pk2(v[j].x, v[j].y), pk2(v[j].z, v[j].w)); s2 += v[j].x * v[j].x + v[j].y * v[j].y + v[j].z * v[j].z + v[j].w * v[j].w; }
        else ((float4*)orow_)[lane + 64 * j] = v[j]; }
    if (FIRST) {
        const float r2 = rsqrtf(wave_sum(s2) * (1.f / DM) + EPS);
        uint2* o = (uint2*)xnrow + lane;
#pragma unroll
        for (int j = 0; j < 8; ++j) { const float4 gg = ((const float4*)g_next)[lane + 64 * j];
            o[64 * j] = make_uint2(pk2(v[j].x * r2 * gg.x, v[j].y * r2 * gg.y), pk2(v[j].z * r2 * gg.z, v[j].w * r2 * gg.w)); }
    }
}

__global__ void __launch_bounds__(NWAVES * 64, 2) mk_fwd(Args args) {
    extern __shared__ __attribute__((aligned(16))) unsigned char lds[];
    LAS unsigned char* L = (LAS unsigned char*)lds;
    volatile LAS unsigned* MISC = (volatile LAS unsigned*)(L + MISC_OFF);
    const int G = gridDim.x; const int bx = blockIdx.x;
    const int vcu = (G % 8 == 0) ? (bx % 8) * (G / 8) + bx / 8 : bx;
    unsigned char* ws = args.ws;
    gu32* ctl = (gu32*)(ws + WS_CTL);
    for (int u = threadIdx.x; u < (LDS_BYTES - LDSCTL_OFF) / 4; u += NWAVES * 64) ((LAS unsigned*)(L + LDSCTL_OFF))[u] = 0u;
    __syncthreads();
    XcdBarrier bar; bar.bar = (unsigned*)(ctl + CW_BAR) + args.li * XCD_BAR_WORDS; bar.x = 0; bar.st = nullptr;
    const bool multi = (args.ph_hi - args.ph_lo) > 1;
    if (multi) bar = xcd_barrier_post((unsigned*)(ctl + CW_BAR) + args.li * XCD_BAR_WORDS, MISC + 8);
    bf16_t* XN = (bf16_t*)(ws + WS_XN); bf16_t* PROJ = (bf16_t*)(ws + WS_PROJ); bf16_t* Y = (bf16_t*)(ws + WS_Y);
    bf16_t* QB = (bf16_t*)(ws + WS_QB); bf16_t* KVB = (bf16_t*)(ws + WS_KVB); bf16_t* MIX = (bf16_t*)(ws + WS_MIX);
    const int lo = args.ph_lo, hi = args.ph_hi;
#define IN(k) (lo <= (k) && (k) < hi)
#define SEAM(k) do { if (IN(k) && IN((k) + 1)) xcd_barrier(bar); } while (0)
    const int NGW = G * NWAVES;
#define FRESH_IDS() int tid__ = threadIdx.x; asm volatile("" : "+v"(tid__)); const int lane_ = tid__ & 63, wave_ = __builtin_amdgcn_readfirstlane(tid__ >> 6), gw_ = vcu * NWAVES + wave_
    const float2* tab = (const float2*)(ws + WS_TAB);
    if (IN(0)) { for (int rep_ = 0; rep_ < NREP(0); ++rep_) { FRESH_IDS(); phase_prologue(args, L, gw_, NGW, wave_, lane_); } }
    SEAM(0);
#define LAYER(l) do { \
        constexpr int pb = 1 + 5 * (l); \
        if (IN(pb + 0)) { for (int rep_ = 0; rep_ < NREP(1); ++rep_) { \
            pg8::Gemm g{XN, (const bf16_t*)(ws + WS_WIN + (l) * WIN_L)}; pg8::StaticOrder S; S.init(M, NP, G, bx); \
            pg8::EpiBf16 E{PROJ, NP, C_CQ / 256, C_CQ / 256 + 2, 0.08838834764831845f * 1.4426950408889634f}; \
            pg8::gemm_phase<DM, DM, DM, pg8::EpiBf16, pg8::StaticOrder, true, true>(L + RING_OFF, g, S, E); \
        } } \
        SEAM(pb + 0); \
        if (IN(pb + 1)) { for (int rep_ = 0; rep_ < NREP(3); ++rep_) { \
            if (rep_ == 0) { FRESH_IDS(); for (int m = gw_; m < M; m += NGW) postprojK_row(PROJ + (size_t)m * NP, m, lane_, args.in[5] + (l) * 128, tab); } \
            { pg8::Gemm g{PROJ + C_BCQ, (const bf16_t*)(ws + WS_WUQ + (l) * WUQ_L)}; pg8::RsOrder<512, NP> S; S.init(M, 768, G, bx); S.A = PROJ + C_BCQ; S.tab = (LAS float*)(L + RST_OFF); \
              pg8::EpiBf16Rs<2> E{QB, 768, (const LAS float*)(L + RST_OFF), tab + T_BR, tab + T_BC, 1.f}; \
              pg8::gemm_phase<512, NP, 512, pg8::EpiBf16Rs<2>, pg8::RsOrder<512, NP>, true, true>(L + RING_OFF, g, S, E); } \
            { pg8::Gemm g{PROJ + C_BCKV, (const bf16_t*)(ws + WS_WUKV + (l) * WUKV_L)}; pg8::RsOrder<256, NP> S; S.init(M, 1024, G, bx); S.A = PROJ + C_BCKV; S.tab = (LAS float*)(L + RST_OFF); \
              pg8::EpiBf16Rs<-1> E{KVB, 1024, (const LAS float*)(L + RST_OFF), tab, tab, 1.f}; \
              pg8::gemm_phase<256, NP, 256, pg8::EpiBf16Rs<-1>, pg8::RsOrder<256, NP>, true, true>(L + RING_OFF, g, S, E); } \
        } } \
        SEAM(pb + 1); \
        if (IN(pb + 2)) { for (int rep_ = 0; rep_ < NREP(4); ++rep_) { \
            const float* rpb_l = args.in[10] + (size_t)(l) * 4 * 465; const float* qg_l = args.in[4] + (l) * 128; \
            for (int u = vcu; u < 1024; u += G) { \
                if (u < 512) { if (rep_ == 0 || (AREP & 1)) { const int kvh = u >> 8, b_ = (u & 255) >> 5, i_ = u & 31; att::attn_unit<0, 3>(b_, kvh * 4 + (i_ >> 3), i_ & 7, PROJ, QB, KVB, rpb_l, qg_l, tab, MIX, (char*)lds + RING_OFF, L + RING_OFF); } } \
                else if (u < 768) { if (rep_ == 0 || (AREP & 2)) { const int ub = u - 512, b_ = ub >> 5, i_ = ub & 31; att::attn_unit<1, 3>(b_, i_ >> 3, i_ & 7, PROJ, QB, KVB, rpb_l, qg_l, tab, MIX, (char*)lds + RING_OFF, L + RING_OFF); } } \
                else { if (rep_ == 0 || (AREP & 4)) { const int ub = u - 768, b_ = ub >> 5, i_ = ub & 31; att::attn_unit<2, 2>(b_, i_ >> 3, i_ & 7, PROJ, QB, KVB, rpb_l, qg_l, tab, MIX, (char*)lds + RING_OFF, L + RING_OFF); } } \
            } \
        } } \
        SEAM(pb + 2); \
        if (IN(pb + 3)) { for (int rep_ = 0; rep_ < NREP(5); ++rep_) { \
            pg8::Gemm g{MIX, (const bf16_t*)(ws + WS_WOUT + (l) * WOUT_L)}; pg8::StaticOrder S; S.init(M, DM, G, bx); \
            pg8::EpiBf16 E{Y, DM, 0, 0, 1.f}; \
            pg8::gemm_phase<DMIX, DMIX, DMIX, pg8::EpiBf16, pg8::StaticOrder, true, true>(L + RING_OFF, g, S, E); \
        } } \
        SEAM(pb + 3); \
        if (IN(pb + 4)) { FRESH_IDS(); bf16_t* X1B = (bf16_t*)(ws + WS_X1B); for (int m = gw_; m < M; m += NGW) rowpass_row<(l) == 0>(Y + (size_t)m * DM, args.in[0] + (size_t)m * DM, X1B + (size_t)m * DM, args.in[2] + (l) * DM, args.out + (size_t)m * DM, \
                X1B + (size_t)m * DM, args.in[1] + (((l) + 1) % DEPTH) * DM, XN + (size_t)m * DM, lane_); } \
        SEAM(pb + 4); \
    } while (0)
    LAYER(0);
    LAYER(1);
#undef LAYER
#undef IN
#undef SEAM
}

static int g_grid = 0;
static void launch_mk(Args a, int lo, int hi, int li, hipStream_t stream) {
    a.ph_lo = lo; a.ph_hi = hi; a.li = li;
    hipLaunchKernelGGL(mk_fwd, dim3(g_grid), dim3(NWAVES * 64), LDS_BYTES, stream, a);
}

extern "C" void kernel_launch(void* const* d_in, const int* in_sizes, int n_in, void* d_out, int out_size, void* d_ws, size_t ws_size, hipStream_t stream) {
  if (n_in != 12 || in_sizes[0] != M * DM || out_size != M * DM || ws_size < WS_END) {
    fprintf(stderr, "kernel_launch: unexpected shapes n_in %d in0 %d out %d ws %zu (need %zu)\n", n_in, n_in > 0 ? in_sizes[0] : -1, out_size, ws_size, (size_t)WS_END); return; }
  if (g_grid == 0) {
    int dev = 0, cus = 0, per_cu = 0;
    if (hipGetDevice(&dev) != hipSuccess || hipDeviceGetAttribute(&cus, hipDeviceAttributeMultiprocessorCount, dev) != hipSuccess) { fprintf(stderr, "kernel_launch: device query failed\n"); g_grid = -1; return; }
    if (hipFuncSetAttribute((const void*)mk_fwd, hipFuncAttributeMaxDynamicSharedMemorySize, LDS_BYTES) != hipSuccess) { fprintf(stderr, "kernel_launch: hipFuncSetAttribute failed\n"); g_grid = -1; return; }
    if (hipOccupancyMaxActiveBlocksPerMultiprocessor(&per_cu, (const void*)mk_fwd, NWAVES * 64, LDS_BYTES) != hipSuccess || per_cu < 1) { fprintf(stderr, "kernel_launch: occupancy query says %d blocks/CU\n", per_cu); g_grid = -1; (void)hipGetLastError(); return; }
    g_grid = cus;
  }
  if (g_grid < 0) return;
  const float* x = (const float*)d_in[0]; const float* norm_pre = (const float*)d_in[1]; const float* norm_post = (const float*)d_in[2];
  const float* w_in = (const float*)d_in[3]; const float* a_qn = (const float*)d_in[4]; const float* a_kn = (const float*)d_in[5];
  const float* b_qn = (const float*)d_in[6]; const float* b_kvn = (const float*)d_in[7]; const float* w_uq = (const float*)d_in[8];
  const float* w_ukv = (const float*)d_in[9]; const float* rpb = (const float*)d_in[10]; const float* w_out = (const float*)d_in[11];
  char* ws = (char*)d_ws; float* out = (float*)d_out;
  (void)hipMemsetAsync(ws + WS_CTL, 0, CTL_ZERO_BYTES, stream);
  Args a{}; for (int i = 0; i < 12; ++i) a.in[i] = (const float*)d_in[i]; a.out = out; a.ws = (unsigned char*)d_ws; a.amask = AMASK;
  launch_mk(a, 0, N_PHASES, 0, stream);
  (void)x; (void)norm_pre; (void)norm_post; (void)w_in; (void)a_qn; (void)a_kn; (void)b_qn; (void)b_kvn; (void)w_uq; (void)w_ukv; (void)rpb; (void)w_out;
}
```

```cpp
#include <hip/hip_runtime.h>
#include <cstdint>
#include <cstdio>

typedef unsigned short bf16_t;
typedef short bf16x8 __attribute__((ext_vector_type(8)));
typedef float f32x4 __attribute__((ext_vector_type(4)));
#define DEVI __device__ __forceinline__

constexpr int BATCH = 8, SEQ = 2048, DM = 2048, DEPTH = 2;
constexpr int M = BATCH * SEQ;
constexpr int DIN = 5952, NP = 6144;
constexpr int DMIX = 2048;
constexpr float EPS = 1e-6f;
constexpr int C_AQ = 0, C_AK = 1024, C_AV = 1280, C_AG = 1536, C_BCQ = 2560, C_BCKV = 3072, C_BKR = 3328, C_BG = 3584,
              C_CQ = 4096, C_CK = 4608, C_CV = 5120, C_CG = 5632;
constexpr size_t MiB = 1u << 20;
constexpr size_t WS_TAB = 1 * MiB;
constexpr size_t WS_RS2 = 1 * MiB + 512 * 1024;
constexpr size_t WS_WIN = 2 * MiB, WIN_L = 24 * MiB;
constexpr size_t WS_WOUT = 50 * MiB, WOUT_L = 8 * MiB;
constexpr size_t WS_WUQ = 66 * MiB, WUQ_L = 1 * MiB;
constexpr size_t WS_WUKV = 68 * MiB, WUKV_L = 1 * MiB;
constexpr size_t WS_XN = 70 * MiB;
constexpr size_t WS_PROJ = 134 * MiB;
constexpr size_t WS_Y = WS_PROJ;
constexpr size_t WS_QB = 326 * MiB;
constexpr size_t WS_KVB = 350 * MiB;
constexpr size_t WS_MIX = 382 * MiB;
constexpr size_t WS_X1B = 446 * MiB;
constexpr size_t WS_END = 510 * MiB;
constexpr int T_AR = 0, T_AC = 1024, T_BR = 3072, T_BC = 3584, T_N = 4608;

DEVI float bf2f(unsigned v) { return __uint_as_float(v << 16); }
DEVI unsigned f2bf(float f) { unsigned u = __float_as_uint(f); return (u + 0x7fffu + ((u >> 16) & 1u)) >> 16; }
DEVI unsigned pk2(float lo, float hi) { return f2bf(lo) | (f2bf(hi) << 16); }
DEVI float wave_sum(float v) {
#pragma unroll
  for (int o = 1; o < 64; o <<= 1) v += __shfl_xor(v, o);
  return v;
}
DEVI float wave_max(float v) {
#pragma unroll
  for (int o = 1; o < 64; o <<= 1) v = fmaxf(v, __shfl_xor(v, o));
  return v;
}

DEVI int perm128(int p) { const int a = p >> 6, j = (p & 63) >> 1, t = p & 1; return 64 * a + 32 * t + j; }
DEVI int perm64(int p) { const int a = p >> 5, j = (p & 31) >> 1, t = p & 1; return 32 * a + 16 * t + j; }
DEVI int map_col(int mode, int s) {
  if (mode == 0) return s;
  if (mode == 1) {
    if (s < 1280) return (s & ~127) + perm128(s & 127);
    if (s < 3328) return s;
    if (s < 3392) return 3328 + perm64(s - 3328);
    if (s < 3584) return -1;
    return s - 192;
  }
  if (s < 512) return (s >> 7) * 192 + (s & 127);
  const int h = (s - 512) >> 6, p = (s - 512) & 63;
  return h * 192 + 128 + perm64(p);
}

__global__ __launch_bounds__(256) void k_transpose_cvt(const float* __restrict__ src, bf16_t* __restrict__ dst, int K, int Ns, int mode) {
  __shared__ float tile[32][33];
  const int n0 = blockIdx.x * 32, k0 = blockIdx.y * 32, tx = threadIdx.x & 31, ty = threadIdx.x >> 5;
  const int so = map_col(mode, n0 + tx);
#pragma unroll
  for (int i = 0; i < 4; ++i) { const int kk = ty + 8 * i; tile[kk][tx] = so >= 0 ? src[(size_t)(k0 + kk) * Ns + so] : 0.f; }
  __syncthreads();
#pragma unroll
  for (int i = 0; i < 4; ++i) { const int nn = ty + 8 * i; dst[(size_t)(n0 + nn) * K + k0 + tx] = (bf16_t)f2bf(tile[tx][nn]); }
}

__global__ __launch_bounds__(256) void k_rope_tab(float2* tab) {
  const int i = blockIdx.x * 256 + threadIdx.x; if (i >= T_N) return;
  int pos, j; float n;
  if (i < T_AC) { pos = i >> 5; j = i & 31; n = 64.f; }
  else if (i < T_BR) { pos = (i - T_AC) >> 5; j = i & 31; n = 64.f; }
  else if (i < T_BC) { pos = (i - T_BR) >> 4; j = i & 15; n = 32.f; }
  else { pos = (i - T_BC) >> 4; j = i & 15; n = 32.f; }
  const float inv = 1.0f / powf(10000.f, (float)(2 * j) / n);
  const float ang = (float)pos * inv;
  const float k = rintf(ang * 0.15915494309189535f);
  float r = fmaf(-k, 6.28318548202514648f, ang); r = fmaf(-k, -1.74845553e-7f, r);
  tab[i] = make_float2(cosf(r), sinf(r));
}

__global__ __launch_bounds__(256) void k_rmsnorm_xn(const float* __restrict__ x, const float* __restrict__ g, bf16_t* __restrict__ xn) {
  const int row = blockIdx.x * 4 + (threadIdx.x >> 6), lane = threadIdx.x & 63;
  const float4* xr = (const float4*)(x + (size_t)row * DM) + lane;
  float4 v[8]; float ss = 0.f;
#pragma unroll
  for (int j = 0; j < 8; ++j) { v[j] = xr[64 * j]; ss += v[j].x * v[j].x + v[j].y * v[j].y + v[j].z * v[j].z + v[j].w * v[j].w; }
  const float rs = rsqrtf(wave_sum(ss) * (1.f / DM) + EPS);
  uint2* o = (uint2*)(xn + (size_t)row * DM) + lane;
#pragma unroll
  for (int j = 0; j < 8; ++j) { const float4 gg = ((const float4*)g)[lane + 64 * j];
    o[64 * j] = make_uint2(pk2(v[j].x * rs * gg.x, v[j].y * rs * gg.y), pk2(v[j].z * rs * gg.z, v[j].w * rs * gg.w)); }
}

template <bool OUT_F32>
__global__ __launch_bounds__(256) void k_gemm_naive(const bf16_t* __restrict__ A, int lda, const bf16_t* __restrict__ Bt, int ldb, void* __restrict__ C, int ldc, int K) {
  __shared__ __attribute__((aligned(16))) bf16_t sA[64 * 40];
  __shared__ __attribute__((aligned(16))) bf16_t sB[64 * 40];
  const int tid = threadIdx.x, lane = tid & 63, w = tid >> 6;
  const int m0 = blockIdx.y * 64, n0 = blockIdx.x * 64, lr = tid >> 2, lc = (tid & 3) * 8;
  f32x4 acc0 = {0, 0, 0, 0}, acc1 = acc0, acc2 = acc0, acc3 = acc0;
  for (int k0 = 0; k0 < K; k0 += 32) {
    const uint4 va = *(const uint4*)(A + (size_t)(m0 + lr) * lda + k0 + lc);
    const uint4 vb = *(const uint4*)(Bt + (size_t)(n0 + lr) * ldb + k0 + lc);
    __syncthreads();
    *(uint4*)(sA + lr * 40 + lc) = va; *(uint4*)(sB + lr * 40 + lc) = vb;
    __syncthreads();
    const bf16x8 a = *(const bf16x8*)(sA + (16 * w + (lane & 15)) * 40 + (lane >> 4) * 8);
    const bf16x8 b0 = *(const bf16x8*)(sB + (0 + (lane & 15)) * 40 + (lane >> 4) * 8);
    const bf16x8 b1 = *(const bf16x8*)(sB + (16 + (lane & 15)) * 40 + (lane >> 4) * 8);
    const bf16x8 b2 = *(const bf16x8*)(sB + (32 + (lane & 15)) * 40 + (lane >> 4) * 8);
    const bf16x8 b3 = *(const bf16x8*)(sB + (48 + (lane & 15)) * 40 + (lane >> 4) * 8);
    acc0 = __builtin_amdgcn_mfma_f32_16x16x32_bf16(a, b0, acc0, 0, 0, 0);
    acc1 = __builtin_amdgcn_mfma_f32_16x16x32_bf16(a, b1, acc1, 0, 0, 0);
    acc2 = __builtin_amdgcn_mfma_f32_16x16x32_bf16(a, b2, acc2, 0, 0, 0);
    acc3 = __builtin_amdgcn_mfma_f32_16x16x32_bf16(a, b3, acc3, 0, 0, 0);
  }
#pragma unroll
  for (int j = 0; j < 4; ++j) {
    const size_t row = m0 + 16 * w + (lane >> 4) * 4 + j; const int col = n0 + (lane & 15);
    if (OUT_F32) { float* c = (float*)C + row * ldc + col; c[0] = acc0[j]; c[16] = acc1[j]; c[32] = acc2[j]; c[48] = acc3[j]; }
    else { bf16_t* c = (bf16_t*)C + row * ldc + col; c[0] = (bf16_t)f2bf(acc0[j]); c[16] = (bf16_t)f2bf(acc1[j]); c[32] = (bf16_t)f2bf(acc2[j]); c[48] = (bf16_t)f2bf(acc3[j]); }
  }
}

__global__ __launch_bounds__(256) void k_postproj(bf16_t* __restrict__ PROJ, const float* __restrict__ a_qn, const float* __restrict__ a_kn,
                                                  const float* __restrict__ b_qn, const float* __restrict__ b_kvn, const float2* __restrict__ tab) {
  const int row = blockIdx.x * 4 + (threadIdx.x >> 6), lane = threadIdx.x & 63;
  const int t = row & (SEQ - 1), pr = t >> 6, pc = t & 63;
  bf16_t* p = PROJ + (size_t)row * NP;
  {
    const int a = lane >> 5, j = lane & 31;
    const float2 cs = a == 0 ? tab[T_AR + pr * 32 + j] : tab[T_AC + pc * 32 + j];
    const int d1 = 64 * a + j, d2 = d1 + 32;
    for (int hb = 0; hb < 10; ++hb) {
      unsigned* pp = (unsigned*)(p + hb * 128) + lane;
      const unsigned v = *pp; const float x1 = bf2f(v & 0xffffu), x2 = bf2f(v >> 16);
      const float rs = rsqrtf(wave_sum(x1 * x1 + x2 * x2) * (1.f / 128.f) + EPS);
      const float* g = hb < 8 ? a_qn : a_kn;
      const float y1 = x1 * rs * g[d1], y2 = x2 * rs * g[d2];
      *pp = pk2(y1 * cs.x - y2 * cs.y, y2 * cs.x + y1 * cs.y);
    }
  }
  {
    uint4* pp = (uint4*)(p + C_BCQ) + lane; const uint4 v = *pp; float x[8];
    x[0] = bf2f(v.x & 0xffffu); x[1] = bf2f(v.x >> 16); x[2] = bf2f(v.y & 0xffffu); x[3] = bf2f(v.y >> 16);
    x[4] = bf2f(v.z & 0xffffu); x[5] = bf2f(v.z >> 16); x[6] = bf2f(v.w & 0xffffu); x[7] = bf2f(v.w >> 16);
    float ss = 0.f;
#pragma unroll
    for (int i = 0; i < 8; ++i) ss += x[i] * x[i];
    const float rs = rsqrtf(wave_sum(ss) * (1.f / 512.f) + EPS);
    const float4 g0 = ((const float4*)b_qn)[2 * lane], g1 = ((const float4*)b_qn)[2 * lane + 1];
    *pp = make_uint4(pk2(x[0] * rs * g0.x, x[1] * rs * g0.y), pk2(x[2] * rs * g0.z, x[3] * rs * g0.w),
                     pk2(x[4] * rs * g1.x, x[5] * rs * g1.y), pk2(x[6] * rs * g1.z, x[7] * rs * g1.w));
  }
  {
    uint2* pp = (uint2*)(p + C_BCKV) + lane; const uint2 v = *pp;
    const float x0 = bf2f(v.x & 0xffffu), x1 = bf2f(v.x >> 16), x2 = bf2f(v.y & 0xffffu), x3 = bf2f(v.y >> 16);
    const float rs = rsqrtf(wave_sum(x0 * x0 + x1 * x1 + x2 * x2 + x3 * x3) * (1.f / 256.f) + EPS);
    const float4 g = ((const float4*)b_kvn)[lane];
    *pp = make_uint2(pk2(x0 * rs * g.x, x1 * rs * g.y), pk2(x2 * rs * g.z, x3 * rs * g.w));
  }
  if (lane < 32) {
    const int a = lane >> 4, j = lane & 15;
    const float2 cs = a == 0 ? tab[T_BR + pr * 16 + j] : tab[T_BC + pc * 16 + j];
    unsigned* pp = (unsigned*)(p + C_BKR) + lane; const unsigned v = *pp; const float x1 = bf2f(v & 0xffffu), x2 = bf2f(v >> 16);
    *pp = pk2(x1 * cs.x - x2 * cs.y, x2 * cs.x + x1 * cs.y);
  }
}

__global__ __launch_bounds__(256) void k_rope_qpe(bf16_t* __restrict__ QB, const float2* __restrict__ tab) {
  const int row = blockIdx.x * 4 + (threadIdx.x >> 6), lane = threadIdx.x & 63;
  const int t = row & (SEQ - 1), pr = t >> 6, pc = t & 63;
  unsigned* p = (unsigned*)(QB + (size_t)row * 768 + 512);
#pragma unroll
  for (int i = 0; i < 2; ++i) {
    const int pi = lane + 64 * i, a = (pi >> 4) & 1, j = pi & 15;
    const float2 cs = a == 0 ? tab[T_BR + pr * 16 + j] : tab[T_BC + pc * 16 + j];
    const unsigned v = p[pi]; const float x1 = bf2f(v & 0xffffu), x2 = bf2f(v >> 16);
    p[pi] = pk2(x1 * cs.x - x2 * cs.y, x2 * cs.x + x1 * cs.y);
  }
}

DEVI float dot8(const uint4 kv, const float* q) {
  return bf2f(kv.x & 0xffffu) * q[0] + bf2f(kv.x >> 16) * q[1] + bf2f(kv.y & 0xffffu) * q[2] + bf2f(kv.y >> 16) * q[3] +
         bf2f(kv.z & 0xffffu) * q[4] + bf2f(kv.z >> 16) * q[5] + bf2f(kv.w & 0xffffu) * q[6] + bf2f(kv.w >> 16) * q[7];
}
template <int TYPE>
__global__ __launch_bounds__(256) void k_attn_naive(const bf16_t* __restrict__ PROJ, const bf16_t* __restrict__ QB, const bf16_t* __restrict__ KVB,
                                                    const float* __restrict__ rpb, bf16_t* __restrict__ MIX) {
  __shared__ float qs[4][192];
  __shared__ float ps[4][2048];
  constexpr int NH = TYPE == 0 ? 8 : 4;
  const int w = threadIdx.x >> 6, lane = threadIdx.x & 63;
  const int item = blockIdx.x * 4 + w, h = item % NH, row = item / NH, b = row >> 11, t = row & 2047;
  const float scale = TYPE == 1 ? 0.07216878364870322f : 0.08838834764831845f;
  if (TYPE == 0) { for (int d = lane; d < 128; d += 64) qs[w][d] = bf2f(PROJ[(size_t)row * NP + C_AQ + h * 128 + d]); }
  else if (TYPE == 2) { for (int d = lane; d < 128; d += 64) qs[w][d] = bf2f(PROJ[(size_t)row * NP + C_CQ + h * 128 + d]); }
  else { for (int d = lane; d < 128; d += 64) qs[w][d] = bf2f(QB[(size_t)row * 768 + h * 128 + d]); qs[w][128 + lane] = bf2f(QB[(size_t)row * 768 + 512 + h * 64 + lane]); }
  __syncthreads();
  const int r = t >> 6, c = t & 63;
  const int r0 = min(max(r - 4, 0), 24), c0 = min(max(c - 8, 0), 48);
  constexpr int NK = TYPE == 2 ? 128 : 2048;
  float lmax = -3.0e38f;
  for (int i = 0; i < NK / 64; ++i) {
    const int n = lane + 64 * i; int j; float bias = 0.f;
    if (TYPE == 2) { const int kr = r0 + (n >> 4), kc = c0 + (n & 15); j = kr * 64 + kc; bias = rpb[(h * 15 + (kr - r + 7)) * 31 + (kc - c + 15)]; } else j = n;
    const size_t krow = (size_t)b * 2048 + j;
    const bf16_t* kp = TYPE == 0 ? PROJ + krow * NP + C_AK + (h >> 2) * 128 : TYPE == 2 ? PROJ + krow * NP + C_CK + h * 128 : KVB + krow * 1024 + h * 256;
    float acc = 0.f;
#pragma unroll
    for (int d = 0; d < 128; d += 8) acc += dot8(*(const uint4*)(kp + d), &qs[w][d]);
    if (TYPE == 1) { const bf16_t* kp2 = PROJ + krow * NP + C_BKR;
#pragma unroll
      for (int d = 0; d < 64; d += 8) acc += dot8(*(const uint4*)(kp2 + d), &qs[w][128 + d]); }
    const float s = acc * scale + bias;
    ps[w][n] = s; lmax = fmaxf(lmax, s);
  }
  const float mx = wave_max(lmax);
  float lsum = 0.f;
  for (int i = 0; i < NK / 64; ++i) { const int n = lane + 64 * i; const float p = __expf(ps[w][n] - mx); ps[w][n] = p; lsum += p; }
  const float l = wave_sum(lsum);
  __syncthreads();
  float o0 = 0.f, o1 = 0.f;
  for (int n = 0; n < NK; ++n) {
    int j; if (TYPE == 2) j = (r0 + (n >> 4)) * 64 + c0 + (n & 15); else j = n;
    const size_t krow = (size_t)b * 2048 + j;
    const bf16_t* vp = TYPE == 0 ? PROJ + krow * NP + C_AV + (h >> 2) * 128 : TYPE == 2 ? PROJ + krow * NP + C_CV + h * 128 : KVB + krow * 1024 + h * 256 + 128;
    const unsigned v = ((const unsigned*)vp)[lane]; const float p = ps[w][n];
    o0 += p * bf2f(v & 0xffffu); o1 += p * bf2f(v >> 16);
  }
  const int gcol = (TYPE == 0 ? C_AG : TYPE == 1 ? C_BG : C_CG) + h * 128, mcol = (TYPE == 0 ? 0 : TYPE == 1 ? 1024 : 1536) + h * 128;
  const unsigned gv = ((const unsigned*)(PROJ + (size_t)row * NP + gcol))[lane];
  const float g0 = bf2f(gv & 0xffffu), g1 = bf2f(gv >> 16), il = 1.f / l;
  ((unsigned*)(MIX + (size_t)row * DMIX + mcol))[lane] = pk2(o0 * il * (g0 / (1.f + __expf(-g0))), o1 * il * (g1 / (1.f + __expf(-g1))));
}

__global__ __launch_bounds__(256) void k_rowpass(const float* __restrict__ Y, const float* resid, const float* __restrict__ g_post, float* out,
                                                 const float* __restrict__ g_next, bf16_t* __restrict__ xn) {
  const int row = blockIdx.x * 4 + (threadIdx.x >> 6), lane = threadIdx.x & 63;
  const float4* yr = (const float4*)(Y + (size_t)row * DM) + lane; const float4* xr = (const float4*)(resid + (size_t)row * DM) + lane;
  float4 v[8]; float ss = 0.f;
#pragma unroll
  for (int j = 0; j < 8; ++j) { v[j] = yr[64 * j]; ss += v[j].x * v[j].x + v[j].y * v[j].y + v[j].z * v[j].z + v[j].w * v[j].w; }
  const float rs = rsqrtf(wave_sum(ss) * (1.f / DM) + EPS);
  float4* orow = (float4*)(out + (size_t)row * DM) + lane; float s2 = 0.f;
#pragma unroll
  for (int j = 0; j < 8; ++j) { const float4 gg = ((const float4*)g_post)[lane + 64 * j]; const float4 xx = xr[64 * j];
    v[j].x = xx.x + v[j].x * rs * gg.x; v[j].y = xx.y + v[j].y * rs * gg.y; v[j].z = xx.z + v[j].z * rs * gg.z; v[j].w = xx.w + v[j].w * rs * gg.w;
    orow[64 * j] = v[j]; s2 += v[j].x * v[j].x + v[j].y * v[j].y + v[j].z * v[j].z + v[j].w * v[j].w; }
  if (g_next) {
    const float r2 = rsqrtf(wave_sum(s2) * (1.f / DM) + EPS);
    uint2* o = (uint2*)(xn + (size_t)row * DM) + lane;
#pragma unroll
    for (int j = 0; j < 8; ++j) { const float4 gg = ((const float4*)g_next)[lane + 64 * j];
      o[64 * j] = make_uint2(pk2(v[j].x * r2 * gg.x, v[j].y * r2 * gg.y), pk2(v[j].z * r2 * gg.z, v[j].w * r2 * gg.w)); }
  }
}

namespace pg8 {
#define PG8_LAS __attribute__((address_space(3)))
typedef unsigned u32x4 __attribute__((ext_vector_type(4)));
constexpr int BM = 256, BK = 64, HALF = 128, HTB = HALF * BK * 2, STAGE_BYTES = 8 * HTB, NXCD = 8, WGM = 8;
__host__ __device__ __forceinline__ int lds_byte(int r, int c) { const int st = (r >> 4) * 2 + (c >> 5), rr = r & 15, cc = c & 31, ob = rr * 64 + cc * 2; return st * 1024 + (ob ^ (((ob >> 9) & 1) << 5)); }
__host__ __device__ __forceinline__ void stage_rc(int b, int& R, int& C) { const int st = b / 1024, sb = b % 1024, swz = sb ^ (((sb >> 9) & 1) << 5); R = (st >> 1) * 16 + swz / 64; C = (st & 1) * 32 + (swz % 64) / 2; }
__host__ __device__ __forceinline__ int perm32(int rho) { const int n = rho >> 4, i = rho & 15; return 8 * (i >> 2) + 4 * n + (i & 3); }
struct Unit { int pm, pn, slot; };
struct Gemm { const bf16_t* A; const bf16_t* Bt; };
struct StaticOrder {
    int nM, nN, nwg, G, c;
    __host__ __device__ void init(int M, int N, int G_, int c_) { nM = M / BM; nN = N / BM; nwg = nM * nN; G = G_; c = c_; }
    __host__ __device__ bool next(int i, Unit& u) const {
        const long L = (long)i * G + c; if (L >= nwg) return false;
        int wgid = (int)L; { const int q = nwg / NXCD, r = nwg % NXCD, xcd = wgid % NXCD, off = wgid / NXCD; wgid = (xcd < r ? xcd * (q + 1) : r * (q + 1) + (xcd - r) * q) + off; }
        const int nig = WGM * nN, gid = wgid / nig, fm = gid * WGM, gsz = (nM - fm) < WGM ? (nM - fm) : WGM;
        u.pm = fm + ((wgid % nig) % gsz); u.pn = (wgid % nig) / gsz; u.slot = i & 1; return true;
    }
    __device__ __forceinline__ void a_ready(const Unit&) const {}
    __device__ __forceinline__ void done(const Unit&) const {}
};
__device__ __forceinline__ unsigned cvt_pk_bf16(float lo, float hi) { unsigned r; asm volatile("v_cvt_pk_bf16_f32 %0, %1, %2" : "=v"(r) : "v"(lo), "v"(hi)); return r; }
struct EpiF32 {
    static constexpr bool PERM = false, AFTER_DRAIN = false;
    float* C; int ldc;
    __device__ __forceinline__ void operator()(const f32x4 (&acc)[2][2][4][2], const Unit& u, int wr, int wc, int fr, int fq) const {
        const int row0 = u.pm * BM + wr * 64 + fr, col0 = u.pn * BM + wc * 32 + 4 * fq;
#pragma unroll
        for (int ai = 0; ai < 2; ++ai)
#pragma unroll
            for (int m = 0; m < 4; ++m) { float* rowp = C + (size_t)(row0 + ai * HALF + m * 16) * ldc + col0;
#pragma unroll
                for (int bj = 0; bj < 2; ++bj)
#pragma unroll
                    for (int n = 0; n < 2; ++n) *(f32x4*)(rowp + bj * HALF + n * 16) = acc[ai][bj][m][n]; }
    }
};
struct EpiNone {
    static constexpr bool PERM = true, AFTER_DRAIN = false;
    __device__ __forceinline__ void operator()(const f32x4 (&acc)[2][2][4][2], const Unit&, int, int, int, int) const {
#pragma unroll
        for (int ai = 0; ai < 2; ++ai)
#pragma unroll
            for (int bj = 0; bj < 2; ++bj)
#pragma unroll
                for (int m = 0; m < 4; ++m)
#pragma unroll
                    for (int n = 0; n < 2; ++n) asm volatile("" :: "v"(acc[ai][bj][m][n]));
    }
};
struct EpiBf16 {
    static constexpr bool PERM = true, AFTER_DRAIN = false;
    bf16_t* O; int ldc; int sc_lo, sc_hi; float sc; const float* rowscale;
    __device__ __forceinline__ void operator()(const f32x4 (&acc)[2][2][4][2], const Unit& u, int wr, int wc, int fr, int fq) const {
        const int row0 = u.pm * BM + wr * 64 + fr, col0 = u.pn * BM + wc * 32 + 8 * fq;
        const float s_ = (u.pn >= sc_lo && u.pn < sc_hi) ? sc : 1.f;
#pragma unroll
        for (int ai = 0; ai < 2; ++ai)
#pragma unroll
            for (int m = 0; m < 4; ++m) { bf16_t* rowp = O + (size_t)(row0 + ai * HALF + m * 16) * ldc + col0;
                const float sr_ = rowscale ? s_ * rowscale[row0 + ai * HALF + m * 16] : s_;
#pragma unroll
                for (int bj = 0; bj < 2; ++bj) { const f32x4 v0 = acc[ai][bj][m][0] * sr_, v1 = acc[ai][bj][m][1] * sr_;
                    u32x4 w; w.x = cvt_pk_bf16(v0[0], v0[1]); w.y = cvt_pk_bf16(v0[2], v0[3]); w.z = cvt_pk_bf16(v1[0], v1[1]); w.w = cvt_pk_bf16(v1[2], v1[3]);
                    *(u32x4*)(rowp + bj * HALF) = w; } }
    }
};

template <int KW, int LDA> struct RsOrder : StaticOrder {
    const bf16_t* A; PG8_LAS float* tab;
    __device__ __forceinline__ void a_ready(const Unit& u) const {
        int l_ = threadIdx.x; asm volatile("" : "+v"(l_));
        const int lane = l_ & 63, wid = l_ >> 6, rr = lane >> 4, c = lane & 15;
        constexpr int NV = KW / 16 / 8;
        const bf16_t* base = A + (size_t)(u.pm * BM + wid * 32 + rr) * LDA + c * (KW / 16);
#pragma unroll 2
        for (int i = 0; i < 8; ++i) {
            float ss = 0.f;
#pragma unroll
            for (int v = 0; v < NV; ++v) { const u32x4 x = *(const u32x4*)(base + (size_t)(4 * i) * LDA + v * 8);
#pragma unroll
                for (int e = 0; e < 4; ++e) { const float a = __uint_as_float(x[e] << 16), b = __uint_as_float(x[e] & 0xffff0000u); ss += a * a + b * b; } }
            ss += __shfl_xor(ss, 1); ss += __shfl_xor(ss, 2); ss += __shfl_xor(ss, 4); ss += __shfl_xor(ss, 8);
            if (c == 0) tab[u.slot * 256 + wid * 32 + 4 * i + rr] = rsqrtf(ss * (1.f / KW) + 1e-6f);
        }
    }
};
template <int ROPE_PN> struct EpiBf16Rs {
    static constexpr bool PERM = true, AFTER_DRAIN = false;
    bf16_t* O; int ldc; const PG8_LAS float* rst; const float2* tab_r; const float2* tab_c; float gsc;
    __device__ __forceinline__ void operator()(const f32x4 (&acc)[2][2][4][2], const Unit& u, int wr, int wc, int fr, int fq) const {
        const int row0 = u.pm * BM + wr * 64 + fr, col0 = u.pn * BM + wc * 32 + 8 * fq;
        const bool rope = (ROPE_PN >= 0) && (u.pn == ROPE_PN);
#pragma unroll
        for (int ai = 0; ai < 2; ++ai)
#pragma unroll
            for (int m = 0; m < 4; ++m) { const int row = row0 + ai * HALF + m * 16; bf16_t* rowp = O + (size_t)row * ldc + col0;
                const float rs = rst[u.slot * 256 + ai * HALF + wr * 64 + m * 16 + fr] * gsc;
                f32x4 c01 = {1.f, 0.f, 1.f, 0.f}, c23 = c01;
                if (rope) { const int t = row & 2047; const float2* tp = (wc & 1) ? tab_c + (t & 63) * 16 + 4 * fq : tab_r + (t >> 6) * 16 + 4 * fq;
                    c01 = *(const f32x4*)tp; c23 = *(const f32x4*)(tp + 2); }
#pragma unroll
                for (int bj = 0; bj < 2; ++bj) { f32x4 v0 = acc[ai][bj][m][0] * rs, v1 = acc[ai][bj][m][1] * rs;
                    if (rope) { const f32x4 a0 = v0, a1 = v1;
                        v0[0] = a0[0] * c01[0] - a0[1] * c01[1]; v0[1] = a0[1] * c01[0] + a0[0] * c01[1]; v0[2] = a0[2] * c01[2] - a0[3] * c01[3]; v0[3] = a0[3] * c01[2] + a0[2] * c01[3];
                        v1[0] = a1[0] * c23[0] - a1[1] * c23[1]; v1[1] = a1[1] * c23[0] + a1[0] * c23[1]; v1[2] = a1[2] * c23[2] - a1[3] * c23[3]; v1[3] = a1[3] * c23[2] + a1[2] * c23[3]; }
                    u32x4 w; w.x = cvt_pk_bf16(v0[0], v0[1]); w.y = cvt_pk_bf16(v0[2], v0[3]); w.z = cvt_pk_bf16(v1[0], v1[1]); w.w = cvt_pk_bf16(v1[2], v1[3]);
                    *(u32x4*)(rowp + bj * HALF) = w; } }
    }
};

template <int K, int LDA, int LDB, class Epi, class Sched, bool ALIGN_EPI = false, bool SP2 = false>
__device__ __forceinline__ void gemm_phase(PG8_LAS unsigned char* lds, const Gemm g, const Sched& S, const Epi& E) {
    int tid_ = threadIdx.x; asm volatile("" : "+v"(tid_));
    const int tid = tid_, wid = __builtin_amdgcn_readfirstlane(tid >> 6), lane = tid & 63, wr = wid >> 2, wc = wid & 3, fr = lane & 15, fq = lane >> 4;
    constexpr int nt = K / BK;
    unsigned voffA[2], voffB[2];
#pragma unroll
    for (int i = 0; i < 2; ++i) { int R, C; stage_rc(tid * 16 + i * 8192, R, C); const int Rb = Epi::PERM ? ((R & ~31) + perm32(R & 31)) : R;
        voffA[i] = (unsigned)(R * LDA + C) * 2u; voffB[i] = (unsigned)(Rb * LDB + C) * 2u; }
    constexpr size_t kstep = (size_t)(BK * 2);
    constexpr size_t hsA = (size_t)HALF * LDA * 2, hsB = (size_t)HALF * LDB * 2;
    constexpr size_t tsA = 2 * hsA, tsB = 2 * hsB;
    const unsigned ldsw = (unsigned)wid * 1024u;
    const int aoff = lds_byte(wr * 64 + fr, fq * 8), boff = lds_byte(wc * 32 + fr, fq * 8);
#define PG8_SA(b, h) (((b) * 2 + (h)) * HTB)
#define PG8_SB(b, h) ((4 + (b) * 2 + (h)) * HTB)
#define PG8_STAGE(bufoff, gbase, voff) do { _Pragma("unroll") for (int _i = 0; _i < 2; ++_i) \
        __builtin_amdgcn_global_load_lds((const unsigned*)((const char*)(gbase) + (voff)[_i]), (PG8_LAS unsigned*)(lds + (bufoff) + ldsw + _i * 8192), 16, 0, 0); } while (0)
#define PG8_LDA(dst, b, h) do { _Pragma("unroll") for (int m = 0; m < 4; ++m) _Pragma("unroll") for (int k = 0; k < 2; ++k) dst[m][k] = *(const PG8_LAS bf16x8*)(lds + PG8_SA(b, h) + aoff + m * 2048 + k * 1024); } while (0)
#define PG8_LDB(dst, b, h) do { _Pragma("unroll") for (int n = 0; n < 2; ++n) _Pragma("unroll") for (int k = 0; k < 2; ++k) dst[n][k] = *(const PG8_LAS bf16x8*)(lds + PG8_SB(b, h) + boff + n * 2048 + k * 1024); } while (0)
#define PG8_MMA(ai, bj, At, Bt) do { __builtin_amdgcn_s_setprio(1); _Pragma("unroll") for (int m = 0; m < 4; ++m) _Pragma("unroll") for (int n = 0; n < 2; ++n) _Pragma("unroll") for (int k = 0; k < 2; ++k) \
        acc[ai][bj][m][n] = __builtin_amdgcn_mfma_f32_16x16x32_bf16(Bt[n][k], At[m][k], acc[ai][bj][m][n], 0, 0, 0); __builtin_amdgcn_s_setprio(0); } while (0)
#define PG8_WAIT_V(n) asm volatile("s_waitcnt vmcnt(" #n ")" ::: "memory")
#define PG8_WAIT_L(n) asm volatile("s_waitcnt lgkmcnt(" #n ")" ::: "memory")
#define PG8_BAR __builtin_amdgcn_s_barrier()
#define PG8_SCHED __builtin_amdgcn_sched_barrier(0)
    Unit cur, nxt; int ui = 0;
    if (!S.next(0, cur)) return;
    f32x4 acc[2][2][4][2];
#pragma unroll
    for (int a = 0; a < 2; ++a)
#pragma unroll
        for (int b = 0; b < 2; ++b)
#pragma unroll
            for (int m = 0; m < 4; ++m)
#pragma unroll
                for (int n = 0; n < 2; ++n) acc[a][b][m][n] = (f32x4){0.f, 0.f, 0.f, 0.f};
    bf16x8 At[4][2], B0[2][2], B1[2][2];
    const char* cA = (const char*)g.A + (size_t)cur.pm * tsA; const char* cB = (const char*)g.Bt + (size_t)cur.pn * tsB;
    S.a_ready(cur);
    if constexpr (SP2) {
        PG8_STAGE(PG8_SB(0, 0), cB, voffB); PG8_STAGE(PG8_SB(0, 1), cB + hsB, voffB); PG8_STAGE(PG8_SA(0, 0), cA, voffA); PG8_STAGE(PG8_SA(0, 1), cA + hsA, voffA);
        if (wr == 1) PG8_BAR;
        PG8_WAIT_V(2); PG8_BAR;
        PG8_STAGE(PG8_SB(1, 0), cB + kstep, voffB); PG8_STAGE(PG8_SA(1, 0), cA + kstep, voffA); PG8_STAGE(PG8_SB(1, 1), cB + hsB + kstep, voffB);
        PG8_WAIT_V(6); PG8_BAR;
    } else {
        PG8_STAGE(PG8_SB(0, 0), cB, voffB); PG8_STAGE(PG8_SA(0, 0), cA, voffA); PG8_STAGE(PG8_SB(0, 1), cB + hsB, voffB); PG8_STAGE(PG8_SA(0, 1), cA + hsA, voffA);
        if (wr == 1) PG8_BAR;
        PG8_WAIT_V(4); PG8_BAR;
        PG8_STAGE(PG8_SB(1, 0), cB + kstep, voffB); PG8_STAGE(PG8_SA(1, 0), cA + kstep, voffA); PG8_STAGE(PG8_SB(1, 1), cB + hsB + kstep, voffB);
        PG8_WAIT_V(6); PG8_BAR;
    }
    for (;;) {
        const bool has_next = S.next(ui + 1, nxt);
        const char* nA = has_next ? (const char*)g.A + (size_t)nxt.pm * tsA : cA; const char* nB = has_next ? (const char*)g.Bt + (size_t)nxt.pn * tsB : cB;
#pragma unroll 1
        for (int t = 0; t < nt; t += 2) {
            const bool last = (t == nt - 2);
            const char* a1 = cA + (size_t)(t + 1) * kstep;
            const char* a2 = last ? nA : cA + (size_t)(t + 2) * kstep; const char* b2 = last ? nB : cB + (size_t)(t + 2) * kstep;
            const char* a3 = a2 + kstep; const char* b3 = b2 + kstep;
            if (last && has_next) S.a_ready(nxt);
            if constexpr (SP2) {
            PG8_LDB(B0, 0, 0); PG8_LDB(B1, 0, 1); PG8_SCHED; PG8_LDA(At, 0, 0); PG8_STAGE(PG8_SA(1, 1), a1 + hsA, voffA);
            PG8_WAIT_V(8); PG8_WAIT_L(0); PG8_BAR; PG8_MMA(0, 0, At, B0); PG8_MMA(0, 1, At, B1); PG8_BAR; PG8_SCHED;
            PG8_LDA(At, 0, 1); PG8_STAGE(PG8_SB(0, 0), b2, voffB); PG8_STAGE(PG8_SB(0, 1), b2 + hsB, voffB); PG8_STAGE(PG8_SA(0, 0), a2, voffA);
            PG8_WAIT_V(8); PG8_WAIT_L(0); PG8_BAR; PG8_MMA(1, 0, At, B0); PG8_MMA(1, 1, At, B1); PG8_BAR; PG8_SCHED;
            PG8_LDB(B0, 1, 0); PG8_LDB(B1, 1, 1); PG8_SCHED; PG8_LDA(At, 1, 0); PG8_STAGE(PG8_SA(0, 1), a2 + hsA, voffA);
            PG8_WAIT_V(8); PG8_WAIT_L(0); PG8_BAR; PG8_MMA(0, 0, At, B0); PG8_MMA(0, 1, At, B1); PG8_BAR; PG8_SCHED;
            PG8_LDA(At, 1, 1); PG8_STAGE(PG8_SB(1, 0), b3, voffB); PG8_STAGE(PG8_SB(1, 1), b3 + hsB, voffB); PG8_STAGE(PG8_SA(1, 0), a3, voffA);
            PG8_WAIT_V(8); PG8_WAIT_L(0); PG8_BAR; PG8_MMA(1, 0, At, B0); PG8_MMA(1, 1, At, B1); PG8_BAR; PG8_SCHED;
            } else {
            PG8_LDB(B0, 0, 0); PG8_SCHED; PG8_LDA(At, 0, 0); PG8_STAGE(PG8_SA(1, 1), a1 + hsA, voffA);
            PG8_WAIT_L(8); PG8_BAR; PG8_WAIT_L(0); PG8_MMA(0, 0, At, B0); PG8_BAR; PG8_SCHED;
            PG8_LDB(B1, 0, 1); PG8_STAGE(PG8_SB(0, 0), b2, voffB);
            PG8_BAR; PG8_WAIT_L(0); PG8_MMA(0, 1, At, B1); PG8_BAR;
            PG8_LDA(At, 0, 1); PG8_STAGE(PG8_SA(0, 0), a2, voffA);
            PG8_BAR; PG8_WAIT_L(0); PG8_MMA(1, 0, At, B0); PG8_BAR; PG8_SCHED;
            PG8_STAGE(PG8_SB(0, 1), b2 + hsB, voffB);
            PG8_WAIT_V(6); PG8_BAR; PG8_MMA(1, 1, At, B1); PG8_BAR;
            PG8_LDB(B0, 1, 0); PG8_SCHED; PG8_LDA(At, 1, 0); PG8_STAGE(PG8_SA(0, 1), a2 + hsA, voffA);
            PG8_WAIT_L(8); PG8_BAR; PG8_WAIT_L(0); PG8_MMA(0, 0, At, B0); PG8_BAR; PG8_SCHED;
            PG8_LDB(B1, 1, 1); PG8_STAGE(PG8_SB(1, 0), b3, voffB);
            PG8_BAR; PG8_WAIT_L(0); PG8_MMA(0, 1, At, B1); PG8_BAR;
            PG8_LDA(At, 1, 1); PG8_STAGE(PG8_SA(1, 0), a3, voffA);
            PG8_BAR; PG8_WAIT_L(0); PG8_MMA(1, 0, At, B0); PG8_BAR; PG8_SCHED;
            PG8_STAGE(PG8_SB(1, 1), b3 + hsB, voffB);
            PG8_WAIT_V(6); PG8_BAR; PG8_MMA(1, 1, At, B1); PG8_BAR;
            }
        }
        if constexpr (ALIGN_EPI) { if (wr == 0) PG8_BAR; }
        if constexpr (!Epi::AFTER_DRAIN) { E(acc, cur, wr, wc, fr, fq); S.done(cur); }
        if (!has_next) break;
#pragma unroll
        for (int a = 0; a < 2; ++a)
#pragma unroll
            for (int b = 0; b < 2; ++b)
#pragma unroll
                for (int m = 0; m < 4; ++m)
#pragma unroll
                    for (int n = 0; n < 2; ++n) acc[a][b][m][n] = (f32x4){0.f, 0.f, 0.f, 0.f};
        cur = nxt; cA = nA; cB = nB; ++ui;
        if constexpr (ALIGN_EPI) { if (wr == 1) PG8_BAR; }
    }
    PG8_WAIT_V(0);
    if constexpr (!ALIGN_EPI) { if (wr == 0) PG8_BAR; }
    PG8_BAR;
    if constexpr (Epi::AFTER_DRAIN) { E.fused(acc, cur, wr, wc, fr, fq, lds, wid, lane); S.done(cur); }
#undef PG8_SA
#undef PG8_SB
#undef PG8_STAGE
#undef PG8_LDA
#undef PG8_LDB
#undef PG8_MMA
#undef PG8_WAIT_V
#undef PG8_WAIT_L
#undef PG8_BAR
#undef PG8_SCHED
}
}
#ifndef LAS
#define LAS __attribute__((address_space(3)))
#endif
namespace att {
using f32x16 = __attribute__((ext_vector_type(16))) float;
using s16x4  = __attribute__((ext_vector_type(4))) short;
using u32x4  = __attribute__((ext_vector_type(4))) unsigned;
constexpr int NW = 8, QBLK = 32, KVBLK = 64;
constexpr int SHM_V = 16384, SHM_K = 16384, SHM_P = 8192;
constexpr int OFF_V = 0, OFF_K = 2 * SHM_V, OFF_P = OFF_K + 2 * SHM_K, OFF_WS = OFF_P + 2 * SHM_P, OFF_BIAS = OFF_WS + NW * 64 * 4, OFF_QPE = OFF_BIAS + 2048, LDS_ATT = OFF_QPE + NW * 4096;
constexpr float THR = 8.f;
#define KSWZ(row, colB) ((row) * 256 + ((colB) ^ (((row) & 7) << 4)))
#define PSWZ(row, colB) ((row) * 128 + ((colB) ^ ((((row) >> 1) & 7) << 4)))
#define SBAR() __builtin_amdgcn_sched_barrier(0)
DEVI int crow(int r, int hi) { return (r & 3) + 8 * (r >> 2) + 4 * hi; }
DEVI unsigned cvtpk(float lo, float hi) { unsigned r; asm volatile("v_cvt_pk_bf16_f32 %0, %1, %2" : "=v"(r) : "v"(lo), "v"(hi)); return r; }

DEVI void partialSM2(f32x16& p0, f32x16& p1, float& mhat, f32x16& negm, float& alpha, bool first) {
  constexpr float THRL = 10.f;
  float pmax = p0[0];
#pragma unroll
  for (int r = 1; r < 16; ++r) pmax = fmaxf(pmax, p0[r]);
#pragma unroll
  for (int r = 0; r < 16; ++r) pmax = fmaxf(pmax, p1[r]);
  { auto rr = __builtin_amdgcn_permlane32_swap(__float_as_uint(pmax), __float_as_uint(pmax), false, false);
    pmax = fmaxf(__uint_as_float(rr[0]), __uint_as_float(rr[1])); }
  alpha = 1.f;
  if (__builtin_expect(first || __any(pmax > THRL), 0)) {
    const float dl = first ? pmax : fmaxf(pmax, 0.f);
    mhat += dl;
#pragma unroll
    for (int r = 0; r < 16; ++r) { p0[r] -= dl; p1[r] -= dl; }
#pragma unroll
    for (int r = 0; r < 16; ++r) negm[r] = -mhat;
    asm volatile("" : "+v"(negm));
    alpha = first ? 1.f : __builtin_amdgcn_exp2f(-dl);
  }
#pragma unroll
  for (int r = 0; r < 16; ++r) p0[r] = __builtin_amdgcn_exp2f(p0[r]);
}
template <int TYPE> DEVI void partialSM(f32x16& p0, f32x16& p1, float& m_reg, float& mn, float& alpha) {
  constexpr float SCALE = TYPE == 1 ? 0.07216878364870322f : 0.08838834764831845f;
  constexpr float C = SCALE * 1.4426950408889634f;
  float pmax = p0[0];
#pragma unroll
  for (int r = 1; r < 16; ++r) pmax = fmaxf(pmax, p0[r]);
#pragma unroll
  for (int r = 0; r < 16; ++r) pmax = fmaxf(pmax, p1[r]);
  { auto rr = __builtin_amdgcn_permlane32_swap(__float_as_uint(pmax), __float_as_uint(pmax), false, false);
    pmax = fmaxf(__uint_as_float(rr[0]), __uint_as_float(rr[1])); }
  if (__builtin_expect(__all(pmax - m_reg <= THR / SCALE), 1)) { mn = m_reg; alpha = 1.f; }
  else { mn = fmaxf(m_reg, pmax); alpha = __builtin_amdgcn_exp2f((m_reg - mn) * C); m_reg = mn; }
  const float mnC = -mn * C;
#pragma unroll
  for (int r = 0; r < 16; ++r) p0[r] = fmaf(p0[r], C, mnC);
#pragma unroll
  for (int r = 0; r < 16; ++r) p1[r] = fmaf(p1[r], C, mnC);
#pragma unroll
  for (int r = 0; r < 16; ++r) p0[r] = __builtin_amdgcn_exp2f(p0[r]);
}
DEVI void finishSM(f32x16& p0, f32x16& p1, float alpha, float& l_reg, bf16x8& pa0, bf16x8& pa1, bf16x8& pa2, bf16x8& pa3) {
#pragma unroll
  for (int r = 0; r < 16; ++r) p1[r] = __builtin_amdgcn_exp2f(p1[r]);
  float ps = 0;
#pragma unroll
  for (int r = 0; r < 16; ++r) ps += p0[r];
#pragma unroll
  for (int r = 0; r < 16; ++r) ps += p1[r];
  { auto rr = __builtin_amdgcn_permlane32_swap(__float_as_uint(ps), __float_as_uint(ps), false, false);
    ps = __uint_as_float(rr[0]) + __uint_as_float(rr[1]); }
  l_reg = l_reg * alpha + ps;
#define PK4(P, BASE, OUT) do { unsigned a0 = cvtpk(P[BASE + 0], P[BASE + 1]), a1 = cvtpk(P[BASE + 2], P[BASE + 3]);   \
    unsigned b0 = cvtpk(P[BASE + 4], P[BASE + 5]), b1 = cvtpk(P[BASE + 6], P[BASE + 7]);                              \
    auto r0 = __builtin_amdgcn_permlane32_swap(a0, b0, false, false); auto r1 = __builtin_amdgcn_permlane32_swap(a1, b1, false, false); \
    u32x4 w = {r0[0], r1[0], r0[1], r1[1]}; OUT = *reinterpret_cast<bf16x8*>(&w); } while (0)
  PK4(p0, 0, pa0); PK4(p0, 8, pa1); PK4(p1, 0, pa2); PK4(p1, 8, pa3);
#undef PK4
}
template <int TYPE> DEVI void qkt(f32x16& p0, f32x16& p1, const char* Ks, const char* Ps, const bf16x8* qr, const char* Qe, const f32x16& negm, int r32, int hi) {
  if constexpr (TYPE == 1) { p0 = f32x16{}; p1 = f32x16{}; } else { p0 = negm; p1 = negm; }
#pragma unroll
  for (int d0 = 0; d0 < 8; ++d0) { const int cb = (d0 * 16 + hi * 8) * 2;
    const bf16x8 b0 = *reinterpret_cast<const bf16x8*>(Ks + KSWZ(r32, cb));
    const bf16x8 b1 = *reinterpret_cast<const bf16x8*>(Ks + KSWZ(32 + r32, cb));
    p0 = __builtin_amdgcn_mfma_f32_32x32x16_bf16(b0, qr[d0], p0, 0, 0, 0);
    p1 = __builtin_amdgcn_mfma_f32_32x32x16_bf16(b1, qr[d0], p1, 0, 0, 0); }
  if constexpr (TYPE == 1) {
#pragma unroll
    for (int d0 = 0; d0 < 4; ++d0) { const int cb = (d0 * 16 + hi * 8) * 2;
      const bf16x8 b0 = *reinterpret_cast<const bf16x8*>(Ps + PSWZ(r32, cb));
      const bf16x8 b1 = *reinterpret_cast<const bf16x8*>(Ps + PSWZ(32 + r32, cb));
      const bf16x8 qe = *reinterpret_cast<const bf16x8*>(Qe + PSWZ(r32, cb));
      p0 = __builtin_amdgcn_mfma_f32_32x32x16_bf16(b0, qe, p0, 0, 0, 0);
      p1 = __builtin_amdgcn_mfma_f32_32x32x16_bf16(b1, qe, p1, 0, 0, 0); }
  }
}
DEVI int v_st(int k, int c) { const int kk = (k & ~0xC) | ((k & 4) << 1) | ((k & 8) >> 1); return ((kk >> 3) * 4 + (c >> 5)) * 512 + ((kk & 7) * 32 + (c & 31)) * 2; }
DEVI int v_rd_base(int lane) { return ((lane & 3) << 3) | (((lane >> 2) & 3) << 6) | (((lane >> 4) & 1) << 5) | (((lane >> 5) & 1) << 8); }
constexpr int v_rd_off(int d0, int ks, int half) { return d0 * 512 + ks * 4096 + half * 2048; }
template <int OFF> DEVI s16x4 tr_read(int vb) { s16x4 r; asm volatile("ds_read_b64_tr_b16 %0, %1 offset:%2" : "=&v"(r) : "v"(vb), "i"(OFF) : "memory"); return r; }
template <int D0> DEVI void pv_one(f32x16& od, int vb, bf16x8 pa0, bf16x8 pa1, bf16x8 pa2, bf16x8 pa3) {
  const s16x4 l0 = tr_read<v_rd_off(D0, 0, 0)>(vb), h0 = tr_read<v_rd_off(D0, 0, 1)>(vb), l1 = tr_read<v_rd_off(D0, 1, 0)>(vb), h1 = tr_read<v_rd_off(D0, 1, 1)>(vb);
  const s16x4 l2 = tr_read<v_rd_off(D0, 2, 0)>(vb), h2 = tr_read<v_rd_off(D0, 2, 1)>(vb), l3 = tr_read<v_rd_off(D0, 3, 0)>(vb), h3 = tr_read<v_rd_off(D0, 3, 1)>(vb);
  asm volatile("s_waitcnt lgkmcnt(0)" ::: "memory"); SBAR();
#define PK(L, H) (bf16x8){L[0], L[1], L[2], L[3], H[0], H[1], H[2], H[3]}
  od = __builtin_amdgcn_mfma_f32_32x32x16_bf16(pa0, PK(l0, h0), od, 0, 0, 0);
  od = __builtin_amdgcn_mfma_f32_32x32x16_bf16(pa1, PK(l1, h1), od, 0, 0, 0);
  od = __builtin_amdgcn_mfma_f32_32x32x16_bf16(pa2, PK(l2, h2), od, 0, 0, 0);
  od = __builtin_amdgcn_mfma_f32_32x32x16_bf16(pa3, PK(l3, h3), od, 0, 0, 0);
#undef PK
}
DEVI void pv_d0(f32x16* o, int vb, bf16x8 pa0, bf16x8 pa1, bf16x8 pa2, bf16x8 pa3) {
  pv_one<0>(o[0], vb, pa0, pa1, pa2, pa3); pv_one<1>(o[1], vb, pa0, pa1, pa2, pa3); pv_one<2>(o[2], vb, pa0, pa1, pa2, pa3); pv_one<3>(o[3], vb, pa0, pa1, pa2, pa3);
}
DEVI void nb_mask(f32x16& p0, f32x16& p1, int kr, int r, int r0, int c, int c0, int hi, const float* bt) {
  const bool active = (unsigned)(kr - r0) < 8u;
  if (!active) {
#pragma unroll
    for (int i = 0; i < 16; ++i) { p0[i] = -1e30f; p1[i] = -1e30f; }
  } else {
    const float* bp = bt + (kr - r + 7) * 31 + 15 - c + 4 * hi;
    const int dk = 4 * hi - c0;
#pragma unroll
    for (int i = 0; i < 16; ++i) { const int kc = (i & 3) + 8 * (i >> 2);
      p0[i] = ((unsigned)(kc + dk) < 16u) ? p0[i] + bp[kc] : -1e30f;
      p1[i] = ((unsigned)(kc + 32 + dk) < 16u) ? p1[i] + bp[kc + 32] : -1e30f; }
  }
}

template <int TYPE, int SDEPTH>
DEVI void attn_unit(int b, int h, int qb, const bf16_t* __restrict__ PROJ, const bf16_t* __restrict__ QB, const bf16_t* __restrict__ KVB,
                    const float* __restrict__ rpb, const float* __restrict__ qgain, const float2* __restrict__ tab, bf16_t* __restrict__ MIX, char* lds, LAS unsigned char* L3) {
  constexpr float SCALE = TYPE == 1 ? 0.07216878364870322f : 0.08838834764831845f;
  constexpr int NQ = 8;
  constexpr int LDQ = TYPE == 1 ? 768 : NP, LDK = TYPE == 1 ? 1024 : NP;
  int tid_ = threadIdx.x; asm volatile("" : "+v"(tid_));
  const int tid = tid_, wid = tid >> 6, lane = tid & 63, r32 = lane & 31, hi = lane >> 5;
  const size_t row0 = (size_t)b * SEQ + qb * 256, kb0 = (size_t)b * SEQ;
  const bf16_t* Qp = TYPE == 0 ? PROJ + row0 * NP + C_AQ + h * 128 : TYPE == 2 ? PROJ + row0 * NP + C_CQ + h * 128 : QB + row0 * 768 + h * 128;
  const bf16_t* Kh = TYPE == 0 ? PROJ + kb0 * NP + C_AK + (h >> 2) * 128 : TYPE == 2 ? PROJ + kb0 * NP + C_CK + h * 128 : KVB + kb0 * 1024 + h * 256;
  const bf16_t* Vh = TYPE == 0 ? PROJ + kb0 * NP + C_AV + (h >> 2) * 128 : TYPE == 2 ? PROJ + kb0 * NP + C_CV + h * 128 : KVB + kb0 * 1024 + h * 256 + 128;
  const bf16_t* Ph = PROJ + kb0 * NP + C_BKR;
  char* V_lds = lds + OFF_V; char* K_lds = lds + OFF_K; char* P_lds = lds + OFF_P;
  float* wsf = (float*)(lds + OFF_WS) + wid * 64; float* li_l = wsf; float* al_l = wsf + 32;
  float* bt = (float*)(lds + OFF_BIAS);
  int kt0 = 0, NT = SEQ / KVBLK;
  if (TYPE == 2) { if (qb == 0) { kt0 = 0; NT = 8; } else if (qb == 7) { kt0 = 24; NT = 8; } else { kt0 = min(4 * qb - 4, 20); NT = 12; } }
  const int nr = 4 * qb + (wid >> 1), nc = 32 * (wid & 1) + r32, nr0 = min(max(nr - 4, 0), 24), nc0 = min(max(nc - 8, 0), 48);
  if (TYPE == 2) { for (int i = tid; i < 465; i += 512) bt[i] = rpb[h * 465 + i] * 1.4426950408889634f; }
  float mhat = 0.f, l_reg = 0; bool first = true; f32x16 negm = {}; asm volatile("" : "+v"(negm)); f32x16 o[4] = {}; bf16x8 qr[NQ];
  const bf16_t* Qw = Qp + (size_t)(wid * QBLK + r32) * LDQ + hi * 8;
#pragma unroll
  for (int d0 = 0; d0 < 8; ++d0) qr[d0] = *reinterpret_cast<const bf16x8*>(Qw + d0 * 16);
  if constexpr (TYPE == 0) {
    float ss = 0.f;
#pragma unroll
    for (int d0 = 0; d0 < 8; ++d0) { const u32x4 w = __builtin_bit_cast(u32x4, qr[d0]);
#pragma unroll
      for (int e = 0; e < 4; ++e) { const float x1 = __uint_as_float(w[e] << 16), x2 = __uint_as_float(w[e] & 0xffff0000u); ss += x1 * x1 + x2 * x2; } }
    { auto rr = __builtin_amdgcn_permlane32_swap(__float_as_uint(ss), __float_as_uint(ss), false, false); ss = __uint_as_float(rr[0]) + __uint_as_float(rr[1]); }
    const float rs = rsqrtf(ss * (1.f / 128.f) + EPS) * (SCALE * 1.4426950408889634f);
    const int t_ = qb * 256 + wid * QBLK + r32, pr = t_ >> 6, pc = t_ & 63;
#pragma unroll
    for (int d0 = 0; d0 < 8; ++d0) { const int ax = d0 >> 2, j0 = (d0 & 3) * 8 + hi * 4;
      const float4 g0 = *(const float4*)(qgain + 64 * ax + j0), g1 = *(const float4*)(qgain + 64 * ax + 32 + j0);
      const float4* tp = (const float4*)(tab + (ax == 0 ? T_AR + pr * 32 : T_AC + pc * 32) + j0); const float4 c01 = tp[0], c23 = tp[1];
      const u32x4 w = __builtin_bit_cast(u32x4, qr[d0]); u32x4 o_;
      { const float x1 = __uint_as_float(w[0] << 16) * rs * g0.x, x2 = __uint_as_float(w[0] & 0xffff0000u) * rs * g1.x; o_[0] = pk2(x1 * c01.x - x2 * c01.y, x2 * c01.x + x1 * c01.y); }
      { const float x1 = __uint_as_float(w[1] << 16) * rs * g0.y, x2 = __uint_as_float(w[1] & 0xffff0000u) * rs * g1.y; o_[1] = pk2(x1 * c01.z - x2 * c01.w, x2 * c01.z + x1 * c01.w); }
      { const float x1 = __uint_as_float(w[2] << 16) * rs * g0.z, x2 = __uint_as_float(w[2] & 0xffff0000u) * rs * g1.z; o_[2] = pk2(x1 * c23.x - x2 * c23.y, x2 * c23.x + x1 * c23.y); }
      { const float x1 = __uint_as_float(w[3] << 16) * rs * g0.w, x2 = __uint_as_float(w[3] & 0xffff0000u) * rs * g1.w; o_[3] = pk2(x1 * c23.z - x2 * c23.w, x2 * c23.z + x1 * c23.w); }
      qr[d0] = __builtin_bit_cast(bf16x8, o_); }
  }
  const char* Qe = lds + OFF_QPE + wid * 4096;
  if constexpr (TYPE == 1) {
#pragma unroll
    for (int i = 0; i < 4; ++i) { const int idx = i * 64 + lane, rw = idx >> 3, ch = idx & 7;
      *(u32x4*)(lds + OFF_QPE + wid * 4096 + PSWZ(rw, ch * 16)) = *reinterpret_cast<const u32x4*>(QB + (row0 + wid * QBLK + rw) * 768 + 512 + h * 64 + ch * 8); } }
  const int sr = tid >> 4, sc = (tid & 15) * 8, vst0 = v_st(sr, sc), vst1 = v_st(32 + sr, sc);
  const int pr_ = tid >> 3, pc_ = (tid & 7) * 8;
  const int vb0 = (int)(uintptr_t)V_lds + v_rd_base(lane);
  struct { bf16x8 vs0, vs1, ks0, ks1, ps; } sr_[2];
#define SLOAD(i, k0) do { const size_t kk_ = (size_t)(kt0 * KVBLK + (k0)); \
    sr_[i].vs0 = *reinterpret_cast<const bf16x8*>(&Vh[(kk_ + sr) * LDK + sc]); sr_[i].vs1 = *reinterpret_cast<const bf16x8*>(&Vh[(kk_ + 32 + sr) * LDK + sc]); \
    sr_[i].ks0 = *reinterpret_cast<const bf16x8*>(&Kh[(kk_ + sr) * LDK + sc]); sr_[i].ks1 = *reinterpret_cast<const bf16x8*>(&Kh[(kk_ + 32 + sr) * LDK + sc]); \
    if constexpr (TYPE == 1) sr_[i].ps = *reinterpret_cast<const bf16x8*>(&Ph[(kk_ + pr_) * NP + pc_]); } while (0)
#define SWRITE(bf, i) do { *(bf16x8*)(V_lds + (bf) * SHM_V + vst0) = sr_[i].vs0; *(bf16x8*)(V_lds + (bf) * SHM_V + vst1) = sr_[i].vs1; const int kc = sc * 2; \
    *(bf16x8*)(K_lds + (bf) * SHM_K + KSWZ(sr, kc)) = sr_[i].ks0; *(bf16x8*)(K_lds + (bf) * SHM_K + KSWZ(32 + sr, kc)) = sr_[i].ks1; \
    if constexpr (TYPE == 1) *(bf16x8*)(P_lds + (bf) * SHM_P + PSWZ(pr_, pc_ * 2)) = sr_[i].ps; } while (0)
#define SWAIT() do { if constexpr (SDEPTH == 2) { if constexpr (TYPE == 1) asm volatile("s_waitcnt vmcnt(5)" ::: "memory"); else asm volatile("s_waitcnt vmcnt(4)" ::: "memory"); } \
    else asm volatile("s_waitcnt vmcnt(0)" ::: "memory"); } while (0)
#define RESC(a) do { if (__any((a) < 1.f)) { if (hi == 0) al_l[r32] = (a); asm volatile("s_waitcnt lgkmcnt(0)" ::: "memory"); \
    _Pragma("unroll") for (int d = 0; d < 4; ++d) _Pragma("unroll") for (int r = 0; r < 16; ++r) o[d][r] *= al_l[crow(r, hi)]; } } while (0)
#define MASK(P0, P1, j) do { if constexpr (TYPE == 2) nb_mask(P0, P1, kt0 + (j), nr, nr0, nc, nc0, hi, bt); } while (0)
  f32x16 pA0, pA1, pB0, pB1; float alA, alB; float m_reg = -1e30f, mn_ = 0.f; (void)mn_; (void)m_reg;
#define PSM(P0, P1, AL) do { if constexpr (TYPE == 1) partialSM<TYPE>(P0, P1, m_reg, mn_, AL); else { partialSM2(P0, P1, mhat, negm, AL, first); first = false; } } while (0)
  bf16x8 pa0, pa1, pa2, pa3;
  constexpr int SE = 0, SO = (SDEPTH == 2) ? 1 : 0;
  if constexpr (TYPE == 2) {
    const int wnr0 = __builtin_amdgcn_readfirstlane(nr0);
#define ACT(j) ((unsigned)(kt0 + (j) - wnr0) < 8u)
#define TILE(j, bf) do { if (ACT(j)) { qkt<TYPE>(pA0, pA1, K_lds + (bf) * SHM_K, P_lds, qr, Qe, negm, r32, hi); MASK(pA0, pA1, j); PSM(pA0, pA1, alA); RESC(alA); \
      finishSM(pA0, pA1, alA, l_reg, pa0, pa1, pa2, pa3); SBAR(); pv_d0(o, vb0 + (bf) * SHM_V, pa0, pa1, pa2, pa3); } } while (0)
    SLOAD(0, 0); asm volatile("s_waitcnt vmcnt(0)" ::: "memory"); SWRITE(0, 0); __syncthreads();
    SLOAD(1, KVBLK); if constexpr (SDEPTH == 2) SLOAD(0, 2 * KVBLK);
    for (int j = 0; j < NT; j += 2) {
      TILE(j, 0);
      SWAIT(); SWRITE(1, 1);
      if constexpr (SDEPTH == 2) { if (j + 3 < NT) SLOAD(1, (j + 3) * KVBLK); }
      __syncthreads();
      if constexpr (SDEPTH == 1) { if (j + 2 < NT) SLOAD(0, (j + 2) * KVBLK); }
      TILE(j + 1, 1);
      if (j + 2 < NT) { SWAIT(); SWRITE(0, 0);
        if constexpr (SDEPTH == 2) { if (j + 4 < NT) SLOAD(0, (j + 4) * KVBLK); }
        __syncthreads();
        if constexpr (SDEPTH == 1) SLOAD(1, (j + 3) * KVBLK); }
    }
#undef TILE
#undef ACT
  } else if constexpr (SDEPTH == 3) {
    unsigned kofs[2], vofs[2], pofs;
#pragma unroll
    for (int i = 0; i < 2; ++i) { const int q = 2 * wid + i;
      { const int row = 4 * q + (lane >> 4), c = (lane & 15) ^ (row & 7); kofs[i] = (unsigned)(row * LDK + c * 8); }
      { const int kk = (q >> 1) * 8 + ((lane & 31) >> 2), k = (kk & ~0xC) | ((kk & 4) << 1) | ((kk & 8) >> 1), col = ((q & 1) * 2 + (lane >> 5)) * 32 + (lane & 3) * 8; vofs[i] = (unsigned)(k * LDK + col); } }
    { const int row = 8 * wid + (lane >> 3), c = (lane & 7) ^ ((row >> 1) & 7); pofs = (unsigned)(row * NP + c * 8); }
    LAS unsigned char* Kd = L3 + OFF_K + wid * 2048; LAS unsigned char* Vd = L3 + OFF_V + wid * 2048; LAS unsigned char* Pd = L3 + OFF_P + wid * 1024;
#define DMA_K(t, bf) do { const bf16_t* kb_ = Kh + (size_t)(kt0 + (t)) * KVBLK * LDK; \
      __builtin_amdgcn_global_load_lds((const unsigned*)(kb_ + kofs[0]), (LAS unsigned*)(Kd + (bf) * SHM_K), 16, 0, 0); __builtin_amdgcn_global_load_lds((const unsigned*)(kb_ + kofs[1]), (LAS unsigned*)(Kd + (bf) * SHM_K + 1024), 16, 0, 0); \
      if constexpr (TYPE == 1) __builtin_amdgcn_global_load_lds((const unsigned*)(Ph + (size_t)(kt0 + (t)) * KVBLK * NP + pofs), (LAS unsigned*)(Pd + (bf) * SHM_P), 16, 0, 0); } while (0)
#define DMA_V(t, bf) do { const bf16_t* vb_ = Vh + (size_t)(kt0 + (t)) * KVBLK * LDK; \
      __builtin_amdgcn_global_load_lds((const unsigned*)(vb_ + vofs[0]), (LAS unsigned*)(Vd + (bf) * SHM_V), 16, 0, 0); __builtin_amdgcn_global_load_lds((const unsigned*)(vb_ + vofs[1]), (LAS unsigned*)(Vd + (bf) * SHM_V + 1024), 16, 0, 0); } while (0)
#define DBAR() do { asm volatile("s_waitcnt vmcnt(0)" ::: "memory"); __syncthreads(); } while (0)
    DMA_K(0, 0); DMA_K(1, 1); DMA_V(0, 0); DBAR();
    SBAR(); qkt<TYPE>(pA0, pA1, K_lds, P_lds, qr, Qe, negm, r32, hi); PSM(pA0, pA1, alA);
    __syncthreads();
    for (int t = 1; t + 1 < NT; t += 2) {
      DMA_K(t + 1, 0); DMA_V(t, 1);
      SBAR(); qkt<TYPE>(pB0, pB1, K_lds + SHM_K, P_lds + SHM_P, qr, Qe, negm, r32, hi);
      finishSM(pA0, pA1, alA, l_reg, pa0, pa1, pa2, pa3); SBAR();
      pv_d0(o, vb0, pa0, pa1, pa2, pa3); PSM(pB0, pB1, alB);
      RESC(alB); DBAR();
      if (t + 2 < NT) DMA_K(t + 2, 1); DMA_V(t + 1, 0);
      SBAR(); qkt<TYPE>(pA0, pA1, K_lds, P_lds, qr, Qe, negm, r32, hi);
      finishSM(pB0, pB1, alB, l_reg, pa0, pa1, pa2, pa3); SBAR();
      pv_d0(o, vb0 + SHM_V, pa0, pa1, pa2, pa3); PSM(pA0, pA1, alA);
      RESC(alA); DBAR();
    }
    DMA_V(NT - 1, 1);
    SBAR(); qkt<TYPE>(pB0, pB1, K_lds + SHM_K, P_lds + SHM_P, qr, Qe, negm, r32, hi);
    finishSM(pA0, pA1, alA, l_reg, pa0, pa1, pa2, pa3); SBAR();
    pv_d0(o, vb0, pa0, pa1, pa2, pa3); PSM(pB0, pB1, alB);
    RESC(alB); DBAR();
    finishSM(pB0, pB1, alB, l_reg, pa0, pa1, pa2, pa3); SBAR();
    pv_d0(o, vb0 + SHM_V, pa0, pa1, pa2, pa3);
#undef DMA_K
#undef DMA_V
#undef DBAR
#define KLOAD(t)
#define VLOAD(t)
#define KWRITE(t)
#define VWRITE(t)
#undef KLOAD
#undef VLOAD
#undef KWRITE
#undef VWRITE
  } else {
  SLOAD(SE, 0); asm volatile("s_waitcnt vmcnt(0)" ::: "memory"); SWRITE(0, SE); __syncthreads();
  qkt<TYPE>(pA0, pA1, K_lds, P_lds, qr, Qe, negm, r32, hi); MASK(pA0, pA1, 0); PSM(pA0, pA1, alA);
  SLOAD(SO, KVBLK); if constexpr (SDEPTH == 2) { if (2 < NT) SLOAD(SE, 2 * KVBLK); }
  SWAIT(); SWRITE(1, SO); __syncthreads();
  for (int j = 1; j + 1 < NT; j += 2) {
    SBAR(); qkt<TYPE>(pB0, pB1, K_lds + SHM_K, P_lds + SHM_P, qr, Qe, negm, r32, hi); MASK(pB0, pB1, j);
    finishSM(pA0, pA1, alA, l_reg, pa0, pa1, pa2, pa3); SBAR();
    SLOAD(SO, (j + SDEPTH) * KVBLK); SBAR();
    pv_d0(o, vb0, pa0, pa1, pa2, pa3); PSM(pB0, pB1, alB);
    __syncthreads(); SWAIT(); SWRITE(0, SE);
    RESC(alB); __syncthreads();
    SBAR(); qkt<TYPE>(pA0, pA1, K_lds, P_lds, qr, Qe, negm, r32, hi); MASK(pA0, pA1, j + 1);
    finishSM(pB0, pB1, alB, l_reg, pa0, pa1, pa2, pa3); SBAR();
    if (SDEPTH == 1 || j + 3 < NT) SLOAD(SE, (j + 1 + SDEPTH) * KVBLK); SBAR();
    pv_d0(o, vb0 + SHM_V, pa0, pa1, pa2, pa3); PSM(pA0, pA1, alA);
    __syncthreads(); SWAIT(); SWRITE(1, SO);
    RESC(alA); __syncthreads();
  }
  SBAR(); qkt<TYPE>(pB0, pB1, K_lds + SHM_K, P_lds + SHM_P, qr, Qe, negm, r32, hi); MASK(pB0, pB1, NT - 1);
  finishSM(pA0, pA1, alA, l_reg, pa0, pa1, pa2, pa3); SBAR();
  pv_d0(o, vb0, pa0, pa1, pa2, pa3); PSM(pB0, pB1, alB);
  __syncthreads(); RESC(alB);
  finishSM(pB0, pB1, alB, l_reg, pa0, pa1, pa2, pa3); SBAR();
  pv_d0(o, vb0 + SHM_V, pa0, pa1, pa2, pa3);
  }
  if (hi == 0) li_l[r32] = l_reg; asm volatile("s_waitcnt lgkmcnt(0)" ::: "memory");
  float rli[16];
#pragma unroll
  for (int r = 0; r < 16; ++r) rli[r] = __builtin_amdgcn_rcpf(li_l[crow(r, hi)]);
  __syncthreads();
  bf16_t* stg = (bf16_t*)(lds + wid * 8192);
#pragma unroll
  for (int r = 0; r < 16; ++r) { const int orow = crow(r, hi);
#pragma unroll
    for (int d0 = 0; d0 < 4; ++d0) stg[orow * 128 + d0 * 32 + r32] = (bf16_t)f2bf(o[d0][r] * rli[r]); }
  asm volatile("s_waitcnt lgkmcnt(0)" ::: "memory");
  constexpr int GCOL = TYPE == 0 ? C_AG : TYPE == 1 ? C_BG : C_CG, MCOL = TYPE == 0 ? 0 : TYPE == 1 ? 1024 : 1536;
  const bf16_t* Gp = PROJ + (row0 + wid * QBLK) * NP + GCOL + h * 128; bf16_t* Op = MIX + (row0 + wid * QBLK) * DMIX + MCOL + h * 128;
#pragma unroll
  for (int i = 0; i < 8; ++i) { const int pidx = i * 64 + lane, row = pidx >> 4, ch = pidx & 15;
    const u32x4 ov = *(const u32x4*)(stg + row * 128 + ch * 8); const u32x4 gv = *(const u32x4*)(Gp + (size_t)row * NP + ch * 8);
    u32x4 w;
#pragma unroll
    for (int e = 0; e < 4; ++e) { const float g0 = bf2f(gv[e] & 0xffffu), g1 = bf2f(gv[e] >> 16), o0 = bf2f(ov[e] & 0xffffu), o1 = bf2f(ov[e] >> 16);
      w[e] = pk2(o0 * g0 * __builtin_amdgcn_rcpf(1.f + __expf(-g0)), o1 * g1 * __builtin_amdgcn_rcpf(1.f + __expf(-g1))); }
    *(u32x4*)(Op + (size_t)row * DMIX + ch * 8) = w; }
  __syncthreads();
#undef SLOAD
#undef SWRITE
#undef SWAIT
#undef RESC
#undef MASK
#undef PSM
}
#undef SBAR
}
#ifndef AMASK
#define AMASK 7
#endif
#ifndef REP_KIND
#define REP_KIND -1
#endif
#ifndef G1_NOEPI
#define G1_NOEPI 0
#endif
#ifndef G1_ALIGN
#define G1_ALIGN true
#endif
#ifndef G1_SP2
#define G1_SP2 true
#endif
#ifndef AREP
#define AREP 7
#endif
#define NREP(k) ((k) == REP_KIND ? 2 : 1)
constexpr int NWAVES = 8;
constexpr int N_PHASES = 1 + 5 * DEPTH;
constexpr size_t WS_CTL = 0, CTL_ZERO_BYTES = 64 * 1024;
constexpr int CW_BAR = 1024;
constexpr int RING_OFF = 0, RING_BYTES = 131072;
constexpr int LDSCTL_OFF = RING_BYTES, MISC_OFF = LDSCTL_OFF + 320, RST_OFF = LDSCTL_OFF + 1024;
constexpr int LDS_BYTES = 147456;

#define GAS __attribute__((address_space(1)))
#ifndef LAS
#define LAS __attribute__((address_space(3)))
#endif
typedef GAS unsigned gu32;
#define RLX_AGENT __ATOMIC_RELAXED, __HIP_MEMORY_SCOPE_AGENT

#define XB_TMO      128
#define XB_XCNT(j)  (256  + 64 * (j))
#define XB_XSUB(j)  (1280 + 64 * (j))
#define XB_XGEN(j)  (2304 + 64 * (j))
#define XB_TOP      3328
#define XB_TOPGEN   3392
#define XCD_BAR_WORDS 3456
#define XB_SPIN_CAP (1u << 18)
__device__ __forceinline__ unsigned xb_ld(unsigned* p)              { return __hip_atomic_load(p, __ATOMIC_RELAXED, __HIP_MEMORY_SCOPE_AGENT); }
__device__ __forceinline__ unsigned xb_add(unsigned* p, unsigned v) { return __hip_atomic_fetch_add(p, v, __ATOMIC_RELAXED, __HIP_MEMORY_SCOPE_AGENT); }
__device__ __forceinline__ unsigned xb_xcc_id() { return (unsigned)__builtin_amdgcn_s_getreg((3 << 11) | 20) & 0xFu; }
#define XB_SPIN(cond, bar) do { unsigned _sp = 0; while (cond) { __builtin_amdgcn_s_sleep(1); \
    if ((++_sp & 255u) == 0u) { if (xb_ld(&(bar)[XB_TMO])) break; if (_sp > XB_SPIN_CAP) { atomicAdd(&(bar)[XB_TMO], 1u); break; } } } } while (0)
struct XcdBarrier { unsigned* bar; unsigned x; volatile LAS unsigned* st; };
__device__ __forceinline__ XcdBarrier xcd_barrier_post(unsigned* bar, volatile LAS unsigned* st) {
    XcdBarrier b; b.bar = bar; b.x = xb_xcc_id(); b.st = st;
    if (threadIdx.x == 0) (void)xb_add(&bar[XB_XCNT(b.x)], 1u);
    return b;
}
__device__ __forceinline__ void xcd_barrier_complete(unsigned* bar, unsigned x, unsigned& nloc, unsigned& nx) {
    const unsigned G = gridDim.x * gridDim.y * gridDim.z;
    unsigned sum, cnt, mine, sp = 0u;
    for (;;) {
        sum = 0u; cnt = 0u; mine = 0u;
#pragma unroll
        for (unsigned j = 0; j < 16; ++j) { const unsigned c = xb_ld(&bar[XB_XCNT(j)]); sum += c; cnt += (c > 0u) ? 1u : 0u; mine = (j == x) ? c : mine; }
        if (sum == G) break;
        __builtin_amdgcn_s_sleep(1);
        if ((++sp & 255u) == 0u) { if (xb_ld(&bar[XB_TMO])) break; if (sp > XB_SPIN_CAP) { atomicAdd(&bar[XB_TMO], 1u); break; } }
    }
    nloc = mine > 0u ? mine : 1u; nx = cnt > 0u ? cnt : 1u;
}
__device__ __forceinline__ void xcd_barrier(const XcdBarrier& b) {
    asm volatile("s_waitcnt vmcnt(0)" ::: "memory");
    __syncthreads();
    if (threadIdx.x == 0) {
        unsigned* bar = b.bar;
        __builtin_amdgcn_s_waitcnt(0);
        unsigned nloc = b.st[0], nx = b.st[1];
        if (nloc == 0u) { xcd_barrier_complete(bar, b.x, nloc, nx); b.st[0] = nloc; b.st[1] = nx; }
        const unsigned old = xb_add(&bar[XB_XSUB(b.x)], 1u);
        const unsigned gen = old / nloc;
        if (old + 1u == (gen + 1u) * nloc) {
            __builtin_amdgcn_fence(__ATOMIC_RELEASE, "agent");
            asm volatile("s_waitcnt vmcnt(0)" ::: "memory");
            const unsigned og = xb_add(&bar[XB_TOP], 1u);
            const unsigned tg = og / nx;
            if (og + 1u == (tg + 1u) * nx) xb_add(&bar[XB_TOPGEN], 1u);
            else XB_SPIN(xb_ld(&bar[XB_TOPGEN]) == tg, bar);
            __builtin_amdgcn_fence(__ATOMIC_ACQUIRE, "agent");
            xb_add(&bar[XB_XGEN(b.x)], 1u);
            asm volatile("s_waitcnt vmcnt(0)" ::: "memory");
        } else {
            XB_SPIN(xb_ld(&bar[XB_XGEN(b.x)]) == gen, bar);
            __builtin_amdgcn_fence(__ATOMIC_ACQUIRE, "agent");
            asm volatile("s_waitcnt vmcnt(0)" ::: "memory");
        }
    }
    __syncthreads();
}

struct Args {
    const float* in[12]; float* out; unsigned char* ws;
    int ph_lo, ph_hi, li, amask;
};


DEVI int fwd_col(int mode, int o) {
    if (mode == 0) return o;
    if (mode == 1) {
        if (o < 1280) { const int d = o & 127, a = d >> 6, t = (d >> 5) & 1, j = d & 31; return (o & ~127) + 64 * a + 2 * j + t; }
        if (o < 3328) return o;
        if (o < 3392) { const int d = o - 3328, a = d >> 5, t = (d >> 4) & 1, j = d & 15; return 3328 + 32 * a + 2 * j + t; }
        return o + 192;
    }
    const int h = o / 192, d = o - h * 192;
    if (d < 128) return h * 128 + d;
    { const int p = d - 128, a = p >> 5, t = (p >> 4) & 1, j = p & 15; return 512 + h * 64 + 32 * a + 2 * j + t; }
}
DEVI void p0_transpose_item(const float* __restrict__ W, int K, int Ns, int mode, const float* __restrict__ kgain, bf16_t* __restrict__ WT, LAS unsigned* scr, int item, int lane) {
    const int nblk = Ns / 64, kb = item / nblk, nb = item - kb * nblk, k0 = 64 * kb, n0 = 64 * nb;
    const int ks = lane >> 4, n4 = (lane & 15) * 4;
    float4 v[16];
#pragma unroll
    for (int i = 0; i < 16; ++i) { const int k = 8 * (i >> 1) + 2 * ks + (i & 1); v[i] = *(const float4*)(W + (size_t)(k0 + k) * Ns + n0 + n4); }
#pragma unroll
    for (int i = 0; i < 8; ++i) { const int kp = 4 * i + ks; float g0 = 1.f, g1 = 1.f;
        if (kgain) { g0 = kgain[k0 + 2 * kp]; g1 = kgain[k0 + 2 * kp + 1]; }
        LAS unsigned* d = scr + kp * 65 + n4;
        d[0] = pk2(v[2 * i].x * g0, v[2 * i + 1].x * g1); d[1] = pk2(v[2 * i].y * g0, v[2 * i + 1].y * g1);
        d[2] = pk2(v[2 * i].z * g0, v[2 * i + 1].z * g1); d[3] = pk2(v[2 * i].w * g0, v[2 * i + 1].w * g1); }
    asm volatile("s_waitcnt lgkmcnt(0)" ::: "memory");
    const int c = lane & 7;
#pragma unroll
    for (int i = 0; i < 8; ++i) { const int n = 8 * i + (lane >> 3); const LAS unsigned* s = scr + (4 * c) * 65 + n;
        uint4 o; o.x = s[0]; o.y = s[65]; o.z = s[130]; o.w = s[195];
        *(uint4*)(WT + (size_t)fwd_col(mode, n0 + n) * K + k0 + 8 * c) = o; }
    asm volatile("s_waitcnt lgkmcnt(0)" ::: "memory");
}
DEVI void rmsnorm_row_xn(const float* __restrict__ xrow, const float* __restrict__ g, bf16_t* __restrict__ orow, int lane) {
    const float4* xr = (const float4*)xrow + lane;
    float4 v[8]; float ss = 0.f;
#pragma unroll
    for (int j = 0; j < 8; ++j) { v[j] = xr[64 * j]; ss += v[j].x * v[j].x + v[j].y * v[j].y + v[j].z * v[j].z + v[j].w * v[j].w; }
    const float rs = rsqrtf(wave_sum(ss) * (1.f / DM) + EPS);
    uint2* o = (uint2*)orow + lane;
#pragma unroll
    for (int j = 0; j < 8; ++j) { const float4 gg = ((const float4*)g)[lane + 64 * j];
        o[64 * j] = make_uint2(pk2(v[j].x * rs * gg.x, v[j].y * rs * gg.y), pk2(v[j].z * rs * gg.z, v[j].w * rs * gg.w)); }
}
DEVI void phase_prologue(const Args& args, LAS unsigned char* L, int gw, int NGW, int wave, int lane) {
    unsigned char* ws = args.ws;
    LAS unsigned* scr = (LAS unsigned*)(L + RING_OFF + wave * 16384);
    constexpr int I_IN = (DM / 64) * (DIN / 64), I_OUT = (DMIX / 64) * (DM / 64), I_UQ = (512 / 64) * (768 / 64), I_UKV = (256 / 64) * (1024 / 64), I_L = I_IN + I_OUT + I_UQ + I_UKV;
    for (int it = gw; it < DEPTH * I_L; it += NGW) {
        const int l = it / I_L; int r = it % I_L;
        if (r < I_IN) { p0_transpose_item(args.in[3] + (size_t)l * DM * DIN, DM, DIN, 1, l == 0 ? nullptr : args.in[1] + l * DM, (bf16_t*)(ws + WS_WIN + l * WIN_L), scr, r, lane); continue; } r -= I_IN;
        if (r < I_OUT) { p0_transpose_item(args.in[11] + (size_t)l * DMIX * DM, DMIX, DM, 0, nullptr, (bf16_t*)(ws + WS_WOUT + l * WOUT_L), scr, r, lane); continue; } r -= I_OUT;
        if (r < I_UQ) { p0_transpose_item(args.in[8] + (size_t)l * 512 * 768, 512, 768, 2, args.in[6] + l * 512, (bf16_t*)(ws + WS_WUQ + l * WUQ_L), scr, r, lane); continue; } r -= I_UQ;
        p0_transpose_item(args.in[9] + (size_t)l * 256 * 1024, 256, 1024, 0, args.in[7] + l * 256, (bf16_t*)(ws + WS_WUKV + l * WUKV_L), scr, r, lane);
    }
    for (int it = gw; it < DEPTH * 192 * 4; it += NGW) { const int l = it / 768, r = (it % 768) >> 2, q = it & 3;
        ((uint4*)((bf16_t*)(ws + WS_WIN + l * WIN_L) + (size_t)(3392 + r) * DM))[q * 64 + lane] = make_uint4(0u, 0u, 0u, 0u); }
    bf16_t* XN = (bf16_t*)(ws + WS_XN);
    for (int m = gw; m < M; m += NGW) rmsnorm_row_xn(args.in[0] + (size_t)m * DM, args.in[1], XN + (size_t)m * DM, lane);
    float2* tab = (float2*)(ws + WS_TAB);
    for (int i = gw * 64 + lane; i < T_N; i += NGW * 64) {
        int pos, j; float n;
        if (i < T_AC) { pos = i >> 5; j = i & 31; n = 64.f; }
        else if (i < T_BR) { pos = (i - T_AC) >> 5; j = i & 31; n = 64.f; }
        else if (i < T_BC) { pos = (i - T_BR) >> 4; j = i & 15; n = 32.f; }
        else { pos = (i - T_BC) >> 4; j = i & 15; n = 32.f; }
        const float inv = 1.0f / powf(10000.f, (float)(2 * j) / n);
        const float ang = (float)pos * inv;
        const float k = rintf(ang * 0.15915494309189535f);
        float r = fmaf(-k, 6.28318548202514648f, ang); r = fmaf(-k, -1.74845553e-7f, r);
        tab[i] = make_float2(cosf(r), sinf(r));
    }
}
DEVI void postproj_row(bf16_t* __restrict__ p, int row, int lane, const float* __restrict__ a_qn, const float* __restrict__ a_kn,
                       const float* __restrict__ b_qn, const float* __restrict__ b_kvn, const float2* __restrict__ tab) {
    const int t = row & (SEQ - 1), pr = t >> 6, pc = t & 63;
    {
        const int a = lane >> 5, j = lane & 31;
        const float2 cs = a == 0 ? tab[T_AR + pr * 32 + j] : tab[T_AC + pc * 32 + j];
        const int d1 = 64 * a + j, d2 = d1 + 32;
        const float gq1 = a_qn[d1], gq2 = a_qn[d2], gk1 = a_kn[d1], gk2 = a_kn[d2];
        unsigned v[10];
#pragma unroll
        for (int hb = 0; hb < 10; ++hb) v[hb] = ((const unsigned*)(p + hb * 128))[lane];
#pragma unroll
        for (int hb = 0; hb < 10; ++hb) {
            const float x1 = bf2f(v[hb] & 0xffffu), x2 = bf2f(v[hb] >> 16);
            const float rs = rsqrtf(wave_sum(x1 * x1 + x2 * x2) * (1.f / 128.f) + EPS);
            const float y1 = x1 * rs * (hb < 8 ? gq1 : gk1), y2 = x2 * rs * (hb < 8 ? gq2 : gk2);
            ((unsigned*)(p + hb * 128))[lane] = pk2(y1 * cs.x - y2 * cs.y, y2 * cs.x + y1 * cs.y);
        }
    }
    {
        uint4* pp = (uint4*)(p + C_BCQ) + lane; const uint4 v = *pp; float x[8];
        x[0] = bf2f(v.x & 0xffffu); x[1] = bf2f(v.x >> 16); x[2] = bf2f(v.y & 0xffffu); x[3] = bf2f(v.y >> 16);
        x[4] = bf2f(v.z & 0xffffu); x[5] = bf2f(v.z >> 16); x[6] = bf2f(v.w & 0xffffu); x[7] = bf2f(v.w >> 16);
        float ss = 0.f;
#pragma unroll
        for (int i = 0; i < 8; ++i) ss += x[i] * x[i];
        const float rs = rsqrtf(wave_sum(ss) * (1.f / 512.f) + EPS);
        const float4 g0 = ((const float4*)b_qn)[2 * lane], g1 = ((const float4*)b_qn)[2 * lane + 1];
        *pp = make_uint4(pk2(x[0] * rs * g0.x, x[1] * rs * g0.y), pk2(x[2] * rs * g0.z, x[3] * rs * g0.w),
                         pk2(x[4] * rs * g1.x, x[5] * rs * g1.y), pk2(x[6] * rs * g1.z, x[7] * rs * g1.w));
    }
    {
        uint2* pp = (uint2*)(p + C_BCKV) + lane; const uint2 v = *pp;
        const float x0 = bf2f(v.x & 0xffffu), x1 = bf2f(v.x >> 16), x2 = bf2f(v.y & 0xffffu), x3 = bf2f(v.y >> 16);
        const float rs = rsqrtf(wave_sum(x0 * x0 + x1 * x1 + x2 * x2 + x3 * x3) * (1.f / 256.f) + EPS);
        const float4 g = ((const float4*)b_kvn)[lane];
        *pp = make_uint2(pk2(x0 * rs * g.x, x1 * rs * g.y), pk2(x2 * rs * g.z, x3 * rs * g.w));
    }
    if (lane < 32) {
        const int a = lane >> 4, j = lane & 15;
        const float2 cs = a == 0 ? tab[T_BR + pr * 16 + j] : tab[T_BC + pc * 16 + j];
        unsigned* pp = (unsigned*)(p + C_BKR) + lane; const unsigned v = *pp; const float x1 = bf2f(v & 0xffffu), x2 = bf2f(v >> 16);
        *pp = pk2(x1 * cs.x - x2 * cs.y, x2 * cs.x + x1 * cs.y);
    }
}
DEVI void postprojK_row(bf16_t* __restrict__ p, int row, int lane, const float* __restrict__ a_kn, const float2* __restrict__ tab) {
    const int t = row & (SEQ - 1), pr = t >> 6, pc = t & 63;
    const int a = lane >> 5, j = lane & 31;
    const float2 cs = a == 0 ? tab[T_AR + pr * 32 + j] : tab[T_AC + pc * 32 + j];
    const float gk1 = a_kn[64 * a + j], gk2 = a_kn[64 * a + j + 32];
    unsigned* pk = (unsigned*)(p + C_AK); const unsigned v0 = pk[lane], v1 = pk[64 + lane];
    unsigned vr = 0; const int a2 = lane >> 4, j2 = lane & 15; float2 cs2 = make_float2(1.f, 0.f);
    if (lane < 32) { vr = ((const unsigned*)(p + C_BKR))[lane]; cs2 = a2 == 0 ? tab[T_BR + pr * 16 + j2] : tab[T_BC + pc * 16 + j2]; }
    { const float x1 = bf2f(v0 & 0xffffu), x2 = bf2f(v0 >> 16); const float rs = rsqrtf(wave_sum(x1 * x1 + x2 * x2) * (1.f / 128.f) + EPS);
      const float y1 = x1 * rs * gk1, y2 = x2 * rs * gk2; pk[lane] = pk2(y1 * cs.x - y2 * cs.y, y2 * cs.x + y1 * cs.y); }
    { const float x1 = bf2f(v1 & 0xffffu), x2 = bf2f(v1 >> 16); const float rs = rsqrtf(wave_sum(x1 * x1 + x2 * x2) * (1.f / 128.f) + EPS);
      const float y1 = x1 * rs * gk1, y2 = x2 * rs * gk2; pk[64 + lane] = pk2(y1 * cs.x - y2 * cs.y, y2 * cs.x + y1 * cs.y); }
    if (lane < 32) { const float x1 = bf2f(vr & 0xffffu), x2 = bf2f(vr >> 16); ((unsigned*)(p + C_BKR))[lane] = pk2(x1 * cs2.x - x2 * cs2.y, x2 * cs2.x + x1 * cs2.y); }
}
template <bool FIRST>
DEVI void rowpass_row(const bf16_t* __restrict__ yrow, const float* __restrict__ xrow, const bf16_t* __restrict__ x1row_in, const float* __restrict__ g_post, float* __restrict__ orow_,
                      bf16_t* __restrict__ x1row_out, float* __restrict__ rs2out, int lane) {
    const uint2* yr = (const uint2*)yrow + lane;
    float4 v[8]; float ss = 0.f;
#pragma unroll
    for (int j = 0; j < 8; ++j) { const uint2 yv = yr[64 * j]; v[j] = make_float4(bf2f(yv.x & 0xffffu), bf2f(yv.x >> 16), bf2f(yv.y & 0xffffu), bf2f(yv.y >> 16)); ss += v[j].x * v[j].x + v[j].y * v[j].y + v[j].z * v[j].z + v[j].w * v[j].w; }
    const float rs = rsqrtf(wave_sum(ss) * (1.f / DM) + EPS);
    float s2 = 0.f;
#pragma unroll
    for (int j = 0; j < 8; ++j) { const float4 gg = ((const float4*)g_post)[lane + 64 * j]; float4 xx;
        if (FIRST) xx = ((const float4*)xrow)[lane + 64 * j];
        else { const uint2 xv = ((const uint2*)x1row_in)[lane + 64 * j]; xx = make_float4(bf2f(xv.x & 0xffffu), bf2f(xv.x >> 16), bf2f(xv.y & 0xffffu), bf2f(xv.y >> 16)); }
        v[j].x = xx.x + v[j].x * rs * gg.x; v[j].y = xx.y + v[j].y * rs * gg.y; v[j].z = xx.z + v[j].z * rs * gg.z; v[j].w = xx.w + v[j].w * rs * gg.w;
        if (FIRST) { ((uint2*)x1row_out)[lane + 64 * j] = make_uint2(pk2(v[j].x, v[j].y), pk2(v[j].z, v[j].w)); s2 += v[j].x * v[j].x + v[j].y * v[j].y + v[j].z * v[j].z + v[j].w * v[j].w; }
        else ((float4*)orow_)[lane + 64 * j] = v[j]; }
    if (FIRST) { const float r2 = rsqrtf(wave_sum(s2) * (1.f / DM) + EPS); if (lane == 0) *rs2out = r2; }
}

__global__ void __launch_bounds__(NWAVES * 64, 2) mk_fwd(Args args) {
    extern __shared__ __attribute__((aligned(16))) unsigned char lds[];
    LAS unsigned char* L = (LAS unsigned char*)lds;
    volatile LAS unsigned* MISC = (volatile LAS unsigned*)(L + MISC_OFF);
    const int G = gridDim.x; const int bx = blockIdx.x;
    const int vcu = (G % 8 == 0) ? (bx % 8) * (G / 8) + bx / 8 : bx;
    unsigned char* ws = args.ws;
    gu32* ctl = (gu32*)(ws + WS_CTL);
    for (int u = threadIdx.x; u < (LDS_BYTES - LDSCTL_OFF) / 4; u += NWAVES * 64) ((LAS unsigned*)(L + LDSCTL_OFF))[u] = 0u;
    __syncthreads();
    XcdBarrier bar; bar.bar = (unsigned*)(ctl + CW_BAR) + args.li * XCD_BAR_WORDS; bar.x = 0; bar.st = nullptr;
    const bool multi = (args.ph_hi - args.ph_lo) > 1;
    if (multi) bar = xcd_barrier_post((unsigned*)(ctl + CW_BAR) + args.li * XCD_BAR_WORDS, MISC + 8);
    bf16_t* XN = (bf16_t*)(ws + WS_XN); bf16_t* PROJ = (bf16_t*)(ws + WS_PROJ); bf16_t* Y = (bf16_t*)(ws + WS_Y);
    bf16_t* QB = (bf16_t*)(ws + WS_QB); bf16_t* KVB = (bf16_t*)(ws + WS_KVB); bf16_t* MIX = (bf16_t*)(ws + WS_MIX);
    const int lo = args.ph_lo, hi = args.ph_hi;
#define IN(k) (lo <= (k) && (k) < hi)
#define SEAM(k) do { if (IN(k) && IN((k) + 1)) xcd_barrier(bar); } while (0)
    const int NGW = G * NWAVES;
#define FRESH_IDS() int tid__ = threadIdx.x; asm volatile("" : "+v"(tid__)); const int lane_ = tid__ & 63, wave_ = __builtin_amdgcn_readfirstlane(tid__ >> 6), gw_ = vcu * NWAVES + wave_
    const float2* tab = (const float2*)(ws + WS_TAB);
    if (IN(0)) { for (int rep_ = 0; rep_ < NREP(0); ++rep_) { FRESH_IDS(); phase_prologue(args, L, gw_, NGW, wave_, lane_); } }
    SEAM(0);
#define LAYER(l) do { \
        constexpr int pb = 1 + 5 * (l); \
        if (IN(pb + 0)) { for (int rep_ = 0; rep_ < NREP(1); ++rep_) { \
            pg8::Gemm g{(l) == 0 ? XN : (const bf16_t*)(ws + WS_X1B), (const bf16_t*)(ws + WS_WIN + (l) * WIN_L)}; pg8::StaticOrder S; S.init(M, NP, G, bx); \
            pg8::EpiBf16 E{PROJ, NP, C_CQ / 256, C_CQ / 256 + 2, 0.08838834764831845f * 1.4426950408889634f, (l) == 0 ? nullptr : (const float*)(ws + WS_RS2)}; \
            pg8::gemm_phase<DM, DM, DM, pg8::EpiBf16, pg8::StaticOrder, true, true>(L + RING_OFF, g, S, E); \
        } } \
        SEAM(pb + 0); \
        if (IN(pb + 1)) { for (int rep_ = 0; rep_ < NREP(3); ++rep_) { \
            if (rep_ == 0) { FRESH_IDS(); for (int m = gw_; m < M; m += NGW) postprojK_row(PROJ + (size_t)m * NP, m, lane_, args.in[5] + (l) * 128, tab); } \
            { pg8::Gemm g{PROJ + C_BCQ, (const bf16_t*)(ws + WS_WUQ + (l) * WUQ_L)}; pg8::RsOrder<512, NP> S; S.init(M, 768, G, bx); S.A = PROJ + C_BCQ; S.tab = (LAS float*)(L + RST_OFF); \
              pg8::EpiBf16Rs<2> E{QB, 768, (const LAS float*)(L + RST_OFF), tab + T_BR, tab + T_BC, 1.f}; \
              pg8::gemm_phase<512, NP, 512, pg8::EpiBf16Rs<2>, pg8::RsOrder<512, NP>, true, true>(L + RING_OFF, g, S, E); } \
            { pg8::Gemm g{PROJ + C_BCKV, (const bf16_t*)(ws + WS_WUKV + (l) * WUKV_L)}; pg8::RsOrder<256, NP> S; S.init(M, 1024, G, bx); S.A = PROJ + C_BCKV; S.tab = (LAS float*)(L + RST_OFF); \
              pg8::EpiBf16Rs<-1> E{KVB, 1024, (const LAS float*)(L + RST_OFF), tab, tab, 1.f}; \
              pg8::gemm_phase<256, NP, 256, pg8::EpiBf16Rs<-1>, pg8::RsOrder<256, NP>, true, true>(L + RING_OFF, g, S, E); } \
        } } \
        SEAM(pb + 1); \
        if (IN(pb + 2)) { for (int rep_ = 0; rep_ < NREP(4); ++rep_) { \
            const float* rpb_l = args.in[10] + (size_t)(l) * 4 * 465; const float* qg_l = args.in[4] + (l) * 128; \
            for (int u = vcu; u < 1024; u += G) { \
                if (u < 512) { if (rep_ == 0 || (AREP & 1)) { const int kvh = u >> 8, b_ = (u & 255) >> 5, i_ = u & 31; att::attn_unit<0, 3>(b_, kvh * 4 + (i_ >> 3), i_ & 7, PROJ, QB, KVB, rpb_l, qg_l, tab, MIX, (char*)lds + RING_OFF, L + RING_OFF); } } \
                else if (u < 768) { if (rep_ == 0 || (AREP & 2)) { const int ub = u - 512, b_ = ub >> 5, i_ = ub & 31; att::attn_unit<1, 3>(b_, i_ >> 3, i_ & 7, PROJ, QB, KVB, rpb_l, qg_l, tab, MIX, (char*)lds + RING_OFF, L + RING_OFF); } } \
                else { if (rep_ == 0 || (AREP & 4)) { const int ub = u - 768, b_ = ub >> 5, i_ = ub & 31; att::attn_unit<2, 2>(b_, i_ >> 3, i_ & 7, PROJ, QB, KVB, rpb_l, qg_l, tab, MIX, (char*)lds + RING_OFF, L + RING_OFF); } } \
            } \
        } } \
        SEAM(pb + 2); \
        if (IN(pb + 3)) { for (int rep_ = 0; rep_ < NREP(5); ++rep_) { \
            pg8::Gemm g{MIX, (const bf16_t*)(ws + WS_WOUT + (l) * WOUT_L)}; pg8::StaticOrder S; S.init(M, DM, G, bx); \
            pg8::EpiBf16 E{Y, DM, 0, 0, 1.f, nullptr}; \
            pg8::gemm_phase<DMIX, DMIX, DMIX, pg8::EpiBf16, pg8::StaticOrder, true, true>(L + RING_OFF, g, S, E); \
        } } \
        SEAM(pb + 3); \
        if (IN(pb + 4)) { FRESH_IDS(); bf16_t* X1B = (bf16_t*)(ws + WS_X1B); for (int m = gw_; m < M; m += NGW) rowpass_row<(l) == 0>(Y + (size_t)m * DM, args.in[0] + (size_t)m * DM, X1B + (size_t)m * DM, args.in[2] + (l) * DM, args.out + (size_t)m * DM, \
                X1B + (size_t)m * DM, (float*)(ws + WS_RS2) + m, lane_); } \
        SEAM(pb + 4); \
    } while (0)
    LAYER(0);
    LAYER(1);
#undef LAYER
#undef IN
#undef SEAM
}

static int g_grid = 0;
static void launch_mk(Args a, int lo, int hi, int li, hipStream_t stream) {
    a.ph_lo = lo; a.ph_hi = hi; a.li = li;
    hipLaunchKernelGGL(mk_fwd, dim3(g_grid), dim3(NWAVES * 64), LDS_BYTES, stream, a);
}

extern "C" void kernel_launch(void* const* d_in, const int* in_sizes, int n_in, void* d_out, int out_size, void* d_ws, size_t ws_size, hipStream_t stream) {
  if (n_in != 12 || in_sizes[0] != M * DM || out_size != M * DM || ws_size < WS_END) {
    fprintf(stderr, "kernel_launch: unexpected shapes n_in %d in0 %d out %d ws %zu (need %zu)\n", n_in, n_in > 0 ? in_sizes[0] : -1, out_size, ws_size, (size_t)WS_END); return; }
  if (g_grid == 0) {
    int dev = 0, cus = 0, per_cu = 0;
    if (hipGetDevice(&dev) != hipSuccess || hipDeviceGetAttribute(&cus, hipDeviceAttributeMultiprocessorCount, dev) != hipSuccess) { fprintf(stderr, "kernel_launch: device query failed\n"); g_grid = -1; return; }
    if (hipFuncSetAttribute((const void*)mk_fwd, hipFuncAttributeMaxDynamicSharedMemorySize, LDS_BYTES) != hipSuccess) { fprintf(stderr, "kernel_launch: hipFuncSetAttribute failed\n"); g_grid = -1; return; }
    if (hipOccupancyMaxActiveBlocksPerMultiprocessor(&per_cu, (const void*)mk_fwd, NWAVES * 64, LDS_BYTES) != hipSuccess || per_cu < 1) { fprintf(stderr, "kernel_launch: occupancy query says %d blocks/CU\n", per_cu); g_grid = -1; (void)hipGetLastError(); return; }
    g_grid = cus;
  }
  if (g_grid < 0) return;
  const float* x = (const float*)d_in[0]; const float* norm_pre = (const float*)d_in[1]; const float* norm_post = (const float*)d_in[2];
  const float* w_in = (const float*)d_in[3]; const float* a_qn = (const float*)d_in[4]; const float* a_kn = (const float*)d_in[5];
  const float* b_qn = (const float*)d_in[6]; const float* b_kvn = (const float*)d_in[7]; const float* w_uq = (const float*)d_in[8];
  const float* w_ukv = (const float*)d_in[9]; const float* rpb = (const float*)d_in[10]; const float* w_out = (const float*)d_in[11];
  char* ws = (char*)d_ws; float* out = (float*)d_out;
  (void)hipMemsetAsync(ws + WS_CTL, 0, CTL_ZERO_BYTES, stream);
  Args a{}; for (int i = 0; i < 12; ++i) a.in[i] = (const float*)d_in[i]; a.out = out; a.ws = (unsigned char*)d_ws; a.amask = AMASK;
  launch_mk(a, 0, N_PHASES, 0, stream);
  (void)x; (void)norm_pre; (void)norm_post; (void)w_in; (void)a_qn; (void)a_kn; (void)b_qn; (void)b_kvn; (void)w_uq; (void)w_ukv; (void)rpb; (void)w_out;
}
```
